# Optimizing an MI355X kernel written in HIP

```python
import math
import jax, jax.numpy as jnp
from jax import lax
import numpy as np

D_MODEL = 1024
BATCH = 16
SEQ = 2048
DEPTH = 4

CHUNK = 64
Q_BLOCK = 128
N_MIXERS = 2
FFN_PERIOD = 2
RMS_EPS = 1e-6

MLA_HEADS = 8
MLA_NOPE = 128
MLA_ROPE = 64
MLA_V = 128
MLA_QK = MLA_NOPE + MLA_ROPE
Q_LORA = 256
KV_LORA = 128
ROPE_THETA = 10000.0

CA_HEADS = 16
CA_HEAD_DIM = 64
LEFT_CHUNKS = 8
BAND_CHUNKS = LEFT_CHUNKS + 1
MAX_REL = 256
REL_BUCKETS = MAX_REL + CHUNK

DENSE_FF = 2816
N_EXPERTS = 8
TOP_K = 2
EXPERT_FF = 3584

kernel_name = "hybrid_mla_chunkband_moe_trunk"


def rmsnorm(x, g):
    xf = x.astype(jnp.float32)
    y = xf * lax.rsqrt(jnp.mean(xf * xf, axis=-1, keepdims=True) + RMS_EPS)
    return (y * g.astype(jnp.float32)).astype(x.dtype)


def rope_angles(positions):
    inv = 1.0 / (ROPE_THETA ** (jnp.arange(0, MLA_ROPE, 2, dtype=jnp.float32) / MLA_ROPE))
    ang = positions.astype(jnp.float32)[..., None] * inv
    return jnp.cos(ang), jnp.sin(ang)


def apply_rope(x, cos, sin):
    x1, x2 = jnp.split(x.astype(jnp.float32), 2, axis=-1)
    c = cos[:, :, None, :]
    s = sin[:, :, None, :]
    return jnp.concatenate([x1 * c - x2 * s, x1 * s + x2 * c], axis=-1).astype(x.dtype)


def chunk_causal_attention(q, k, v):
    B, S, H, Dq = q.shape
    Dv = v.shape[-1]
    nb = S // Q_BLOCK
    scale = Dq ** -0.5
    qb = q.reshape(B, nb, Q_BLOCK, H, Dq).transpose(1, 0, 2, 3, 4)
    key_chunk = jnp.arange(S) // CHUNK

    def one_block(args):
        qi, bi = args
        s = jnp.einsum('bqhd,bkhd->bhqk', qi, k, preferred_element_type=jnp.float32) * scale
        q_chunk = (bi * Q_BLOCK + jnp.arange(Q_BLOCK)) // CHUNK
        mask = key_chunk[None, :] <= q_chunk[:, None]
        s = jnp.where(mask[None, None], s, -jnp.inf)
        p = jax.nn.softmax(s, axis=-1)
        return jnp.einsum('bhqk,bkhd->bqhd', p.astype(v.dtype), v)

    o = lax.map(one_block, (qb, jnp.arange(nb)))
    return o.transpose(1, 0, 2, 3, 4).reshape(B, S, H, Dv)


def mla_mixer(h, cos, sin, w_in, q_a_norm, kv_a_norm, w_uq, w_ukv, q_norm, k_norm, w_o):
    B, S, _ = h.shape
    a = h @ w_in
    q_lat, kv_lat, k_rope = jnp.split(a, [Q_LORA, Q_LORA + KV_LORA], axis=-1)
    q = (rmsnorm(q_lat, q_a_norm) @ w_uq).reshape(B, S, MLA_HEADS, MLA_QK)
    kv = (rmsnorm(kv_lat, kv_a_norm) @ w_ukv).reshape(B, S, MLA_HEADS, MLA_NOPE + MLA_V)
    k_nope, v = jnp.split(kv, [MLA_NOPE], axis=-1)
    k_rope = jnp.broadcast_to(k_rope[:, :, None, :], (B, S, MLA_HEADS, MLA_ROPE))
    k = jnp.concatenate([k_nope, k_rope], axis=-1)
    q = rmsnorm(q, q_norm)
    k = rmsnorm(k, k_norm)
    q = jnp.concatenate([q[..., :MLA_NOPE], apply_rope(q[..., MLA_NOPE:], cos, sin)], axis=-1)
    k = jnp.concatenate([k[..., :MLA_NOPE], apply_rope(k[..., MLA_NOPE:], cos, sin)], axis=-1)
    o = chunk_causal_attention(q, k, v)
    return o.reshape(B, S, MLA_HEADS * MLA_V) @ w_o


def chunked_band_mixer(h, w_qkv, q_norm, k_norm, rel_bias, w_o):
    B, S, _ = h.shape
    NC = S // CHUNK
    BAND = BAND_CHUNKS * CHUNK
    qkv = (h @ w_qkv).reshape(B, S, 3, CA_HEADS, CA_HEAD_DIM)
    q = rmsnorm(qkv[:, :, 0], q_norm)
    k = rmsnorm(qkv[:, :, 1], k_norm)
    v = qkv[:, :, 2]
    qc = q.reshape(B, NC, CHUNK, CA_HEADS, CA_HEAD_DIM)
    pad = ((0, 0), (LEFT_CHUNKS, 0), (0, 0), (0, 0), (0, 0))
    kc = jnp.pad(k.reshape(B, NC, CHUNK, CA_HEADS, CA_HEAD_DIM), pad)
    vc = jnp.pad(v.reshape(B, NC, CHUNK, CA_HEADS, CA_HEAD_DIM), pad)
    band_idx = jnp.arange(NC)[:, None] + jnp.arange(BAND_CHUNKS)[None, :]
    kb = kc[:, band_idx].reshape(B, NC, BAND, CA_HEADS, CA_HEAD_DIM)
    vb = vc[:, band_idx].reshape(B, NC, BAND, CA_HEADS, CA_HEAD_DIM)
    s = jnp.einsum('bcqhd,bckhd->bchqk', qc, kb, preferred_element_type=jnp.float32) * (CA_HEAD_DIM ** -0.5)
    q_off = LEFT_CHUNKS * CHUNK + jnp.arange(CHUNK)
    k_off = jnp.arange(BAND)
    rel = jnp.clip(q_off[:, None] - k_off[None, :], -(CHUNK - 1), MAX_REL) + (CHUNK - 1)
    bias = rel_bias[:, rel].astype(jnp.float32)
    key_chunk = jnp.arange(NC)[:, None] - LEFT_CHUNKS + (k_off // CHUNK)[None, :]
    valid = key_chunk >= 0
    s = jnp.where(valid[None, :, None, None, :], s + bias[None, None], -jnp.inf)
    p = jax.nn.softmax(s, axis=-1)
    o = jnp.einsum('bchqk,bckhd->bcqhd', p.astype(vb.dtype), vb)
    return o.reshape(B, S, CA_HEADS * CA_HEAD_DIM) @ w_o


def swiglu(h, w_gate, w_up, w_down):
    return (jax.nn.silu(h @ w_gate) * (h @ w_up)) @ w_down


def moe_ffn(h, router, w_gate, w_up, w_down):
    B, S, D = h.shape
    t = h.reshape(B * S, D)
    logits = jnp.einsum('td,de->te', t, router, preferred_element_type=jnp.float32)
    top_val, top_idx = lax.top_k(logits, TOP_K)
    top_w = jax.nn.softmax(top_val, axis=-1)
    gates = jnp.sum(jax.nn.one_hot(top_idx, N_EXPERTS, dtype=jnp.float32) * top_w[..., None], axis=1)
    gates = gates.astype(t.dtype)
    out = jnp.zeros_like(t)
    for e in range(N_EXPERTS):
        out = out + gates[:, e:e + 1] * swiglu(t, w_gate[e], w_up[e], w_down[e])
    return out.reshape(B, S, D)


def setup_inputs(seed: int = 0) -> dict:
    key = jax.random.key(seed)
    keys = iter(jax.random.split(key, 128))

    def w(shape, fan_in):
        return jax.random.normal(next(keys), shape, jnp.float32) * fan_in ** -0.5

    def g(n):
        return 1.0 + 0.02 * jax.random.normal(next(keys), (n,), jnp.float32)

    inp = {}
    inp["x"] = jax.random.normal(next(keys), (BATCH, SEQ, D_MODEL), jnp.float32)
    offs = jax.random.randint(next(keys), (BATCH, 1), 0, 64, dtype=jnp.int32) * CHUNK
    inp["positions"] = (offs + jnp.arange(SEQ, dtype=jnp.int32)[None, :]).astype(jnp.int32)
    for i in range(DEPTH):
        p = "l%d_" % i
        inp[p + "attn_norm"] = g(D_MODEL)
        if i % N_MIXERS == 0:
            inp[p + "mla_w_in"] = w((D_MODEL, Q_LORA + KV_LORA + MLA_ROPE), D_MODEL)
            inp[p + "mla_q_a_norm"] = g(Q_LORA)
            inp[p + "mla_kv_a_norm"] = g(KV_LORA)
            inp[p + "mla_w_uq"] = w((Q_LORA, MLA_HEADS * MLA_QK), Q_LORA)
            inp[p + "mla_w_ukv"] = w((KV_LORA, MLA_HEADS * (MLA_NOPE + MLA_V)), KV_LORA)
            inp[p + "mla_q_norm"] = g(MLA_QK)
            inp[p + "mla_k_norm"] = g(MLA_QK)
            inp[p + "mla_w_o"] = w((MLA_HEADS * MLA_V, D_MODEL), MLA_HEADS * MLA_V)
        else:
            inp[p + "ca_w_qkv"] = w((D_MODEL, 3 * CA_HEADS * CA_HEAD_DIM), D_MODEL)
            inp[p + "ca_q_norm"] = g(CA_HEAD_DIM)
            inp[p + "ca_k_norm"] = g(CA_HEAD_DIM)
            inp[p + "ca_rel_bias"] = 0.1 * jax.random.normal(next(keys), (CA_HEADS, REL_BUCKETS), jnp.float32)
            inp[p + "ca_w_o"] = w((CA_HEADS * CA_HEAD_DIM, D_MODEL), CA_HEADS * CA_HEAD_DIM)
        inp[p + "ffn_norm"] = g(D_MODEL)
        if i % FFN_PERIOD == 0:
            inp[p + "ffn_w_gate"] = w((D_MODEL, DENSE_FF), D_MODEL)
            inp[p + "ffn_w_up"] = w((D_MODEL, DENSE_FF), D_MODEL)
            inp[p + "ffn_w_down"] = w((DENSE_FF, D_MODEL), DENSE_FF)
        else:
            inp[p + "moe_router"] = w((D_MODEL, N_EXPERTS), D_MODEL)
            inp[p + "moe_w_gate"] = w((N_EXPERTS, D_MODEL, EXPERT_FF), D_MODEL)
            inp[p + "moe_w_up"] = w((N_EXPERTS, D_MODEL, EXPERT_FF), D_MODEL)
            inp[p + "moe_w_down"] = w((N_EXPERTS, EXPERT_FF, D_MODEL), EXPERT_FF)
    return inp


def reference(x, positions,
              l0_attn_norm, l0_mla_w_in, l0_mla_q_a_norm, l0_mla_kv_a_norm, l0_mla_w_uq, l0_mla_w_ukv,
              l0_mla_q_norm, l0_mla_k_norm, l0_mla_w_o, l0_ffn_norm, l0_ffn_w_gate, l0_ffn_w_up, l0_ffn_w_down,
              l1_attn_norm, l1_ca_w_qkv, l1_ca_q_norm, l1_ca_k_norm, l1_ca_rel_bias, l1_ca_w_o,
              l1_ffn_norm, l1_moe_router, l1_moe_w_gate, l1_moe_w_up, l1_moe_w_down,
              l2_attn_norm, l2_mla_w_in, l2_mla_q_a_norm, l2_mla_kv_a_norm, l2_mla_w_uq, l2_mla_w_ukv,
              l2_mla_q_norm, l2_mla_k_norm, l2_mla_w_o, l2_ffn_norm, l2_ffn_w_gate, l2_ffn_w_up, l2_ffn_w_down,
              l3_attn_norm, l3_ca_w_qkv, l3_ca_q_norm, l3_ca_k_norm, l3_ca_rel_bias, l3_ca_w_o,
              l3_ffn_norm, l3_moe_router, l3_moe_w_gate, l3_moe_w_up, l3_moe_w_down):
    attn_norms = (l0_attn_norm, l1_attn_norm, l2_attn_norm, l3_attn_norm)
    mixers = (
        (l0_mla_w_in, l0_mla_q_a_norm, l0_mla_kv_a_norm, l0_mla_w_uq, l0_mla_w_ukv, l0_mla_q_norm, l0_mla_k_norm, l0_mla_w_o),
        (l1_ca_w_qkv, l1_ca_q_norm, l1_ca_k_norm, l1_ca_rel_bias, l1_ca_w_o),
        (l2_mla_w_in, l2_mla_q_a_norm, l2_mla_kv_a_norm, l2_mla_w_uq, l2_mla_w_ukv, l2_mla_q_norm, l2_mla_k_norm, l2_mla_w_o),
        (l3_ca_w_qkv, l3_ca_q_norm, l3_ca_k_norm, l3_ca_rel_bias, l3_ca_w_o),
    )
    ffn_norms = (l0_ffn_norm, l1_ffn_norm, l2_ffn_norm, l3_ffn_norm)
    ffns = (
        (l0_ffn_w_gate, l0_ffn_w_up, l0_ffn_w_down),
        (l1_moe_router, l1_moe_w_gate, l1_moe_w_up, l1_moe_w_down),
        (l2_ffn_w_gate, l2_ffn_w_up, l2_ffn_w_down),
        (l3_moe_router, l3_moe_w_gate, l3_moe_w_up, l3_moe_w_down),
    )
    cos, sin = rope_angles(positions)
    for i in range(DEPTH):
        h = rmsnorm(x, attn_norms[i])
        if i % N_MIXERS == 0:
            x = x + mla_mixer(h, cos, sin, *mixers[i])
        else:
            x = x + chunked_band_mixer(h, *mixers[i])
        h = rmsnorm(x, ffn_norms[i])
        if i % FFN_PERIOD == 0:
            x = x + swiglu(h, *ffns[i])
        else:
            x = x + moe_ffn(h, *ffns[i])
    return x
```

```cpp
#include <hip/hip_runtime.h>
#include <cstdio>
#include <cstdint>

#ifndef MK_PER_PHASE
#define MK_PER_PHASE 0
#endif
#ifndef NAIVE_MASK
#define NAIVE_MASK 0x0
#endif
#ifndef MOE_FP8
#define MOE_FP8 1
#endif
#ifndef FFN8_MASK
#define FFN8_MASK 2
#endif
#ifndef QKV8_MASK
#define QKV8_MASK 3
#endif
#ifndef MLAUP8_MASK
#define MLAUP8_MASK 0
#endif
#ifndef IN8_MASK
#define IN8_MASK 0
#endif
#ifndef AO8_MASK
#define AO8_MASK 3
#endif
#ifndef BO8_MASK
#define BO8_MASK 3
#endif
#define HAS_G3(f, q) ((((AO8_MASK) & 1) == (f) && ((FFN8_MASK) & 1) == (q)) || ((((AO8_MASK) >> 1) & 1) == (f) && (((FFN8_MASK) >> 1) & 1) == (q)))
#define HAS_G5(f, q) ((((FFN8_MASK) & 1) == (f) && ((QKV8_MASK) & 1) == (q)) || ((((FFN8_MASK) >> 1) & 1) == (f) && (((QKV8_MASK) >> 1) & 1) == (q)))
#ifndef KL_PROBE
#define KL_PROBE 0
#endif
#ifndef MLA_PIPE
#define MLA_PIPE false
#endif
#ifndef BAND_PIPE
#define BAND_PIPE true
#endif
#ifndef NAIVE_ATTN
#define NAIVE_ATTN 0
#endif

#define GAS __attribute__((address_space(1)))
#define LAS __attribute__((address_space(3)))
typedef unsigned short bf16_t;
typedef short bf16x8 __attribute__((ext_vector_type(8)));
typedef short s16x4 __attribute__((ext_vector_type(4)));
typedef float f32x4 __attribute__((ext_vector_type(4)));
typedef float f32x2 __attribute__((ext_vector_type(2)));
typedef unsigned u32x4 __attribute__((ext_vector_type(4)));
typedef unsigned u32x2 __attribute__((ext_vector_type(2)));
typedef GAS unsigned gu32;

constexpr int T_ = 32768, DM = 1024, SEQ = 2048, NBATCH = 16, NCHK = 32;
constexpr float EPS = 1e-6f;
constexpr int MLA_H = 8, QKD = 192, NOPE = 128, ROPE = 64, VD = 128, QLORA = 256, KVLORA = 128, AIN = 448, AINP = 512;
constexpr int CA_H = 16, CA_D = 64, NREL = 320;
constexpr int FF = 2816, NE = 8, EFF = 3584;
constexpr int MAXROWS = 2 * T_ + NE * 256;

constexpr size_t MiB = 1u << 20;
constexpr size_t WS_CTL = 0, CTL_ZERO_BYTES = 1 * MiB;
constexpr size_t WS_ROUTE_E = 1 * MiB;
constexpr size_t WS_ROUTE_P = WS_ROUTE_E + (size_t)T_ * 8;
constexpr size_t WS_ROUTE_W = WS_ROUTE_P + (size_t)T_ * 8;
constexpr size_t WS_PERM = 2 * MiB;
constexpr size_t WS_W = 4 * MiB;
constexpr size_t WS_H = 184 * MiB;
constexpr size_t WS_BIG = 248 * MiB;
constexpr size_t WS_END = WS_BIG + 644 * MiB;
constexpr size_t WE_IN = 0, WE_O = 3 * MiB, WE_GU = 5 * MiB, WE_D = 16 * MiB, WE_QKVF = 22 * MiB;
constexpr size_t WS_CS = WS_W + 160 * MiB;
constexpr size_t WS_SSX = WS_W + 172 * MiB;
constexpr size_t WS_SSQ = WS_W + 170 * MiB;
constexpr size_t WO_QKV = 32 * MiB, WO_O = 38 * MiB, WO_GU = 40 * MiB, WO_D = 96 * MiB;
constexpr size_t B_A1 = 0, B_VM = 32 * MiB, B_QN = 256 * MiB, B_KN = 352 * MiB, B_OM = 448 * MiB;
constexpr size_t B_ACT = 0;
constexpr size_t B_CQ = 0, B_CK = 64 * MiB, B_CV = 128 * MiB, B_CO = 192 * MiB;
constexpr size_t B_Y = 512 * MiB;
static_assert(B_Y + (size_t)MAXROWS * 1024 * 2 <= 644 * MiB && (size_t)MAXROWS * EFF * 2 <= B_Y, "BIG map");
constexpr int CW_TMO = 0, CW_BAR = 4096, CW_CNT = 8192;

static_assert(MOE_FP8 == 1, "the odd-layer weight map (WO_*) is sized for fp8 expert weights");
constexpr int RING_BYTES = 131072, LDSCTL_OFF = RING_BYTES, MISC_OFF = LDSCTL_OFF + 320, LDS_BYTES = 147456;

#define RLX_AGENT __ATOMIC_RELAXED, __HIP_MEMORY_SCOPE_AGENT
#define LDS_WAIT() asm volatile("s_waitcnt lgkmcnt(0)" ::: "memory")
#define VM_WAIT() asm volatile("s_waitcnt vmcnt(0)" ::: "memory")
__device__ __forceinline__ float bf2f(unsigned b) { return __uint_as_float(b << 16); }
__device__ __forceinline__ unsigned f2bf(float f) { unsigned u = __float_as_uint(f); return (u + 0x7fffu + ((u >> 16) & 1u)) >> 16; }
__device__ __forceinline__ unsigned pk2(float lo, float hi) { return f2bf(lo) | (f2bf(hi) << 16); }
__device__ __forceinline__ unsigned cvt_pk_bf16(float lo, float hi) { unsigned r; asm volatile("v_cvt_pk_bf16_f32 %0, %1, %2" : "=v"(r) : "v"(lo), "v"(hi)); return r; }
template <int CTRL, int ROWMASK>
__device__ __forceinline__ float dpp_f(float v) { return __uint_as_float((unsigned)__builtin_amdgcn_update_dpp(0, (int)__float_as_uint(v), CTRL, ROWMASK, 0xF, false)); }
__device__ __forceinline__ float sum_x16_x32(float p) {
    const auto a = __builtin_amdgcn_permlane16_swap(__float_as_uint(p), __float_as_uint(p), false, false); p = __uint_as_float(a[0]) + __uint_as_float(a[1]);
    const auto b = __builtin_amdgcn_permlane32_swap(__float_as_uint(p), __float_as_uint(p), false, false); return __uint_as_float(b[0]) + __uint_as_float(b[1]);
}
__device__ __forceinline__ float wave_sum(float v) {
    v += dpp_f<0xB1, 0xF>(v); v += dpp_f<0x4E, 0xF>(v); v += dpp_f<0x141, 0xF>(v); v += dpp_f<0x140, 0xF>(v);
    v += dpp_f<0x142, 0xA>(v); v += dpp_f<0x143, 0xC>(v);
    return __uint_as_float((unsigned)__builtin_amdgcn_readlane((int)__float_as_uint(v), 63));
}
__device__ __forceinline__ float silu_f(float g) { return g * __builtin_amdgcn_rcpf(1.0f + __builtin_amdgcn_exp2f(g * -1.4426950408889634f)); }
__device__ __forceinline__ float swiglu_s(float g, float u, float c1  , float c2  ) { return (g * u) * (c2 * __builtin_amdgcn_rcpf(1.0f + __builtin_amdgcn_exp2f(g * c1))); }
__device__ __forceinline__ void swiglu8(const f32x4 g0, const f32x4 g1, const f32x4 u0, const f32x4 u1, const float c1, const float k, f32x4& o0, f32x4& o1) {
    const f32x4 t0 = g0 * c1, t1 = g1 * c1; f32x4 e0, e1, r0, r1;
#pragma unroll
    for (int j = 0; j < 4; ++j) { e0[j] = __builtin_amdgcn_exp2f(t0[j]); e1[j] = __builtin_amdgcn_exp2f(t1[j]); }
    const f32x4 d0 = e0 * k + k, d1 = e1 * k + k, p0 = g0 * u0, p1 = g1 * u1;
#pragma unroll
    for (int j = 0; j < 4; ++j) { r0[j] = __builtin_amdgcn_rcpf(d0[j]); r1[j] = __builtin_amdgcn_rcpf(d1[j]); }
    o0 = p0 * r0; o1 = p1 * r1;
}
__device__ __forceinline__ float clamp8(float x) { return __builtin_amdgcn_fmed3f(x, -448.0f, 448.0f); }
__device__ __forceinline__ unsigned pk4_fp8(float a, float b, float c, float d) {
    unsigned w = 0u; w = __builtin_amdgcn_cvt_pk_fp8_f32(clamp8(a), clamp8(b), w, false); w = __builtin_amdgcn_cvt_pk_fp8_f32(clamp8(c), clamp8(d), w, true); return w; }

#ifndef WT_STORES
#define WT_STORES 0
#endif
__device__ __forceinline__ void st16(void* p, u32x4 v) {
#if WT_STORES
    asm volatile("global_store_dwordx4 %0, %1, off sc1" :: "v"(p), "v"(v) : "memory");
#else
    *(u32x4*)p = v;
#endif
}
__device__ __forceinline__ void st8(void* p, u32x2 v) {
#if WT_STORES
    asm volatile("global_store_dwordx2 %0, %1, off sc1" :: "v"(p), "v"(v) : "memory");
#else
    *(u32x2*)p = v;
#endif
}
__device__ __forceinline__ void glds16_s(unsigned voff, const char* sbase, unsigned ldsaddr) { unsigned keep;
    asm volatile("s_mov_b32 %0, m0\n\ts_mov_b32 m0, %3\n\ts_nop 0\n\tglobal_load_lds_dwordx4 %1, %2\n\ts_mov_b32 m0, %0" : "=&s"(keep) : "v"(voff), "s"(sbase), "s"(ldsaddr) : "memory"); }

__device__ __forceinline__ void glds4_s(unsigned voff, const char* sbase, unsigned ldsaddr) { unsigned keep;
    asm volatile("s_mov_b32 %0, m0\n\ts_mov_b32 m0, %3\n\ts_nop 0\n\tglobal_load_lds_dword %1, %2\n\ts_mov_b32 m0, %0" : "=&s"(keep) : "v"(voff), "s"(sbase), "s"(ldsaddr) : "memory"); }

#define XB_TMO      128
#define XB_XCNT(j)  (256  + 64 * (j))
#define XB_XSUB(j)  (1280 + 64 * (j))
#define XB_XGEN(j)  (2304 + 64 * (j))
#define XB_TOP      3328
#define XB_TOPGEN   3392
#define XCD_BAR_WORDS 3456
#define XB_SPIN_CAP (1u << 18)
__device__ __forceinline__ unsigned xb_ld(unsigned* p)              { return __hip_atomic_load(p, __ATOMIC_RELAXED, __HIP_MEMORY_SCOPE_AGENT); }
__device__ __forceinline__ unsigned xb_add(unsigned* p, unsigned v) { return __hip_atomic_fetch_add(p, v, __ATOMIC_RELAXED, __HIP_MEMORY_SCOPE_AGENT); }
__device__ __forceinline__ unsigned xb_xcc_id() { return (unsigned)__builtin_amdgcn_s_getreg((3 << 11) | 20) & 0xFu; }
#define XB_SPIN(cond, bar) do { unsigned _sp = 0; while (cond) { __builtin_amdgcn_s_sleep(1); \
    if ((++_sp & 255u) == 0u) { if (xb_ld(&(bar)[XB_TMO])) break; if (_sp > XB_SPIN_CAP) { atomicAdd(&(bar)[XB_TMO], 1u); break; } } } } while (0)
struct XcdBarrier { unsigned* bar; unsigned x; volatile LAS unsigned* st; };
__device__ __forceinline__ XcdBarrier xcd_barrier_post(unsigned* bar, volatile LAS unsigned* st) {
    XcdBarrier b; b.bar = bar; b.x = xb_xcc_id(); b.st = st;
    if (threadIdx.x == 0) (void)xb_add(&bar[XB_XCNT(b.x)], 1u);
    return b;
}
__device__ __forceinline__ void xcd_barrier_complete(unsigned* bar, unsigned x, unsigned& nloc, unsigned& nx) {
    const unsigned G = gridDim.x * gridDim.y * gridDim.z;
    unsigned sum, cnt, mine, sp = 0u;
    for (;;) {
        sum = 0u; cnt = 0u; mine = 0u;
#pragma unroll
        for (unsigned j = 0; j < 16; ++j) { const unsigned c = xb_ld(&bar[XB_XCNT(j)]); sum += c; cnt += (c > 0u) ? 1u : 0u; mine = (j == x) ? c : mine; }
        if (sum == G) break;
        __builtin_amdgcn_s_sleep(1);
        if ((++sp & 255u) == 0u) { if (xb_ld(&bar[XB_TMO])) break; if (sp > XB_SPIN_CAP) { atomicAdd(&bar[XB_TMO], 1u); break; } }
    }
    nloc = mine > 0u ? mine : 1u; nx = cnt > 0u ? cnt : 1u;
}
__device__ __forceinline__ void xcd_barrier(const XcdBarrier& b, const int tid) {
    asm volatile("s_waitcnt vmcnt(0)" ::: "memory");
    __syncthreads();
    if (tid == 0) {
        unsigned* bar = b.bar;
        __builtin_amdgcn_s_waitcnt(0);
        unsigned nloc = b.st[0], nx = b.st[1];
        if (nloc == 0u) { xcd_barrier_complete(bar, b.x, nloc, nx); b.st[0] = nloc; b.st[1] = nx; }
        const unsigned old = xb_add(&bar[XB_XSUB(b.x)], 1u);
        const unsigned gen = old / nloc;
        if (old + 1u == (gen + 1u) * nloc) {
            __builtin_amdgcn_fence(__ATOMIC_RELEASE, "agent");
            asm volatile("s_waitcnt vmcnt(0)" ::: "memory");
            const unsigned og = xb_add(&bar[XB_TOP], 1u);
            const unsigned tg = og / nx;
            if (og + 1u == (tg + 1u) * nx) xb_add(&bar[XB_TOPGEN], 1u);
            else XB_SPIN(xb_ld(&bar[XB_TOPGEN]) == tg, bar);
            __builtin_amdgcn_fence(__ATOMIC_ACQUIRE, "agent");
            xb_add(&bar[XB_XGEN(b.x)], 1u);
            asm volatile("s_waitcnt vmcnt(0)" ::: "memory");
        } else {
            XB_SPIN(xb_ld(&bar[XB_XGEN(b.x)]) == gen, bar);
            __builtin_amdgcn_fence(__ATOMIC_ACQUIRE, "agent");
            asm volatile("s_waitcnt vmcnt(0)" ::: "memory");
        }
    }
    __syncthreads();
}

namespace pg8 {
constexpr int BM = 256, BK = 64, HALF = 128, HTB = HALF * BK * 2, STAGE_BYTES = 8 * HTB, NXCD = 8, WGM = 8;
__host__ __device__ __forceinline__ int lds_byte(int r, int c) { const int st = (r >> 4) * 2 + (c >> 5), rr = r & 15, cc = c & 31, ob = rr * 64 + cc * 2; return st * 1024 + (ob ^ (((ob >> 9) & 1) << 5)); }
__host__ __device__ __forceinline__ void stage_rc(int b, int& R, int& C) { const int st = b / 1024, sb = b % 1024, swz = sb ^ (((sb >> 9) & 1) << 5); R = (st >> 1) * 16 + swz / 64; C = (st & 1) * 32 + (swz % 64) / 2; }
__host__ __device__ __forceinline__ int perm32(int rho) { const int n = rho >> 4, i = rho & 15; return 8 * (i >> 2) + 4 * n + (i & 3); }

struct Unit { int pm, pn; };
typedef int v4i_t __attribute__((ext_vector_type(4)));
struct Gemm { const char* A; const char* Bt; int K, lda, ldb, es; unsigned sw, sa; int probe = 0; };

struct DenseOrder {
    int nM, nN, nwg, G, c;
    __device__ __forceinline__ void init(int nM_, int nN_, int G_, int c_) { nM = nM_; nN = nN_; nwg = nM * nN; G = G_; c = c_; }
    __device__ __forceinline__ bool next(int i, Unit& u) const {
        const long L = (long)i * G + c; if (L >= nwg) return false;
        int wgid = (int)L; { const int q = nwg / NXCD, r = nwg % NXCD, xcd = wgid % NXCD, off = wgid / NXCD; wgid = (xcd < r ? xcd * (q + 1) : r * (q + 1) + (xcd - r) * q) + off; }
        const int nig = WGM * nN, gid = wgid / nig, fm = gid * WGM, gsz = (nM - fm) < WGM ? (nM - fm) : WGM;
        u.pm = fm + ((wgid % nig) % gsz); u.pn = (wgid % nig) / gsz; return true;
    }
    __device__ __forceinline__ const char* a_base(const Gemm& g, const Unit& u) const { return g.A + (size_t)u.pm * 256 * g.lda * g.es; }
    __device__ __forceinline__ const char* b_base(const Gemm& g, const Unit& u) const { return g.Bt + (size_t)u.pn * 256 * g.ldb * g.es; }
    __device__ __forceinline__ const int* toklist(const Unit&) const { return nullptr; }
    __device__ __forceinline__ LAS unsigned* ofs() const { return nullptr; }
};
struct MoeInfo {
    int c0, c1, c2, c3, c4, c5, c6, c7;
    int s1, s2, s3, s4, s5, s6, s7, total;
    __device__ __forceinline__ void load(const gu32* cnt) {
        c0 = (int)__hip_atomic_load(cnt + 0 * 64, RLX_AGENT); c1 = (int)__hip_atomic_load(cnt + 1 * 64, RLX_AGENT); c2 = (int)__hip_atomic_load(cnt + 2 * 64, RLX_AGENT); c3 = (int)__hip_atomic_load(cnt + 3 * 64, RLX_AGENT);
        c4 = (int)__hip_atomic_load(cnt + 4 * 64, RLX_AGENT); c5 = (int)__hip_atomic_load(cnt + 5 * 64, RLX_AGENT); c6 = (int)__hip_atomic_load(cnt + 6 * 64, RLX_AGENT); c7 = (int)__hip_atomic_load(cnt + 7 * 64, RLX_AGENT);
        c0 = __builtin_amdgcn_readfirstlane(c0); c1 = __builtin_amdgcn_readfirstlane(c1); c2 = __builtin_amdgcn_readfirstlane(c2); c3 = __builtin_amdgcn_readfirstlane(c3);
        c4 = __builtin_amdgcn_readfirstlane(c4); c5 = __builtin_amdgcn_readfirstlane(c5); c6 = __builtin_amdgcn_readfirstlane(c6); c7 = __builtin_amdgcn_readfirstlane(c7);
        s1 = (c0 + 255) >> 8; s2 = s1 + ((c1 + 255) >> 8); s3 = s2 + ((c2 + 255) >> 8); s4 = s3 + ((c3 + 255) >> 8);
        s5 = s4 + ((c4 + 255) >> 8); s6 = s5 + ((c5 + 255) >> 8); s7 = s6 + ((c6 + 255) >> 8); total = s7 + ((c7 + 255) >> 8);
    }
    __device__ __forceinline__ int expert_of(int pm) const { return (pm >= s1) + (pm >= s2) + (pm >= s3) + (pm >= s4) + (pm >= s5) + (pm >= s6) + (pm >= s7); }
    __device__ __forceinline__ int start_of(int e) const { return e == 0 ? 0 : e == 1 ? s1 : e == 2 ? s2 : e == 3 ? s3 : e == 4 ? s4 : e == 5 ? s5 : e == 6 ? s6 : s7; }
    __device__ __forceinline__ int cnt_of(int e) const { return e == 0 ? c0 : e == 1 ? c1 : e == 2 ? c2 : e == 3 ? c3 : e == 4 ? c4 : e == 5 ? c5 : e == 6 ? c6 : c7; }
};
struct MoeOrder {
    static constexpr int TBN = 272;
    DenseOrder d; const int* perm; const LAS int* tb; bool gather;
    __device__ __forceinline__ bool next(int i, Unit& u) const { return d.next(i, u); }
    __device__ __forceinline__ const char* a_base(const Gemm& g, const Unit& u) const { return gather ? g.A : g.A + (size_t)u.pm * 256 * g.lda * g.es; }
    __device__ __forceinline__ const char* b_base(const Gemm& g, const Unit& u) const { const int e = __builtin_amdgcn_readfirstlane(tb[u.pm]); return g.Bt + ((size_t)e * d.nN + u.pn) * 256 * g.ldb * g.es; }
    __device__ __forceinline__ const int* toklist(const Unit& u) const { return perm + __builtin_amdgcn_readfirstlane(tb[2 * TBN + u.pm]); }
    __device__ __forceinline__ LAS unsigned* ofs() const { return (LAS unsigned*)(tb + 3 * TBN); }
};
__device__ __forceinline__ void moe_tables(const MoeInfo& mi, LAS int* tb, int tid) {
    if (tid < MoeOrder::TBN) { int e = 0, rem = 0, base = 0;
        if (tid < mi.total) { e = mi.expert_of(tid); const int lt = tid - mi.start_of(e); rem = mi.cnt_of(e) - lt * 256; base = e * T_ + lt * 256; }
        tb[tid] = e; tb[MoeOrder::TBN + tid] = rem; tb[2 * MoeOrder::TBN + tid] = base; }
    __syncthreads();
}

struct EpiStoreBf16 {
    static constexpr bool PERM = true, PREFETCH = false;
    bf16_t* O; int ldc; float scale;
    __device__ __forceinline__ void operator()(const f32x4 (&acc)[2][2][4][2], const Unit& u, int wr, int wc, int fr, int fq) const {
        const int row0 = u.pm * BM + wr * 64 + fr, col0 = u.pn * BM + wc * 32 + 8 * fq;
#pragma unroll
        for (int ai = 0; ai < 2; ++ai)
#pragma unroll
            for (int m = 0; m < 4; ++m) { bf16_t* rowp = O + (size_t)(row0 + ai * HALF + m * 16) * ldc + col0;
#pragma unroll
                for (int bj = 0; bj < 2; ++bj) { const f32x4 v0 = acc[ai][bj][m][0] * scale, v1 = acc[ai][bj][m][1] * scale;
                    u32x4 w; w.x = cvt_pk_bf16(v0[0], v0[1]); w.y = cvt_pk_bf16(v0[2], v0[3]); w.z = cvt_pk_bf16(v1[0], v1[1]); w.w = cvt_pk_bf16(v1[2], v1[3]);
                    st16(rowp + bj * HALF, w); } }
    }
};
struct EpiResid {
    static constexpr bool PERM = true, PREFETCH = false;
    float* X; int ldc; float scale;
    __device__ __forceinline__ void operator()(const f32x4 (&acc)[2][2][4][2], const Unit& u, int wr, int wc, int fr, int fq) const {
        const int row0 = u.pm * BM + wr * 64 + fr, col0 = u.pn * BM + wc * 32 + 8 * fq;
#pragma unroll
        for (int ai = 0; ai < 2; ++ai)
#pragma unroll
            for (int m = 0; m < 4; ++m) { float* rowp = X + (size_t)(row0 + ai * HALF + m * 16) * ldc + col0;
#pragma unroll
                for (int bj = 0; bj < 2; ++bj) { f32x4* p = (f32x4*)(rowp + bj * HALF); f32x4 a = p[0], b = p[1]; a += acc[ai][bj][m][0] * scale; b += acc[ai][bj][m][1] * scale; p[0] = a; p[1] = b; } }
    }
};
template <bool STATS, bool W8 = false>
struct EpiResid16 {
    static constexpr bool PERM = true, PREFETCH = false;
    const bf16_t* XBin; bf16_t* XB; float* ss; LAS float* P; float scale; unsigned char* X8 = nullptr;
    __device__ __forceinline__ void operator()(const f32x4 (&acc)[2][2][4][2], const Unit& u, int wr, int wc, int fr, int fq) const {
        const int col0 = u.pn * BM + wc * 32 + 8 * fq;
#pragma unroll
        for (int ai = 0; ai < 2; ++ai) { u32x4 xin[4][2];
#pragma unroll
            for (int m = 0; m < 4; ++m)
#pragma unroll
                for (int bj = 0; bj < 2; ++bj) xin[m][bj] = *(const u32x4*)(XBin + (size_t)(u.pm * BM + ai * HALF + wr * 64 + m * 16 + fr) * DM + col0 + bj * HALF);
#pragma unroll
            for (int m = 0; m < 4; ++m) { const int rl = ai * HALF + wr * 64 + m * 16 + fr; bf16_t* rowb = XB + (size_t)(u.pm * BM + rl) * DM + col0; float p = 0.f;
#pragma unroll
                for (int bj = 0; bj < 2; ++bj) { const u32x4 xi = xin[m][bj];
                    f32x4 a = (f32x4){bf2f(xi.x & 0xffffu), bf2f(xi.x >> 16), bf2f(xi.y & 0xffffu), bf2f(xi.y >> 16)}, b = (f32x4){bf2f(xi.z & 0xffffu), bf2f(xi.z >> 16), bf2f(xi.w & 0xffffu), bf2f(xi.w >> 16)};
                    a += acc[ai][bj][m][0] * scale; b += acc[ai][bj][m][1] * scale;
                    if constexpr (STATS) p += ((a[0] * a[0] + a[1] * a[1]) + (a[2] * a[2] + a[3] * a[3])) + ((b[0] * b[0] + b[1] * b[1]) + (b[2] * b[2] + b[3] * b[3]));
                    u32x4 w; w.x = cvt_pk_bf16(a[0], a[1]); w.y = cvt_pk_bf16(a[2], a[3]); w.z = cvt_pk_bf16(b[0], b[1]); w.w = cvt_pk_bf16(b[2], b[3]); st16(rowb + bj * HALF, w);
                    if constexpr (W8) { u32x2 w8; w8.x = pk4_fp8(a[0] * 8.0f, a[1] * 8.0f, a[2] * 8.0f, a[3] * 8.0f); w8.y = pk4_fp8(b[0] * 8.0f, b[1] * 8.0f, b[2] * 8.0f, b[3] * 8.0f); st8(X8 + (size_t)(u.pm * BM + rl) * DM + col0 + bj * HALF, w8); } }
                if constexpr (STATS) { p = sum_x16_x32(p); if (fq == 0) P[rl * 4 + wc] = p; } }
            asm volatile("" ::: "memory"); }
        if constexpr (STATS) {
            asm volatile("s_waitcnt lgkmcnt(0)" ::: "memory"); __builtin_amdgcn_s_barrier(); asm volatile("" ::: "memory");
            if (wc == 0 && fq == 0) {
#pragma unroll
                for (int ai = 0; ai < 2; ++ai)
#pragma unroll
                    for (int m = 0; m < 4; ++m) { const int rl = ai * HALF + wr * 64 + m * 16 + fr; const f32x4 p4 = *(const LAS f32x4*)(P + rl * 4);
                        ss[(size_t)(u.pm * BM + rl) * 4 + u.pn] = (p4[0] + p4[1]) + (p4[2] + p4[3]); } } }
    }
};
struct EpiSwiglu {
    static constexpr bool PERM = true, PREFETCH = true;
    bf16_t* O; int ldc; const float* ss; bool skip; LAS float* P;
    __device__ __forceinline__ void prefetch(const Unit& u, int wid, int lane) const {
        if (ss && wid < 4) glds16_s((unsigned)lane * 16u, (const char*)(ss + (size_t)(u.pm * BM + wid * 64) * 4), (unsigned)__builtin_amdgcn_readfirstlane((int)(unsigned)(uintptr_t)P) + (unsigned)wid * 1024u); }
    __device__ __forceinline__ void operator()(const f32x4 (&acc)[2][2][4][2], const Unit& u, int wr, int wc, int fr, int fq) const {
        if (skip) return;
        const int row0 = u.pm * BM + wr * 64 + fr, col0 = u.pn * HALF + wc * 32 + 8 * fq;
        float rs8[8], kv8[8];
        if (ss) {
#pragma unroll
            for (int r8 = 0; r8 < 8; ++r8) { const f32x4 s4 = *(const LAS f32x4*)(P + ((r8 >> 2) * HALF + wr * 64 + (r8 & 3) * 16 + fr) * 4); kv8[r8] = ((s4[0] + s4[1]) + (s4[2] + s4[3])) * (1.0f / DM) + EPS; rs8[r8] = rsqrtf(kv8[r8]); } }
        else {
#pragma unroll
            for (int r8 = 0; r8 < 8; ++r8) { rs8[r8] = 1.0f; kv8[r8] = 1.0f; } }
#pragma unroll
        for (int ai = 0; ai < 2; ++ai)
#pragma unroll
            for (int m = 0; m < 4; ++m) { bf16_t* rowp = O + (size_t)(row0 + ai * HALF + m * 16) * ldc + col0;
                const float rs = rs8[ai * 4 + m], kv = kv8[ai * 4 + m];
                f32x4 o0, o1; swiglu8(acc[ai][0][m][0], acc[ai][0][m][1], acc[ai][1][m][0], acc[ai][1][m][1], rs * -1.4426950408889634f, kv, o0, o1);
                u32x4 w; w.x = cvt_pk_bf16(o0[0], o0[1]); w.y = cvt_pk_bf16(o0[2], o0[3]); w.z = cvt_pk_bf16(o1[0], o1[1]); w.w = cvt_pk_bf16(o1[2], o1[3]);
                st16(rowp, w); }
    }
};
struct EpiSwiglu8 {
    static constexpr bool PERM = true, PREFETCH = false;
    unsigned char* O; int ldc; float iscale, oscale; bool skip;
    __device__ __forceinline__ void operator()(const f32x4 (&acc)[2][2][4][2], const Unit& u, int wr, int wc, int fr, int fq) const {
        if (skip) return;
        const int row0 = u.pm * BM + wr * 64 + fr, col0 = u.pn * HALF + wc * 32 + 8 * fq;
#pragma unroll
        for (int ai = 0; ai < 2; ++ai)
#pragma unroll
            for (int m = 0; m < 4; ++m) { unsigned char* rowp = O + (size_t)(row0 + ai * HALF + m * 16) * ldc + col0;
                const float c1 = iscale * -1.4426950408889634f, kk = 1.0f / (iscale * iscale * oscale);
                f32x4 o0, o1; swiglu8(acc[ai][0][m][0], acc[ai][0][m][1], acc[ai][1][m][0], acc[ai][1][m][1], c1, kk, o0, o1);
                u32x2 w; w.x = pk4_fp8(o0[0], o0[1], o0[2], o0[3]); w.y = pk4_fp8(o1[0], o1[1], o1[2], o1[3]);
                st8(rowp, w); }
    }
};
struct EpiSwiglu8R {
    static constexpr bool PERM = true, PREFETCH = true;
    unsigned char* O; int ldc; float iscale, oscale; const float* ss; LAS float* P;
    __device__ __forceinline__ void prefetch(const Unit& u, int wid, int lane) const {
        if (wid < 4) glds16_s((unsigned)lane * 16u, (const char*)(ss + (size_t)(u.pm * BM + wid * 64) * 4), (unsigned)__builtin_amdgcn_readfirstlane((int)(unsigned)(uintptr_t)P) + (unsigned)wid * 1024u); }
    __device__ __forceinline__ void operator()(const f32x4 (&acc)[2][2][4][2], const Unit& u, int wr, int wc, int fr, int fq) const {
        const int row0 = u.pm * BM + wr * 64 + fr, col0 = u.pn * HALF + wc * 32 + 8 * fq;
        float rs8[8], kv8[8]; const float ik = 1.0f / (iscale * iscale * oscale);
#pragma unroll
        for (int r8 = 0; r8 < 8; ++r8) { const f32x4 s4 = *(const LAS f32x4*)(P + ((r8 >> 2) * HALF + wr * 64 + (r8 & 3) * 16 + fr) * 4); const float var = ((s4[0] + s4[1]) + (s4[2] + s4[3])) * (1.0f / DM) + EPS; rs8[r8] = rsqrtf(var) * iscale; kv8[r8] = var * ik; }
#pragma unroll
        for (int ai = 0; ai < 2; ++ai)
#pragma unroll
            for (int m = 0; m < 4; ++m) { unsigned char* rowp = O + (size_t)(row0 + ai * HALF + m * 16) * ldc + col0;
                f32x4 o0, o1; swiglu8(acc[ai][0][m][0], acc[ai][0][m][1], acc[ai][1][m][0], acc[ai][1][m][1], rs8[ai * 4 + m] * -1.4426950408889634f, kv8[ai * 4 + m], o0, o1);
                u32x2 w; w.x = pk4_fp8(o0[0], o0[1], o0[2], o0[3]); w.y = pk4_fp8(o1[0], o1[1], o1[2], o1[3]);
                st8(rowp, w); }
    }
};
template <bool OUT8 = false>
struct EpiA1 {
    static constexpr bool PERM = true, PREFETCH = true;
    bf16_t* O; int ldc; float* ss; const float* ssin; LAS float* P; float iscale = 1.0f;
    __device__ __forceinline__ void prefetch(const Unit& u, int wid, int lane) const {
        if (wid < 4) glds16_s((unsigned)lane * 16u, (const char*)(ssin + (size_t)(u.pm * BM + wid * 64) * 4), (unsigned)__builtin_amdgcn_readfirstlane((int)(unsigned)(uintptr_t)P) + (unsigned)wid * 1024u); }
    __device__ __forceinline__ void operator()(const f32x4 (&acc)[2][2][4][2], const Unit& u, int wr, int wc, int fr, int fq) const {
        const int row0 = u.pm * BM + wr * 64 + fr, col0 = u.pn * BM + wc * 32 + 8 * fq;
        float rs8[8];
#pragma unroll
        for (int r8 = 0; r8 < 8; ++r8) { const f32x4 s4 = *(const LAS f32x4*)(P + ((r8 >> 2) * HALF + wr * 64 + (r8 & 3) * 16 + fr) * 4); rs8[r8] = rsqrtf(((s4[0] + s4[1]) + (s4[2] + s4[3])) * (1.0f / DM) + EPS) * iscale; }
        float* sp = ss + (size_t)u.pn * T_ * 4 + wc;
#pragma unroll
        for (int ai = 0; ai < 2; ++ai)
#pragma unroll
            for (int m = 0; m < 4; ++m) { const int row = row0 + ai * HALF + m * 16; bf16_t* rowp = O + (size_t)row * ldc + col0; float p = 0.f;
#pragma unroll
                for (int bj = 0; bj < 2; ++bj) { const float rs = rs8[ai * 4 + m]; const f32x4 v0 = acc[ai][bj][m][0] * rs, v1 = acc[ai][bj][m][1] * rs;
                    if (bj == 0 || u.pn == 0) p += ((v0[0] * v0[0] + v0[1] * v0[1]) + (v0[2] * v0[2] + v0[3] * v0[3])) + ((v1[0] * v1[0] + v1[1] * v1[1]) + (v1[2] * v1[2] + v1[3] * v1[3]));
                    if constexpr (OUT8) { u32x2 w8; w8.x = pk4_fp8(v0[0] * 16.0f, v0[1] * 16.0f, v0[2] * 16.0f, v0[3] * 16.0f); w8.y = pk4_fp8(v1[0] * 16.0f, v1[1] * 16.0f, v1[2] * 16.0f, v1[3] * 16.0f);
                        *(u32x2*)((unsigned char*)O + (size_t)row * ldc + col0 + bj * HALF) = w8; }
                    else { u32x4 w; w.x = cvt_pk_bf16(v0[0], v0[1]); w.y = cvt_pk_bf16(v0[2], v0[3]); w.z = cvt_pk_bf16(v1[0], v1[1]); w.w = cvt_pk_bf16(v1[2], v1[3]);
                    *(u32x4*)(rowp + bj * HALF) = w; } }
                p = sum_x16_x32(p);
                if (fq == 0) sp[(size_t)row * 4] = p; }
    }
};
struct EpiMlaQKV {
    static constexpr bool PERM = true, PREFETCH = true;
    LAS float* SS4;
    __device__ __forceinline__ void prefetch(const Unit& u, int wid, int lane) const {
        if (wid < 4) { const float* ssp = ss + (u.pn < 8 ? (size_t)0 : (size_t)T_ * 4);
            glds16_s((unsigned)lane * 16u, (const char*)(ssp + (size_t)(u.pm * BM + wid * 64) * 4), (unsigned)__builtin_amdgcn_readfirstlane((int)(unsigned)(uintptr_t)SS4) + (unsigned)wid * 1024u);
            glds4_s((unsigned)lane * 4u, (const char*)(positions + u.pm * BM + wid * 64), (unsigned)__builtin_amdgcn_readfirstlane((int)(unsigned)(uintptr_t)(P + 1280)) + (unsigned)wid * 256u); } }
    bf16_t* QN; size_t kn_off; bf16_t* VM; const float* ss; const float* gq; const float* gk; const int* positions; LAS float* P; float iscale = 1.0f; bool nostore = false;
    __device__ __forceinline__ void operator()(const f32x4 (&acc)[2][2][4][2], const Unit& u, int wr, int wc, int fr, int fq) const {
        asm volatile("" : "+v"(fr), "+v"(fq));
        const int pn = u.pn, row0 = u.pm * BM + wr * 64 + fr;
        if (pn >= 16) {
#pragma unroll
            for (int ai = 0; ai < 2; ++ai) { f32x4 s4[4];
#pragma unroll
                for (int m = 0; m < 4; ++m) s4[m] = *(const LAS f32x4*)(SS4 + (ai * HALF + wr * 64 + m * 16 + fr) * 4);
#pragma unroll
                for (int m = 0; m < 4; ++m) { const int row = row0 + ai * HALF + m * 16;
                    const float rs = rsqrtf(((s4[m][0] + s4[m][1]) + (s4[m][2] + s4[m][3])) * (1.0f / KVLORA) + EPS) * iscale;
                    const int sq_ = row & (SEQ - 1), bb_ = row >> 11;
                    bf16_t* rowp = VM + ((size_t)((bb_ * MLA_H + 2 * (pn - 16)) * NCHK + (sq_ >> 6)) * 16 + wc * 4 + ((sq_ >> 4) & 3)) * 512 + (sq_ & 15) * 32 + 8 * fq;
#pragma unroll
                    for (int bj = 0; bj < 2; ++bj) { const f32x4 v0 = acc[ai][bj][m][0] * rs, v1 = acc[ai][bj][m][1] * rs;
                        u32x4 w; w.x = cvt_pk_bf16(v0[0], v0[1]); w.y = cvt_pk_bf16(v0[2], v0[3]); w.z = cvt_pk_bf16(v1[0], v1[1]); w.w = cvt_pk_bf16(v1[2], v1[3]);
                        if (!nostore) *(u32x4*)(rowp + (size_t)bj * (NCHK * 16 * 512)) = w; } }
                asm volatile("" ::: "memory"); }
            asm volatile("s_waitcnt lgkmcnt(0)" ::: "memory"); __builtin_amdgcn_s_barrier(); asm volatile("" ::: "memory");
            return;
        }
        const bool isq = pn < 8; const int h = isq ? pn : pn - 8;
        const float invn = isq ? 1.0f / QLORA : 1.0f / KVLORA;
        LAS float* RS = P + 1024; LAS int* POS = (LAS int*)(P + 1280);
#pragma unroll
        for (int ai = 0; ai < 2; ++ai) { f32x4 s4[4];
#pragma unroll
            for (int m = 0; m < 4; ++m) s4[m] = *(const LAS f32x4*)(SS4 + (ai * HALF + wr * 64 + m * 16 + fr) * 4);
#pragma unroll
            for (int m = 0; m < 4; ++m) { const float rs = rsqrtf(((s4[m][0] + s4[m][1]) + (s4[m][2] + s4[m][3])) * invn + EPS) * iscale, rr = isq ? rs : iscale;
                const f32x4 a0 = acc[ai][0][m][0], a1 = acc[ai][0][m][1], b0 = acc[ai][1][m][0], b1 = acc[ai][1][m][1];
                float p = (((a0[0] * a0[0] + a0[1] * a0[1]) + (a0[2] * a0[2] + a0[3] * a0[3])) + ((a1[0] * a1[0] + a1[1] * a1[1]) + (a1[2] * a1[2] + a1[3] * a1[3]))) * (rs * rs)
                        + (((b0[0] * b0[0] + b0[1] * b0[1]) + (b0[2] * b0[2] + b0[3] * b0[3])) + ((b1[0] * b1[0] + b1[1] * b1[1]) + (b1[2] * b1[2] + b1[3] * b1[3]))) * (rr * rr);
                p = sum_x16_x32(p);
                const int rl = ai * HALF + wr * 64 + m * 16 + fr;
                if (fq == 0) { P[rl * 4 + wc] = p; if (wc == 0) RS[rl] = rs; } }
            asm volatile("" ::: "memory"); }
        asm volatile("s_waitcnt lgkmcnt(0)" ::: "memory"); __builtin_amdgcn_s_barrier(); asm volatile("" ::: "memory");
        f32x4 gn[2], g1, g2;
        const LAS float* GL = SS4 + 1024 + (isq ? 0 : 192);
#pragma unroll
        for (int n = 0; n < 2; ++n) gn[n] = *(const LAS f32x4*)(GL + wc * 32 + 8 * fq + 4 * n);
        const int ib = (wc & 1) * 16 + 4 * fq;
        g1 = *(const LAS f32x4*)(GL + NOPE + ib); g2 = *(const LAS f32x4*)(GL + NOPE + 32 + ib);
        float irev[4];
#pragma unroll
        for (int j = 0; j < 4; ++j) irev[j] = __builtin_amdgcn_exp2f(-(float)(ib + j) * (13.287712379549449f / 32.0f)) * 0.15915494309189535f;
        bf16_t* Ob = QN + (isq ? (size_t)0 : kn_off) + h * QKD;
#pragma unroll
        for (int ai = 0; ai < 2; ++ai)
#pragma unroll
            for (int m = 0; m < 4; ++m) { const int rl = ai * HALF + wr * 64 + m * 16 + fr, row = u.pm * BM + rl; const f32x4 p4 = *(const LAS f32x4*)(P + rl * 4);
                const float rs = RS[rl];
                const float rinv = rsqrtf(((p4[0] + p4[1]) + (p4[2] + p4[3])) * (1.0f / QKD) + EPS), fn = rs * rinv, fr_ = (isq ? rs : iscale) * rinv;
                const int sq_ = row & (SEQ - 1); bf16_t* kt_ = QN + kn_off + ((size_t)((row >> 11) * MLA_H + h) * NCHK + (sq_ >> 6)) * (24 * 512) + (sq_ & 63) * 8;
                bf16_t* rowp = Ob + (size_t)row * (MLA_H * QKD);
                { const f32x4 v0 = acc[ai][0][m][0] * fn * gn[0], v1 = acc[ai][0][m][1] * fn * gn[1];
                  u32x4 w; w.x = cvt_pk_bf16(v0[0], v0[1]); w.y = cvt_pk_bf16(v0[2], v0[3]); w.z = cvt_pk_bf16(v1[0], v1[1]); w.w = cvt_pk_bf16(v1[2], v1[3]);
                  if (!nostore) { if (isq) *(u32x4*)(rowp + wc * 32 + 8 * fq) = w; else *(u32x4*)(kt_ + (4 * wc + fq) * 512) = w; } }
                if (wc < 2) { const float pos = (float)POS[rl]; float cs_[4], sn_[4];
#pragma unroll
                    for (int j = 0; j < 4; ++j) { const float rev = __builtin_amdgcn_fractf(pos * irev[j]); cs_[j] = __builtin_amdgcn_cosf(rev); sn_[j] = __builtin_amdgcn_sinf(rev); }
                    const f32x4 b0 = acc[ai][1][m][0] * fr_, b1 = acc[ai][1][m][1] * fr_;
                    const float x10 = b0[0] * g1[0], x20 = b0[1] * g2[0], x11 = b0[2] * g1[1], x21 = b0[3] * g2[1], x12 = b1[0] * g1[2], x22 = b1[1] * g2[2], x13 = b1[2] * g1[3], x23 = b1[3] * g2[3];
                    u32x2 o1, o2;
                    o1.x = cvt_pk_bf16(x10 * cs_[0] - x20 * sn_[0], x11 * cs_[1] - x21 * sn_[1]); o1.y = cvt_pk_bf16(x12 * cs_[2] - x22 * sn_[2], x13 * cs_[3] - x23 * sn_[3]);
                    o2.x = cvt_pk_bf16(x10 * sn_[0] + x20 * cs_[0], x11 * sn_[1] + x21 * cs_[1]); o2.y = cvt_pk_bf16(x12 * sn_[2] + x22 * cs_[2], x13 * sn_[3] + x23 * cs_[3]);
                    if (nostore) {} else if (isq) { *(u32x2*)(rowp + NOPE + ib) = o1; *(u32x2*)(rowp + NOPE + 32 + ib) = o2; }
                    else { bf16_t* kr_ = kt_ + (16 + 2 * wc + (fq >> 1)) * 512 + 4 * (fq & 1); *(u32x2*)kr_ = o1; *(u32x2*)(kr_ + 4 * 512) = o2; } }
            }
    }
};
struct MlaOrder {
    DenseOrder d;
    __device__ __forceinline__ bool next(int i, Unit& u) const { return d.next(i, u); }
    __device__ __forceinline__ const char* a_base(const Gemm& g, const Unit& u) const { return g.A + (size_t)u.pm * 256 * g.lda * g.es + (u.pn >= 8 ? 256 * g.es : 0); }
    __device__ __forceinline__ const char* b_base(const Gemm& g, const Unit& u) const { return g.Bt + (size_t)u.pn * 256 * g.ldb * g.es; }
    __device__ __forceinline__ const int* toklist(const Unit&) const { return nullptr; }
    __device__ __forceinline__ LAS unsigned* ofs() const { return nullptr; }
};
struct EpiQkvNorm {
    static constexpr bool PERM = true, PREFETCH = true;
    LAS float* P; LAS float* GL;
    __device__ __forceinline__ void prefetch(const Unit& u, int wid, int lane) const {
        if (wid < 4) glds16_s((unsigned)lane * 16u, (const char*)(ss + (size_t)(u.pm * BM + wid * 64) * 4), (unsigned)__builtin_amdgcn_readfirstlane((int)(unsigned)(uintptr_t)P) + (unsigned)wid * 1024u); }
    bf16_t* Q; size_t sect_stride; const float *gq, *gk; const float* ss; float iscale = 1.0f;
    __device__ __forceinline__ void operator()(const f32x4 (&acc)[2][2][4][2], const Unit& u, int wr, int wc, int fr, int fq) const {
        const int sect = u.pn >> 2, head = 4 * (u.pn & 3) + wc;
        bf16_t* O = Q + (size_t)sect * sect_stride + head * 64 + 8 * fq;
        f32x4 g[2][2], ga[2][2], gb[2][2];
#pragma unroll
        for (int bj = 0; bj < 2; ++bj)
#pragma unroll
            for (int n = 0; n < 2; ++n) { ga[bj][n] = *(const LAS f32x4*)(GL + 8 * fq + 32 * bj + 4 * n); gb[bj][n] = *(const LAS f32x4*)(GL + 192 + 8 * fq + 32 * bj + 4 * n); }
        const int row0 = u.pm * BM + wr * 64 + fr;
        float rs8[8];
#pragma unroll
        for (int r8 = 0; r8 < 8; ++r8) { const f32x4 s4 = *(const LAS f32x4*)(P + ((r8 >> 2) * HALF + wr * 64 + (r8 & 3) * 16 + fr) * 4); rs8[r8] = rsqrtf(((s4[0] + s4[1]) + (s4[2] + s4[3])) * (1.0f / DM) + EPS) * iscale; }
#pragma unroll
        for (int bj = 0; bj < 2; ++bj)
#pragma unroll
            for (int n = 0; n < 2; ++n) g[bj][n] = sect == 0 ? ga[bj][n] : (sect == 1 ? gb[bj][n] : (f32x4){1.f, 1.f, 1.f, 1.f});
#pragma unroll
        for (int ai = 0; ai < 2; ++ai)
#pragma unroll
            for (int m = 0; m < 4; ++m) {
                float hs = 0.f;
#pragma unroll
                for (int bj = 0; bj < 2; ++bj)
#pragma unroll
                    for (int n = 0; n < 2; ++n) { const f32x4 x = acc[ai][bj][m][n]; hs += (x[0] * x[0] + x[1] * x[1]) + (x[2] * x[2] + x[3] * x[3]); }
                hs = sum_x16_x32(hs);
                const float rs = rs8[ai * 4 + m];
                const float rinv = sect < 2 ? rs * rsqrtf(hs * rs * rs * (1.0f / 64.0f) + EPS) : rs;
                const int row = row0 + ai * HALF + m * 16, sq_ = row & (SEQ - 1);
                bf16_t* rowp = O + (size_t)row * DM;
                bf16_t* tb_ = Q + (size_t)sect * sect_stride + ((size_t)((row >> 11) * CA_H + head) * NCHK + (sq_ >> 6)) * (8 * 512);
#pragma unroll
                for (int bj = 0; bj < 2; ++bj) { const f32x4 v0 = acc[ai][bj][m][0] * rinv * g[bj][0], v1 = acc[ai][bj][m][1] * rinv * g[bj][1];
                    u32x4 w; w.x = cvt_pk_bf16(v0[0], v0[1]); w.y = cvt_pk_bf16(v0[2], v0[3]); w.z = cvt_pk_bf16(v1[0], v1[1]); w.w = cvt_pk_bf16(v1[2], v1[3]);
                    if (sect == 0) st16(rowp + 32 * bj, w);
                    else if (sect == 1) st16(tb_ + (4 * bj + fq) * 512 + (sq_ & 63) * 8, w);
                    else st16(tb_ + (4 * bj + ((sq_ >> 4) & 3)) * 512 + (sq_ & 15) * 32 + 8 * fq, w); }
            }
    }
};

template <class Epi, class Sched, bool GATHER, bool FP8 = false>
__device__ __forceinline__ void gemm_phase(LAS unsigned char* lds, const int wid, const Gemm g, const Sched& S, const Epi& E) {
    const int wr = wid >> 2, wc = wid & 3;
    constexpr unsigned ES = FP8 ? 1u : 2u;
    const int K = g.K, nt = FP8 ? K / (2 * BK) : K / BK;
    int tid, fr, fq, aoff, boff; unsigned voffB[2], cvA0[2], cvA1[2];
#define PG8_LANE(SETA) do { unsigned z_ = 0u; asm volatile("" : "+v"(z_)); const int lane_ = (int)__builtin_amdgcn_mbcnt_hi(~0u, __builtin_amdgcn_mbcnt_lo(~0u, z_)); \
        tid = wid * 64 + lane_; fr = lane_ & 15; fq = lane_ >> 4; aoff = lds_byte(wr * 64 + fr, fq * 8); boff = lds_byte(wc * 32 + fr, fq * 8); \
        _Pragma("unroll") for (int i = 0; i < 2; ++i) { int R, C; stage_rc(tid * 16 + i * 8192, R, C); const int Rb = Epi::PERM ? ((R & ~31) + perm32(R & 31)) : R; \
            voffB[i] = (unsigned)(Rb * g.ldb) * ES + (unsigned)C * 2u; if (SETA) { cvA0[i] = (unsigned)(R * g.lda) * ES + (unsigned)C * 2u; cvA1[i] = cvA0[i]; } } } while (0)
    PG8_LANE(true);
    const size_t kstep = (size_t)(BK * 2);
    const size_t hstepB = (size_t)HALF * g.ldb * ES;
    const size_t hstepA = GATHER ? (size_t)0 : (size_t)HALF * g.lda * ES;
    const unsigned ldsw = (unsigned)wid * 1024u;
    const unsigned ldsbase = (unsigned)__builtin_amdgcn_readfirstlane((int)(unsigned)(uintptr_t)lds) + ldsw;
#define PG8_SA(b, h) (((b) * 2 + (h)) * HTB)
#define PG8_SB(b, h) ((4 + (b) * 2 + (h)) * HTB)
#define PG8_STAGE(bufoff, gbase, voff) do { if (KL_PROBE && g.probe == 2) break; _Pragma("unroll") for (int _i = 0; _i < 2; ++_i) { unsigned keep_; \
        asm volatile("s_mov_b32 %0, m0\n\ts_mov_b32 m0, %3\n\ts_nop 0\n\tglobal_load_lds_dwordx4 %1, %2\n\ts_mov_b32 m0, %0" \
                     : "=&s"(keep_) : "v"((voff)[_i]), "s"((const char*)(gbase)), "s"(ldsbase + (unsigned)((bufoff) + _i * 8192)) : "memory"); } } while (0)
#define PG8_LDA(dst, b, h) do { _Pragma("unroll") for (int m = 0; m < 4; ++m) _Pragma("unroll") for (int k = 0; k < 2; ++k) dst[m][k] = *(const LAS bf16x8*)(lds + PG8_SA(b, h) + aoff + m * 2048 + k * 1024); } while (0)
#define PG8_LDB(dst, b, h) do { _Pragma("unroll") for (int n = 0; n < 2; ++n) _Pragma("unroll") for (int k = 0; k < 2; ++k) dst[n][k] = *(const LAS bf16x8*)(lds + PG8_SB(b, h) + boff + n * 2048 + k * 1024); } while (0)
#define PG8_CAT(x0, x1) __builtin_shufflevector(__builtin_bit_cast(v4i_t, x0), __builtin_bit_cast(v4i_t, x1), 0, 1, 2, 3, 4, 5, 6, 7)
#define PG8_MMA(ai, bj, At, Bt) do { if (KL_PROBE && g.probe == 1) break; __builtin_amdgcn_s_setprio(1); if constexpr (FP8) { _Pragma("unroll") for (int m = 0; m < 4; ++m) _Pragma("unroll") for (int n = 0; n < 2; ++n) \
        asm("v_mfma_f32_16x16x128_f8f6f4 %0, %1, %2, %0" : "+v"(acc[ai][bj][m][n]) : "v"(PG8_CAT(Bt[n][0], Bt[n][1])), "v"(PG8_CAT(At[m][0], At[m][1]))); } else { \
        _Pragma("unroll") for (int m = 0; m < 4; ++m) _Pragma("unroll") for (int n = 0; n < 2; ++n) _Pragma("unroll") for (int k = 0; k < 2; ++k) \
        acc[ai][bj][m][n] = __builtin_amdgcn_mfma_f32_16x16x32_bf16(Bt[n][k], At[m][k], acc[ai][bj][m][n], 0, 0, 0); } __builtin_amdgcn_s_setprio(0); } while (0)
#define PG8_WAIT_V(n) asm volatile("s_waitcnt vmcnt(" #n ")" ::: "memory")
#define PG8_WAIT_L(n) asm volatile("s_waitcnt lgkmcnt(" #n ")" ::: "memory")
#define PG8_BAR __builtin_amdgcn_s_barrier()
#define PG8_SCHED __builtin_amdgcn_sched_barrier(0)
#define PG8_TOKC(x) ((unsigned)(x) < (unsigned)T_ ? (unsigned)(x) : 0u)
#define PG8_GOFF_G(u, o0, o1) do { const int* tl_ = S.toklist(u); _Pragma("unroll") for (int _i = 0; _i < 2; ++_i) { int R_, C_; stage_rc(tid * 16 + _i * 8192, R_, C_); \
        o0[_i] = PG8_TOKC(tl_[R_]) * (unsigned)g.lda * ES + (unsigned)C_ * 2u; o1[_i] = PG8_TOKC(tl_[HALF + R_]) * (unsigned)g.lda * ES + (unsigned)C_ * 2u; } } while (0)
#define PG8_GOFF_L(par, o0, o1) do { const LAS unsigned* tl_ = S.ofs() + (par) * 256; _Pragma("unroll") for (int _i = 0; _i < 2; ++_i) { int R_, C_; stage_rc(tid * 16 + _i * 8192, R_, C_); \
        o0[_i] = PG8_TOKC(tl_[R_]) * (unsigned)g.lda * ES + (unsigned)C_ * 2u; o1[_i] = PG8_TOKC(tl_[HALF + R_]) * (unsigned)g.lda * ES + (unsigned)C_ * 2u; } } while (0)
    Unit cur, nxt; int ui = 0;
    if (!S.next(0, cur)) return;
    f32x4 acc[2][2][4][2];
#pragma unroll
    for (int a = 0; a < 2; ++a)
#pragma unroll
        for (int b = 0; b < 2; ++b)
#pragma unroll
            for (int m = 0; m < 4; ++m)
#pragma unroll
                for (int n = 0; n < 2; ++n) acc[a][b][m][n] = (f32x4){0.f, 0.f, 0.f, 0.f};
    bf16x8 At[4][2], B0[2][2], B1[2][2];
    const char* cA = S.a_base(g, cur); const char* cB = S.b_base(g, cur);
    if constexpr (GATHER) { PG8_GOFF_G(cur, cvA0, cvA1); }
    PG8_STAGE(PG8_SB(0, 0), cB, voffB); PG8_STAGE(PG8_SB(0, 1), cB + hstepB, voffB); PG8_STAGE(PG8_SA(0, 0), cA, cvA0); PG8_STAGE(PG8_SA(0, 1), cA + hstepA, cvA1);
    if (wr == 1) PG8_BAR;
    PG8_WAIT_V(2); PG8_BAR;
    PG8_STAGE(PG8_SB(1, 0), cB + kstep, voffB); PG8_STAGE(PG8_SA(1, 0), cA + kstep, cvA0); PG8_STAGE(PG8_SB(1, 1), cB + hstepB + kstep, voffB);
    PG8_WAIT_V(6); PG8_BAR;
    for (;;) {
        const bool has_next = S.next(ui + 1, nxt);
        const char* nA = has_next ? S.a_base(g, nxt) : cA; const char* nB = has_next ? S.b_base(g, nxt) : cB;
        if constexpr (GATHER) { if (has_next && wid < 4) {
            unsigned keep_; const unsigned dst_ = (unsigned)__builtin_amdgcn_readfirstlane((int)(unsigned)(uintptr_t)S.ofs()) + (unsigned)(((ui + 1) & 1) * 1024 + wid * 256);
            asm volatile("s_mov_b32 %0, m0\n\ts_mov_b32 m0, %3\n\ts_nop 0\n\tglobal_load_lds_dword %1, %2\n\ts_mov_b32 m0, %0"
                         : "=&s"(keep_) : "v"((unsigned)tid * 4u), "s"((const char*)S.toklist(nxt)), "s"(dst_) : "memory"); } }
        for (int t = 0; t < nt; t += 2) {
            const bool last = (t == nt - 2);
            const char* a1 = cA + (size_t)(t + 1) * kstep;
            const char* a2 = last ? nA : cA + (size_t)(t + 2) * kstep; const char* b2 = last ? nB : cB + (size_t)(t + 2) * kstep;
            const char* a3 = a2 + kstep; const char* b3 = b2 + kstep;
            if constexpr (Epi::PREFETCH) { if (last) E.prefetch(cur, wid, tid & 63); }
            PG8_LDB(B0, 0, 0); PG8_LDB(B1, 0, 1); PG8_SCHED; PG8_LDA(At, 0, 0); PG8_STAGE(PG8_SA(1, 1), a1 + hstepA, cvA1);
            if constexpr (GATHER) { if (last && has_next) { PG8_GOFF_L((ui + 1) & 1, cvA0, cvA1); } }
            PG8_WAIT_V(8); PG8_WAIT_L(0); PG8_BAR; PG8_MMA(0, 0, At, B0); PG8_MMA(0, 1, At, B1); PG8_BAR; PG8_SCHED;
            PG8_LDA(At, 0, 1); PG8_STAGE(PG8_SB(0, 0), b2, voffB); PG8_STAGE(PG8_SB(0, 1), b2 + hstepB, voffB); PG8_STAGE(PG8_SA(0, 0), a2, cvA0);
            PG8_WAIT_V(8); PG8_WAIT_L(0); PG8_BAR; PG8_MMA(1, 0, At, B0); PG8_MMA(1, 1, At, B1); PG8_BAR; PG8_SCHED;
            PG8_LDB(B0, 1, 0); PG8_LDB(B1, 1, 1); PG8_SCHED; PG8_LDA(At, 1, 0); PG8_STAGE(PG8_SA(0, 1), a2 + hstepA, cvA1);
            PG8_WAIT_V(8); PG8_WAIT_L(0); PG8_BAR; PG8_MMA(0, 0, At, B0); PG8_MMA(0, 1, At, B1); PG8_BAR; PG8_SCHED;
            PG8_LDA(At, 1, 1); PG8_STAGE(PG8_SB(1, 0), b3, voffB); PG8_STAGE(PG8_SB(1, 1), b3 + hstepB, voffB); PG8_STAGE(PG8_SA(1, 0), a3, cvA0);
            PG8_WAIT_V(8); PG8_WAIT_L(0); PG8_BAR; PG8_MMA(1, 0, At, B0); PG8_MMA(1, 1, At, B1); PG8_BAR; PG8_SCHED;
        }
        if (wr == 0) PG8_BAR;
        if constexpr (FP8) asm volatile("s_nop 15\n\ts_nop 7" ::: "memory");
        E(acc, cur, wr, wc, fr, fq);
        if (!has_next) break;
        PG8_LANE(!GATHER);
#pragma unroll
        for (int a = 0; a < 2; ++a)
#pragma unroll
            for (int b = 0; b < 2; ++b)
#pragma unroll
                for (int m = 0; m < 4; ++m)
#pragma unroll
                    for (int n = 0; n < 2; ++n) acc[a][b][m][n] = (f32x4){0.f, 0.f, 0.f, 0.f};
        cur = nxt; cA = nA; cB = nB; ++ui;
        if (wr == 1) PG8_BAR;
    }
    PG8_WAIT_V(0);
    PG8_BAR;
#undef PG8_SA
#undef PG8_SB
#undef PG8_STAGE
#undef PG8_LDA
#undef PG8_LDB
#undef PG8_MMA
#undef PG8_CAT
#undef PG8_WAIT_V
#undef PG8_WAIT_L
#undef PG8_BAR
#undef PG8_SCHED
#undef PG8_LANE
#undef PG8_GOFF_G
#undef PG8_GOFF_L
#undef PG8_TOKC
}
}

struct Frame { LAS unsigned char* lds; int tid, lane, wave, vcu, G, gw, NGW; };

typedef float f32x4n __attribute__((ext_vector_type(4)));
template <bool DUAL, class RowFn, class WFn, class EpiFn>
__device__ __forceinline__ void naive_gemm(const Frame& F, int nRowTiles, int N, int K, const bf16_t* A, int lda, RowFn rowfn, WFn wfn, int ldb, EpiFn epi) {
    LAS bf16_t* sA = (LAS bf16_t*)F.lds; LAS bf16_t* sB1 = sA + 64 * 40; LAS bf16_t* sB2 = sB1 + 64 * 40;
    const int ntn = N / 64, tiles = nRowTiles * ntn, wm = F.wave & 1, wn = F.wave >> 1, l15 = F.lane & 15, quad = F.lane >> 4;
    for (int tile = F.vcu; tile < tiles; tile += F.G) {
        const int mt = tile / ntn, n0 = (tile % ntn) * 64;
        const float* B1; const float* B2; wfn(mt, B1, B2);
        const int ar = F.tid >> 3, ak = (F.tid & 7) * 4; const int srow = rowfn(mt * 64 + ar); const bf16_t* arow = A + (size_t)(srow < 0 ? 0 : srow) * lda + ak;
        f32x4n acc1[2] = {}, acc2[2] = {};
        for (int k0 = 0; k0 < K; k0 += 32) {
            *(LAS u32x2*)(sA + ar * 40 + ak) = *(const u32x2*)(arow + k0);
#pragma unroll
            for (int i = 0; i < 4; ++i) { const int idx = F.tid + 512 * i, k = idx >> 6, n = idx & 63;
                sB1[n * 40 + k] = (bf16_t)f2bf(B1[(size_t)(k0 + k) * ldb + n0 + n]);
                if (DUAL) sB2[n * 40 + k] = (bf16_t)f2bf(B2[(size_t)(k0 + k) * ldb + n0 + n]); }
            __syncthreads();
            const bf16x8 b1 = *(const LAS bf16x8*)(sB1 + (wn * 16 + l15) * 40 + quad * 8);
            bf16x8 b2 = b1; if (DUAL) b2 = *(const LAS bf16x8*)(sB2 + (wn * 16 + l15) * 40 + quad * 8);
#pragma unroll
            for (int mi = 0; mi < 2; ++mi) { const bf16x8 a = *(const LAS bf16x8*)(sA + (wm * 32 + mi * 16 + l15) * 40 + quad * 8);
                acc1[mi] = __builtin_amdgcn_mfma_f32_16x16x32_bf16(a, b1, acc1[mi], 0, 0, 0);
                if (DUAL) acc2[mi] = __builtin_amdgcn_mfma_f32_16x16x32_bf16(a, b2, acc2[mi], 0, 0, 0); }
            __syncthreads();
        }
#pragma unroll
        for (int mi = 0; mi < 2; ++mi)
#pragma unroll
            for (int j = 0; j < 4; ++j) { const int r = mt * 64 + wm * 32 + mi * 16 + quad * 4 + j, c = n0 + wn * 16 + l15;
                if (rowfn(r) >= 0) epi(r, c, acc1[mi][j], DUAL ? acc2[mi][j] : 0.f); }
    }
}

struct SrcBlk { const float* W; int ld; int col0; int mode; };
template <bool OUT8 = false, class Map>
__device__ __forceinline__ void conv_matrix(const Frame& F, const Map& map, int Ksrc, int Kd, int Nd, void* WTv, const float* kgain = nullptr, const float oscale = 1.0f) {
    bf16_t* WT = (bf16_t*)WTv; unsigned char* WT8 = (unsigned char*)WTv;
    LAS float* scr = (LAS float*)(F.lds + F.wave * 8704);
    const int nblk = Nd / 32, nitems = (Kd / 64) * nblk, lane = F.lane, lr = lane >> 3, lc = (lane & 7) * 4;
    f32x4 cur[8], nxt[8];
#define CONV_LOAD(item_, v_) do { const int kb_ = (item_) / nblk, nb_ = (item_) % nblk, k0_ = 64 * kb_; const SrcBlk sb_ = map(nb_); \
        _Pragma("unroll") for (int i_ = 0; i_ < 8; ++i_) { const int k_ = k0_ + lr + 8 * i_; \
            if (sb_.mode == 2) { const int c2_ = sb_.col0 + (lc >> 1); v_[i_] = (f32x4){k_ == c2_ ? 1.f : 0.f, k_ == c2_ + 32 ? 1.f : 0.f, k_ == c2_ + 1 ? 1.f : 0.f, k_ == c2_ + 33 ? 1.f : 0.f}; } \
            else { if (sb_.mode == 1) { f32x2 a_ = (f32x2){0.f, 0.f}, b_ = (f32x2){0.f, 0.f}; if (k_ < Ksrc) { const float* p_ = sb_.W + (size_t)k_ * sb_.ld + sb_.col0 + (lc >> 1); a_ = *(const f32x2*)p_; b_ = *(const f32x2*)(p_ + 32); } \
                    v_[i_] = (f32x4){a_.x, b_.x, a_.y, b_.y}; } \
                else v_[i_] = (sb_.W && k_ < Ksrc) ? *(const f32x4*)(sb_.W + (size_t)k_ * sb_.ld + sb_.col0 + lc) : (f32x4){0.f, 0.f, 0.f, 0.f}; \
                if (kgain) { const float g_ = k_ < Ksrc ? kgain[k_] : 0.f; v_[i_] *= g_; } } } } while (0)
    int item = F.gw;
    if (item < nitems) CONV_LOAD(item, cur);
    for (; item < nitems; item += F.NGW) {
        const int ni = item + F.NGW;
        if (ni < nitems) CONV_LOAD(ni, nxt);
        const int kb = item / nblk, nb = item % nblk, k0 = 64 * kb;
#pragma unroll
        for (int i = 0; i < 8; ++i)
#pragma unroll
            for (int j = 0; j < 4; ++j) scr[(lr + 8 * i) * 33 + lc + j] = cur[i][j];
        LDS_WAIT(); asm volatile("" ::: "memory");
        const int c = lane & 7;
#pragma unroll
        for (int j = 0; j < 4; ++j) { const int n = (lane >> 3) + 8 * j; const LAS float* sp = scr + (8 * c) * 33 + n;
            if constexpr (OUT8) { u32x2 o; o.x = pk4_fp8(sp[0 * 33] * oscale, sp[1 * 33] * oscale, sp[2 * 33] * oscale, sp[3 * 33] * oscale); o.y = pk4_fp8(sp[4 * 33] * oscale, sp[5 * 33] * oscale, sp[6 * 33] * oscale, sp[7 * 33] * oscale);
                *(u32x2*)(WT8 + (size_t)(nb * 32 + n) * Kd + k0 + 8 * c) = o; }
            else { u32x4 o; o.x = pk2(sp[0 * 33], sp[1 * 33]); o.y = pk2(sp[2 * 33], sp[3 * 33]); o.z = pk2(sp[4 * 33], sp[5 * 33]); o.w = pk2(sp[6 * 33], sp[7 * 33]);
                *(u32x4*)(WT + (size_t)(nb * 32 + n) * Kd + k0 + 8 * c) = o; } }
        LDS_WAIT(); asm volatile("" ::: "memory");
#pragma unroll
        for (int i = 0; i < 8; ++i) cur[i] = nxt[i];
    }
#undef CONV_LOAD
}
struct MapPlain { const float* W; int N;
    __device__ __forceinline__ SrcBlk operator()(int nb) const { SrcBlk s; s.W = (nb * 32 < N) ? W : nullptr; s.ld = N; s.col0 = nb * 32; s.mode = 0; return s; } };
struct MapGateUp { const float* Wg; const float* Wu; int N;
    __device__ __forceinline__ SrcBlk operator()(int nb) const { const int pn = nb >> 3, w = nb & 7; SrcBlk s; const uintptr_t m = (w < 4) ? (uintptr_t)0 : ~(uintptr_t)0; s.W = (const float*)(((uintptr_t)Wg & ~m) | ((uintptr_t)Wu & m)); s.ld = N; s.col0 = pn * 128 + (w & 3) * 32; s.mode = 0; return s; } };
struct MapQkvCA { const float* W;
    __device__ __forceinline__ SrcBlk operator()(int nb) const { const int pn = nb >> 3, blk = nb & 7, bj = blk >> 2, wc = blk & 3, sect = pn >> 2, t = pn & 3;
        SrcBlk s; s.W = W; s.ld = 3 * DM; s.col0 = sect * DM + (4 * t + wc) * 64 + 32 * bj; s.mode = 0; return s; } };

struct MapMlaQ { const float* W;
    __device__ __forceinline__ SrcBlk operator()(int nb) const { const int h = nb >> 3, blk = nb & 7; SrcBlk s; s.ld = MLA_H * QKD; s.W = blk < 6 ? W : nullptr;
        s.mode = (blk == 4 || blk == 5) ? 1 : 0; s.col0 = blk < 4 ? h * QKD + blk * 32 : h * QKD + NOPE + 16 * (blk & 1); return s; } };
struct MapMlaKV { const float* W;
    __device__ __forceinline__ SrcBlk operator()(int nb) const { const int tl = nb >> 3, blk = nb & 7; SrcBlk s; s.ld = MLA_H * 256; s.W = W; s.mode = 0;
        if (tl < 8) { if (blk < 4) s.col0 = tl * 256 + blk * 32; else if (blk < 6) { s.mode = 2; s.col0 = KVLORA + 16 * (blk - 4); } else { s.W = nullptr; s.col0 = 0; } }
        else { const int hv = 2 * (tl - 8) + (blk >> 2); s.col0 = hv * 256 + NOPE + (blk & 3) * 32; }
        return s; } };

struct ConvSel { SrcBlk sb; int Ksrc, Kd, k0, nb, out8; const float* kgain; unsigned char* WT; float oscale; };
template <class Map>
__device__ __forceinline__ bool conv_pick1(ConvSel& c, int& item, const Map& map, int Ksrc, int Kd, int Nd, void* WT, const float* kgain, int out8, float oscale) {
    const int nblk = Nd / 32, nitems = (Kd / 64) * nblk;
    if (item < nitems) { const int kb = item / nblk; c.nb = item - kb * nblk; c.k0 = 64 * kb; c.sb = map(c.nb); c.Ksrc = Ksrc; c.Kd = Kd; c.out8 = out8; c.kgain = kgain; c.WT = (unsigned char*)WT; c.oscale = oscale; return true; }
    item -= nitems; return false;
}
__device__ __forceinline__ void conv_load(const ConvSel& c, f32x4 (&v)[8], int lr, int lc) {
#pragma unroll
    for (int i = 0; i < 8; ++i) { const int k = c.k0 + lr + 8 * i;
        if (c.sb.mode == 2) { const int c2 = c.sb.col0 + (lc >> 1); v[i] = (f32x4){k == c2 ? 1.f : 0.f, k == c2 + 32 ? 1.f : 0.f, k == c2 + 1 ? 1.f : 0.f, k == c2 + 33 ? 1.f : 0.f}; }
        else { if (c.sb.mode == 1) { f32x2 a = (f32x2){0.f, 0.f}, b = (f32x2){0.f, 0.f}; if (k < c.Ksrc) { const float* q = c.sb.W + (size_t)k * c.sb.ld + c.sb.col0 + (lc >> 1); a = *(const f32x2*)q; b = *(const f32x2*)(q + 32); }
                v[i] = (f32x4){a.x, b.x, a.y, b.y}; }
            else v[i] = (c.sb.W && k < c.Ksrc) ? *(const f32x4*)(c.sb.W + (size_t)k * c.sb.ld + c.sb.col0 + lc) : (f32x4){0.f, 0.f, 0.f, 0.f};
            if (c.kgain) { const float g = k < c.Ksrc ? c.kgain[k] : 0.f; v[i] *= g; } } }
}
__device__ __forceinline__ void conv_store(const ConvSel& c, const f32x4 (&cur)[8], LAS float* scr, int lane, int lr, int lc) {
#pragma unroll
    for (int i = 0; i < 8; ++i)
#pragma unroll
        for (int j = 0; j < 4; ++j) scr[(lr + 8 * i) * 33 + lc + j] = cur[i][j];
    LDS_WAIT(); asm volatile("" ::: "memory");
    const int cc = lane & 7; const float os = c.oscale;
#pragma unroll
    for (int j = 0; j < 4; ++j) { const int n = (lane >> 3) + 8 * j; const LAS float* sp = scr + (8 * cc) * 33 + n;
        if (c.out8) { u32x2 o; o.x = pk4_fp8(sp[0 * 33] * os, sp[1 * 33] * os, sp[2 * 33] * os, sp[3 * 33] * os); o.y = pk4_fp8(sp[4 * 33] * os, sp[5 * 33] * os, sp[6 * 33] * os, sp[7 * 33] * os);
            *(u32x2*)(c.WT + (size_t)(c.nb * 32 + n) * c.Kd + c.k0 + 8 * cc) = o; }
        else { u32x4 o; o.x = pk2(sp[0 * 33], sp[1 * 33]); o.y = pk2(sp[2 * 33], sp[3 * 33]); o.z = pk2(sp[4 * 33], sp[5 * 33]); o.w = pk2(sp[6 * 33], sp[7 * 33]);
            *(u32x4*)((bf16_t*)c.WT + (size_t)(c.nb * 32 + n) * c.Kd + c.k0 + 8 * cc) = o; } }
    LDS_WAIT(); asm volatile("" ::: "memory");
}
struct EvenConv { const float *w_in, *w_uq, *qa, *w_ukv, *kva, *w_o, *wg, *wu, *ffn_norm, *wd; unsigned char* Wb; int up8, ao8, ffn8, in8; const float* attn_norm; };
__device__ __forceinline__ bool even_pick(const EvenConv& e, ConvSel& c, int item) {
    return conv_pick1(c, item, MapGateUp{e.wg, e.wu, FF}, DM, DM, 2 * FF, e.Wb + WE_GU, e.ffn_norm, e.ffn8, e.ffn8 ? 256.0f : 1.0f)
        || conv_pick1(c, item, MapPlain{e.wd, DM}, FF, FF, DM, e.Wb + WE_D, nullptr, e.ffn8, e.ffn8 ? 256.0f : 1.0f)
        || conv_pick1(c, item, MapPlain{e.w_o, DM}, DM, DM, DM, e.Wb + WE_O, nullptr, e.ao8, e.ao8 ? 256.0f : 1.0f)
        || conv_pick1(c, item, MapPlain{e.w_in, AIN}, DM, DM, AINP, e.Wb + WE_IN, e.attn_norm, e.in8, e.in8 ? 256.0f : 1.0f)
        || conv_pick1(c, item, MapMlaQ{e.w_uq}, QLORA, QLORA, MLA_H * 256, e.Wb + WE_QKVF, e.qa, e.up8, e.up8 ? 256.0f : 1.0f)
        || conv_pick1(c, item, MapMlaKV{e.w_ukv}, KVLORA, 256, 12 * 256, e.Wb + WE_QKVF + (size_t)MLA_H * 256 * 256 * (e.up8 ? 1 : 2), e.kva, e.up8, e.up8 ? 256.0f : 1.0f);
}
__device__ __forceinline__ void conv_even(const Frame& F, const EvenConv& e) {
    constexpr int TOTAL = (DM / 64) * (2 * FF / 32) + (FF / 64) * (DM / 32) + (DM / 64) * (DM / 32) + (DM / 64) * (AINP / 32) + (QLORA / 64) * (MLA_H * 256 / 32) + (256 / 64) * (12 * 256 / 32);
    LAS float* scr = (LAS float*)(F.lds + F.wave * 8704);
    const int lane = F.lane, lr = lane >> 3, lc = (lane & 7) * 4;
    f32x4 cur[8], nxt[8]; ConvSel cc, cn;
    int item = F.gw;
    if (item >= TOTAL) return;
    even_pick(e, cc, item); conv_load(cc, cur, lr, lc);
    for (; item < TOTAL; item += F.NGW) {
        const int ni = item + F.NGW < TOTAL ? item + F.NGW : TOTAL - 1;
        even_pick(e, cn, ni); conv_load(cn, nxt, lr, lc);
        conv_store(cc, cur, scr, lane, lr, lc);
#pragma unroll
        for (int i = 0; i < 8; ++i) cur[i] = nxt[i];
        cc = cn;
    }
}

__device__ __forceinline__ void rope_table(const Frame& F, const int* positions, f32x2* CS) {
    for (int idx = F.gw * 64 + F.lane; idx < T_ * 32; idx += F.NGW * 64) { const int t = idx >> 5, i = idx & 31;
        const float inv = exp2f(-(float)i * (13.287712379549449f / 32.0f)); float sn, cs; sincosf((float)positions[t] * inv, &sn, &cs); CS[idx] = (f32x2){cs, sn}; }
}
struct MoeCombine { const int* re; const int* rp; const float* rw; const bf16_t* Y; pg8::MoeInfo mi; };
struct NormRowData { f32x4 x[4]; u32x2 y0[4], y1[4]; float w0, w1; };
template <bool COMBINE>
__device__ __forceinline__ void norm_row_load(NormRowData& d, const float* src, int t, int lane, const MoeCombine& mc, int e0, int e1, int p0, int p1, float w0, float w1) {
    const f32x4* xr = (const f32x4*)(src + (size_t)t * DM) + lane;
#pragma unroll
    for (int j = 0; j < 4; ++j) d.x[j] = xr[64 * j];
    if constexpr (COMBINE) {
        const size_t r0 = (size_t)mc.mi.start_of(e0) * 256 + p0, r1 = (size_t)mc.mi.start_of(e1) * 256 + p1;
        const u32x2* y0 = (const u32x2*)(mc.Y + r0 * DM) + lane; const u32x2* y1 = (const u32x2*)(mc.Y + r1 * DM) + lane;
#pragma unroll
        for (int j = 0; j < 4; ++j) { d.y0[j] = y0[64 * j]; d.y1[j] = y1[64 * j]; }
        d.w0 = w0; d.w1 = w1;
    }
}
template <bool COMBINE, bool WRITE_X, bool WRITE_H, bool OUT8 = false>
__device__ __forceinline__ void norm_rows(const Frame& F, const float* src, float* X, const float* gain, bf16_t* H, const MoeCombine& mc) {
    const int lane = F.lane;
    f32x4 gl[4];
    if constexpr (WRITE_H) {
#pragma unroll
        for (int j = 0; j < 4; ++j) gl[j] = ((const f32x4*)gain)[lane + 64 * j]; }
    NormRowData d, dn;
    int e0n = 0, e1n = 0, p0n = 0, p1n = 0; float w0n = 0.f, w1n = 0.f;
    int t = F.gw;
    if (t < T_) { int e0 = 0, e1 = 0, p0 = 0, p1 = 0; float w0 = 0.f, w1 = 0.f;
        if constexpr (COMBINE) { e0 = mc.re[2 * t]; e1 = mc.re[2 * t + 1]; p0 = mc.rp[2 * t]; p1 = mc.rp[2 * t + 1]; w0 = mc.rw[2 * t]; w1 = mc.rw[2 * t + 1]; }
        norm_row_load<COMBINE>(d, src, t, lane, mc, e0, e1, p0, p1, w0, w1);
        const int t1 = t + F.NGW < T_ ? t + F.NGW : T_ - 1;
        if constexpr (COMBINE) { e0n = mc.re[2 * t1]; e1n = mc.re[2 * t1 + 1]; p0n = mc.rp[2 * t1]; p1n = mc.rp[2 * t1 + 1]; w0n = mc.rw[2 * t1]; w1n = mc.rw[2 * t1 + 1]; } }
    for (; t < T_; t += F.NGW) {
        const int t1 = t + F.NGW, t2 = t1 + F.NGW;
        if (t1 < T_) norm_row_load<COMBINE>(dn, src, t1, lane, mc, e0n, e1n, p0n, p1n, w0n, w1n);
        if constexpr (COMBINE) if (t2 < T_) { e0n = mc.re[2 * t2]; e1n = mc.re[2 * t2 + 1]; p0n = mc.rp[2 * t2]; p1n = mc.rp[2 * t2 + 1]; w0n = mc.rw[2 * t2]; w1n = mc.rw[2 * t2 + 1]; }
        f32x4 v[4];
#pragma unroll
        for (int j = 0; j < 4; ++j) v[j] = d.x[j];
        if constexpr (COMBINE) { const float w0 = d.w0, w1 = d.w1;
#pragma unroll
            for (int j = 0; j < 4; ++j) { const u32x2 a = d.y0[j], b = d.y1[j];
                v[j][0] += w0 * bf2f(a.x & 0xffffu) + w1 * bf2f(b.x & 0xffffu); v[j][1] += w0 * bf2f(a.x >> 16) + w1 * bf2f(b.x >> 16);
                v[j][2] += w0 * bf2f(a.y & 0xffffu) + w1 * bf2f(b.y & 0xffffu); v[j][3] += w0 * bf2f(a.y >> 16) + w1 * bf2f(b.y >> 16); } }
        if constexpr (WRITE_X) { f32x4* xo = (f32x4*)(X + (size_t)t * DM) + lane;
#pragma unroll
            for (int j = 0; j < 4; ++j) xo[64 * j] = v[j]; }
        if constexpr (WRITE_H) {
            float s = 0.f;
#pragma unroll
            for (int j = 0; j < 4; ++j) s += (v[j][0] * v[j][0] + v[j][1] * v[j][1]) + (v[j][2] * v[j][2] + v[j][3] * v[j][3]);
            const float rstd = rsqrtf(wave_sum(s) * (1.0f / DM) + EPS);
            u32x2* ho = (u32x2*)(H + (size_t)t * DM) + lane;
#pragma unroll
            for (int j = 0; j < 4; ++j) { const f32x4 g = gl[j];
                if constexpr (OUT8) { const float r16 = rstd * 16.0f; ((unsigned*)((unsigned char*)H + (size_t)t * DM) + lane)[64 * j] = pk4_fp8(v[j][0] * r16 * g[0], v[j][1] * r16 * g[1], v[j][2] * r16 * g[2], v[j][3] * r16 * g[3]); }
                else { u32x2 o; o.x = cvt_pk_bf16(v[j][0] * rstd * g[0], v[j][1] * rstd * g[1]); o.y = cvt_pk_bf16(v[j][2] * rstd * g[2], v[j][3] * rstd * g[3]); ho[64 * j] = o; } }
        }
        d = dn;
    }
}
struct ResRowData { f32x4 x[4]; u32x2 y0[4], y1[4]; float w0, w1; };
template <bool SRC16, bool COMBINE>
__device__ __forceinline__ void res_row_load(ResRowData& d, const void* src, int t, int lane, const MoeCombine& mc, int e0, int e1, int p0, int p1, float w0, float w1) {
    if constexpr (SRC16) { const u32x2* xr = (const u32x2*)((const bf16_t*)src + (size_t)t * DM) + lane;
#pragma unroll
        for (int j = 0; j < 4; ++j) { const u32x2 a = xr[64 * j]; d.x[j] = (f32x4){bf2f(a.x & 0xffffu), bf2f(a.x >> 16), bf2f(a.y & 0xffffu), bf2f(a.y >> 16)}; } }
    else { const f32x4* xr = (const f32x4*)((const float*)src + (size_t)t * DM) + lane;
#pragma unroll
        for (int j = 0; j < 4; ++j) d.x[j] = xr[64 * j]; }
    if constexpr (COMBINE) {
        const size_t r0 = (size_t)mc.mi.start_of(e0) * 256 + p0, r1 = (size_t)mc.mi.start_of(e1) * 256 + p1;
        const u32x2* y0 = (const u32x2*)(mc.Y + r0 * DM) + lane; const u32x2* y1 = (const u32x2*)(mc.Y + r1 * DM) + lane;
#pragma unroll
        for (int j = 0; j < 4; ++j) { d.y0[j] = y0[64 * j]; d.y1[j] = y1[64 * j]; }
        d.w0 = w0; d.w1 = w1;
    }
}
template <bool SRC16, bool COMBINE, bool WRITE_XB, bool WRITE_H, bool WRITE_F32>
__device__ __forceinline__ void res_rows(const Frame& F, const void* src, bf16_t* XB, const float* gain, bf16_t* H, float* OUT, const MoeCombine& mc, const bool h8 = false, float* ssout = nullptr) {
    const int lane = F.lane; float keep_s = 0.f; int irow = 0;
    f32x4 gl[4];
    if constexpr (WRITE_H) {
#pragma unroll
        for (int j = 0; j < 4; ++j) gl[j] = ((const f32x4*)gain)[lane + 64 * j]; }
    ResRowData d, dn;
    int e0n = 0, e1n = 0, p0n = 0, p1n = 0; float w0n = 0.f, w1n = 0.f;
    int t = F.gw;
    if (t < T_) { int e0 = 0, e1 = 0, p0 = 0, p1 = 0; float w0 = 0.f, w1 = 0.f;
        if constexpr (COMBINE) { e0 = mc.re[2 * t]; e1 = mc.re[2 * t + 1]; p0 = mc.rp[2 * t]; p1 = mc.rp[2 * t + 1]; w0 = mc.rw[2 * t]; w1 = mc.rw[2 * t + 1]; }
        res_row_load<SRC16, COMBINE>(d, src, t, lane, mc, e0, e1, p0, p1, w0, w1);
        const int t1 = t + F.NGW < T_ ? t + F.NGW : T_ - 1;
        if constexpr (COMBINE) { e0n = mc.re[2 * t1]; e1n = mc.re[2 * t1 + 1]; p0n = mc.rp[2 * t1]; p1n = mc.rp[2 * t1 + 1]; w0n = mc.rw[2 * t1]; w1n = mc.rw[2 * t1 + 1]; } }
    for (; t < T_; t += F.NGW) {
        const int t1 = t + F.NGW < T_ ? t + F.NGW : T_ - 1, t2 = t + 2 * F.NGW < T_ ? t + 2 * F.NGW : T_ - 1;
        res_row_load<SRC16, COMBINE>(dn, src, t1, lane, mc, e0n, e1n, p0n, p1n, w0n, w1n);
        if constexpr (COMBINE) { e0n = mc.re[2 * t2]; e1n = mc.re[2 * t2 + 1]; p0n = mc.rp[2 * t2]; p1n = mc.rp[2 * t2 + 1]; w0n = mc.rw[2 * t2]; w1n = mc.rw[2 * t2 + 1]; }
        f32x4 v[4];
#pragma unroll
        for (int j = 0; j < 4; ++j) v[j] = d.x[j];
        if constexpr (COMBINE) { const float w0 = d.w0, w1 = d.w1;
#pragma unroll
            for (int j = 0; j < 4; ++j) { const u32x2 a = d.y0[j], b = d.y1[j];
                v[j][0] += w0 * bf2f(a.x & 0xffffu) + w1 * bf2f(b.x & 0xffffu); v[j][1] += w0 * bf2f(a.x >> 16) + w1 * bf2f(b.x >> 16);
                v[j][2] += w0 * bf2f(a.y & 0xffffu) + w1 * bf2f(b.y & 0xffffu); v[j][3] += w0 * bf2f(a.y >> 16) + w1 * bf2f(b.y >> 16); } }
        if constexpr (WRITE_F32) { f32x4* xo = (f32x4*)(OUT + (size_t)t * DM) + lane;
#pragma unroll
            for (int j = 0; j < 4; ++j) xo[64 * j] = v[j]; }
        if constexpr (WRITE_XB) { u32x2* xo = (u32x2*)(XB + (size_t)t * DM) + lane;
#pragma unroll
            for (int j = 0; j < 4; ++j) { u32x2 o; o.x = cvt_pk_bf16(v[j][0], v[j][1]); o.y = cvt_pk_bf16(v[j][2], v[j][3]); xo[64 * j] = o; } }
        if constexpr (WRITE_XB && !WRITE_H) { if (ssout) {
            float s = 0.f;
#pragma unroll
            for (int j = 0; j < 4; ++j) s += (v[j][0] * v[j][0] + v[j][1] * v[j][1]) + (v[j][2] * v[j][2] + v[j][3] * v[j][3]);
            s = wave_sum(s); keep_s = lane == irow ? s : keep_s; } }
        ++irow;
        if constexpr (WRITE_H) {
            float s = 0.f;
#pragma unroll
            for (int j = 0; j < 4; ++j) s += (v[j][0] * v[j][0] + v[j][1] * v[j][1]) + (v[j][2] * v[j][2] + v[j][3] * v[j][3]);
            const float rstd = rsqrtf(wave_sum(s) * (1.0f / DM) + EPS);
            if (h8) { const float r16 = rstd * 16.0f; unsigned* ho8 = (unsigned*)((unsigned char*)H + (size_t)t * DM) + lane;
#pragma unroll
                for (int j = 0; j < 4; ++j) { const f32x4 g = gl[j]; ho8[64 * j] = pk4_fp8(v[j][0] * r16 * g[0], v[j][1] * r16 * g[1], v[j][2] * r16 * g[2], v[j][3] * r16 * g[3]); } }
            else { u32x2* ho = (u32x2*)(H + (size_t)t * DM) + lane;
#pragma unroll
            for (int j = 0; j < 4; ++j) { const f32x4 g = gl[j]; u32x2 o; o.x = cvt_pk_bf16(v[j][0] * rstd * g[0], v[j][1] * rstd * g[1]); o.y = cvt_pk_bf16(v[j][2] * rstd * g[2], v[j][3] * rstd * g[3]); ho[64 * j] = o; } }
        }
        d = dn;
    }
    if constexpr (WRITE_XB && !WRITE_H) { if (ssout && lane < irow) *(f32x4*)(ssout + (size_t)(F.gw + lane * F.NGW) * 4) = (f32x4){keep_s, 0.f, 0.f, 0.f}; }
}
struct MlaTok { u32x2 aq, akv, qraw[MLA_H], kraw[MLA_H], vraw[MLA_H]; float pos; };
__device__ __forceinline__ void mla_tok_load(MlaTok& d, int t, int lane, const bf16_t* Qraw, const bf16_t* KVraw, const bf16_t* A1, const int* positions) {
    const u32x2* ap = (const u32x2*)(A1 + (size_t)t * AINP) + lane;
    d.aq = ap[0]; d.akv = (u32x2){0u, 0u}; if (lane < 48) d.akv = ap[64];
    d.pos = (float)positions[t];
#pragma unroll
    for (int h = 0; h < MLA_H; ++h) { d.qraw[h] = (u32x2){0u, 0u}; d.kraw[h] = (u32x2){0u, 0u}; d.vraw[h] = (u32x2){0u, 0u};
        if (lane < 48) d.qraw[h] = *((const u32x2*)(Qraw + (size_t)t * 1536 + h * QKD) + lane);
        if (lane < 32) { d.kraw[h] = *((const u32x2*)(KVraw + (size_t)t * 2048 + h * 256) + lane); d.vraw[h] = *((const u32x2*)(KVraw + (size_t)t * 2048 + h * 256 + 128) + lane); } }
}
__device__ __forceinline__ void mla_qk_norm_rope(const Frame& F, const bf16_t* Qraw, bf16_t* KVraw, const bf16_t* A1, const int* positions, const float* gq, const float* gk, bf16_t* QN, bf16_t* KN) {
    const int lane = F.lane; const bool act = lane < 48, isrope = lane >= 32 && lane < 48, second = lane >= 40;
    const f32x4 gql = act ? ((const f32x4*)gq)[lane] : (f32x4){0.f, 0.f, 0.f, 0.f};
    const f32x4 gkl = act ? ((const f32x4*)gk)[lane] : (f32x4){0.f, 0.f, 0.f, 0.f};
    float invf[4];
#pragma unroll
    for (int j = 0; j < 4; ++j) invf[j] = exp2f(-(float)(4 * (lane & 7) + j) * (13.287712379549449f / 32.0f));
    MlaTok d, dn;
    int t = F.gw;
    if (t < T_) mla_tok_load(d, t, lane, Qraw, KVraw, A1, positions);
    for (; t < T_; t += F.NGW) {
        const int tn = t + F.NGW;
        if (tn < T_) mla_tok_load(dn, tn, lane, Qraw, KVraw, A1, positions);
        float cs[4], sn[4];
#pragma unroll
        for (int j = 0; j < 4; ++j) sincosf(d.pos * invf[j], &sn[j], &cs[j]);
        const u32x2 kr = d.akv;
        float rq, rkv;
        { const float q0 = bf2f(d.aq.x & 0xffffu), q1 = bf2f(d.aq.x >> 16), q2 = bf2f(d.aq.y & 0xffffu), q3 = bf2f(d.aq.y >> 16);
          const float k0 = bf2f(d.akv.x & 0xffffu), k1 = bf2f(d.akv.x >> 16), k2 = bf2f(d.akv.y & 0xffffu), k3 = bf2f(d.akv.y >> 16);
          rq = rsqrtf(wave_sum((q0 * q0 + q1 * q1) + (q2 * q2 + q3 * q3)) * (1.0f / QLORA) + EPS);
          rkv = rsqrtf(wave_sum(lane < 32 ? (k0 * k0 + k1 * k1) + (k2 * k2 + k3 * k3) : 0.f) * (1.0f / KVLORA) + EPS); }
#pragma unroll
        for (int h = 0; h < MLA_H; ++h) {
#pragma unroll
            for (int qk = 0; qk < 2; ++qk) {
                const u32x2 raw = qk == 0 ? d.qraw[h] : (lane < 32 ? d.kraw[h] : kr);
                const float sc = qk == 0 ? rq : (lane < 32 ? rkv : 1.0f);
                float v[4] = {bf2f(raw.x & 0xffffu) * sc, bf2f(raw.x >> 16) * sc, bf2f(raw.y & 0xffffu) * sc, bf2f(raw.y >> 16) * sc};
                const float ss = wave_sum(act ? (v[0] * v[0] + v[1] * v[1]) + (v[2] * v[2] + v[3] * v[3]) : 0.f);
                const float rinv = rsqrtf(ss * (1.0f / QKD) + EPS); const f32x4 g = qk == 0 ? gql : gkl;
                float y[4], o[4];
#pragma unroll
                for (int j = 0; j < 4; ++j) y[j] = v[j] * rinv * g[j];
#pragma unroll
                for (int j = 0; j < 4; ++j) { const float pr = __shfl_xor(y[j], 8);
                    o[j] = isrope ? (second ? (pr * sn[j] + y[j] * cs[j]) : (y[j] * cs[j] - pr * sn[j])) : y[j]; }
                if (act) { u32x2 w; w.x = pk2(o[0], o[1]); w.y = pk2(o[2], o[3]); *((u32x2*)((qk == 0 ? QN : KN) + (size_t)t * 1536 + h * QKD) + lane) = w; }
            }
            if (lane < 32) { const u32x2 r = d.vraw[h]; u32x2 w; w.x = pk2(bf2f(r.x & 0xffffu) * rkv, bf2f(r.x >> 16) * rkv); w.y = pk2(bf2f(r.y & 0xffffu) * rkv, bf2f(r.y >> 16) * rkv);
                *((u32x2*)(KVraw + (size_t)t * 2048 + h * 256 + 128) + lane) = w; }
        }
        d = dn;
    }
}
__device__ __forceinline__ void ca_head_norm(const Frame& F, bf16_t* Q, const float* g) {
    for (int t = F.gw; t < T_; t += F.NGW) {
#pragma unroll 1
        for (int hh = 0; hh < 4; ++hh) {
            u32x2* p = (u32x2*)(Q + (size_t)t * DM + hh * 256) + F.lane; const u32x2 a = *p;
            float v[4] = {bf2f(a.x & 0xffffu), bf2f(a.x >> 16), bf2f(a.y & 0xffffu), bf2f(a.y >> 16)};
            float ss = (v[0] * v[0] + v[1] * v[1]) + (v[2] * v[2] + v[3] * v[3]);
            ss += __shfl_xor(ss, 1); ss += __shfl_xor(ss, 2); ss += __shfl_xor(ss, 4); ss += __shfl_xor(ss, 8);
            const float rinv = rsqrtf(ss * (1.0f / 64.0f) + EPS); const f32x4 gg = ((const f32x4*)g)[F.lane & 15];
            u32x2 o; o.x = pk2(v[0] * rinv * gg[0], v[1] * rinv * gg[1]); o.y = pk2(v[2] * rinv * gg[2], v[3] * rinv * gg[3]); *p = o;
        }
    }
}
template <bool OUT8>
__device__ __forceinline__ void norm_router(const Frame& F, const bf16_t* X, const float* gain, const float* router, void* Hv, int* re, int* rp, float* rw, int* perm, gu32* cnt, const bool probe = false) {
    bf16_t* H = (bf16_t*)Hv; unsigned char* H8 = (unsigned char*)Hv;
    LAS unsigned* bc = (LAS unsigned*)(F.lds);
    LAS float* RT = (LAS float*)(F.lds + 256);
    if (F.tid < 16) bc[F.tid] = 0u;
    { const f32x4* rq = (const f32x4*)router + F.tid * 4; const f32x4 q0 = rq[0], q1 = rq[1], q2 = rq[2], q3 = rq[3]; const int k = F.tid * 2;
#pragma unroll
      for (int e = 0; e < 4; ++e) { RT[e * DM + k] = q0[e]; RT[(e + 4) * DM + k] = q1[e]; RT[e * DM + k + 1] = q2[e]; RT[(e + 4) * DM + k + 1] = q3[e]; } }
    __syncthreads();
    const int lane = F.lane; const bool b0 = lane & 1, b1 = lane & 2, b2 = lane & 4;
    f32x4 gl[4];
#pragma unroll
    for (int j = 0; j < 4; ++j) gl[j] = ((const f32x4*)gain)[lane + 64 * j];
    int ke0 = 0, ke1 = 0, kl0 = 0, kl1 = 0; float kw0 = 0.f, kw1 = 0.f; int i = 0;
    constexpr int R = 2;
    u32x2 v[R][4], vn[R][4];
#ifndef E5_PROBE
#define E5_PROBE 0
#endif
    const int nrows = (E5_PROBE && probe) ? 0 : (F.gw < T_ ? (T_ - F.gw + F.NGW - 1) / F.NGW : 0);
    int t = F.gw;
#pragma unroll
    for (int r = 0; r < R; ++r) { const int tr = t + r * F.NGW, tc = tr < T_ ? tr : T_ - 1; const u32x2* xr = (const u32x2*)(X + (size_t)tc * DM) + lane;
#pragma unroll
        for (int j = 0; j < 4; ++j) v[r][j] = xr[64 * j]; }
    for (; i + R <= nrows; t += R * F.NGW, i += R) {
#pragma unroll
        for (int r = 0; r < R; ++r) { const int tn = t + (R + r) * F.NGW, tc = tn < T_ ? tn : T_ - 1; const u32x2* xr = (const u32x2*)(X + (size_t)tc * DM) + lane;
#pragma unroll
            for (int j = 0; j < 4; ++j) vn[r][j] = xr[64 * j]; }
        float s[R], rstd[R];
#pragma unroll
        for (int r = 0; r < R; ++r) { s[r] = 0.f;
#pragma unroll
            for (int j = 0; j < 4; ++j) { const u32x2 a = v[r][j]; const float x0 = bf2f(a.x & 0xffffu), x1 = bf2f(a.x >> 16), x2 = bf2f(a.y & 0xffffu), x3 = bf2f(a.y >> 16); s[r] += (x0 * x0 + x1 * x1) + (x2 * x2 + x3 * x3); } }
#pragma unroll
        for (int r = 0; r < R; ++r) rstd[r] = rsqrtf(wave_sum(s[r]) * (1.0f / DM) + EPS);
        float lg[R][8];
#pragma unroll
        for (int r = 0; r < R; ++r)
#pragma unroll
            for (int e = 0; e < 8; ++e) lg[r][e] = 0.f;
#pragma unroll
        for (int j = 0; j < 4; ++j) { f32x4 h[R];
#pragma unroll
            for (int r = 0; r < R; ++r) { const int tr = t + r * F.NGW; const u32x2 a = v[r][j]; h[r] = (f32x4){bf2f(a.x & 0xffffu), bf2f(a.x >> 16), bf2f(a.y & 0xffffu), bf2f(a.y >> 16)} * rstd[r] * gl[j];
                if constexpr (OUT8) { ((unsigned*)(H8 + (size_t)tr * DM) + lane)[64 * j] = pk4_fp8(h[r][0] * 16.0f, h[r][1] * 16.0f, h[r][2] * 16.0f, h[r][3] * 16.0f); }
                else { u32x2 o; o.x = cvt_pk_bf16(h[r][0], h[r][1]); o.y = cvt_pk_bf16(h[r][2], h[r][3]); ((u32x2*)(H + (size_t)tr * DM) + lane)[64 * j] = o; } }
#pragma unroll
            for (int e = 0; e < 8; ++e) { const f32x4 rt = *(const LAS f32x4*)(RT + e * DM + 256 * j + 4 * lane);
#pragma unroll
                for (int r = 0; r < R; ++r) lg[r][e] += (h[r][0] * rt[0] + h[r][1] * rt[1]) + (h[r][2] * rt[2] + h[r][3] * rt[3]); } }
        int e0[R], e1[R]; float w0[R], w1[R];
#pragma unroll
        for (int r = 0; r < R; ++r) { float L[8];
#pragma unroll
            for (int e = 0; e < 8; ++e) L[e] = wave_sum(lg[r][e]);
            e0[r] = 0; float l0 = L[0];
#pragma unroll
            for (int e = 1; e < 8; ++e) if (L[e] > l0) { l0 = L[e]; e0[r] = e; }
            e1[r] = -1; float l1 = -3.0e38f;
#pragma unroll
            for (int e = 0; e < 8; ++e) if (e != e0[r] && L[e] > l1) { l1 = L[e]; e1[r] = e; }
            const float ex = __expf(l1 - l0); w0[r] = 1.0f / (1.0f + ex); w1[r] = ex * w0[r]; }
        int lp0[R], lp1[R];
#pragma unroll
        for (int r = 0; r < R; ++r) { lp0[r] = 0; lp1[r] = 0; }
        if (lane == 0) {
#pragma unroll
            for (int r = 0; r < R; ++r) { lp0[r] = (int)__hip_atomic_fetch_add(bc + e0[r], 1u, __ATOMIC_RELAXED, __HIP_MEMORY_SCOPE_WORKGROUP); lp1[r] = (int)__hip_atomic_fetch_add(bc + e1[r], 1u, __ATOMIC_RELAXED, __HIP_MEMORY_SCOPE_WORKGROUP); } }
#pragma unroll
        for (int r = 0; r < R; ++r) { const int q0 = __builtin_amdgcn_readfirstlane(lp0[r]), q1 = __builtin_amdgcn_readfirstlane(lp1[r]);
            if (lane == i + r) { ke0 = e0[r]; ke1 = e1[r]; kl0 = q0; kl1 = q1; kw0 = w0[r]; kw1 = w1[r]; } }
#pragma unroll
        for (int r = 0; r < R; ++r)
#pragma unroll
            for (int j = 0; j < 4; ++j) v[r][j] = vn[r][j];
    }
    for (; i < nrows; t += F.NGW, ++i) {
        const u32x2* xr = (const u32x2*)(X + (size_t)t * DM) + lane; f32x4 x[4]; float s = 0.f;
#pragma unroll
        for (int j = 0; j < 4; ++j) { const u32x2 a = xr[64 * j]; x[j] = (f32x4){bf2f(a.x & 0xffffu), bf2f(a.x >> 16), bf2f(a.y & 0xffffu), bf2f(a.y >> 16)}; s += (x[j][0] * x[j][0] + x[j][1] * x[j][1]) + (x[j][2] * x[j][2] + x[j][3] * x[j][3]); }
        const float rstd = rsqrtf(wave_sum(s) * (1.0f / DM) + EPS);
        float L[8];
#pragma unroll
        for (int e = 0; e < 8; ++e) L[e] = 0.f;
#pragma unroll
        for (int j = 0; j < 4; ++j) { const f32x4 h = x[j] * rstd * gl[j];
            if constexpr (OUT8) { ((unsigned*)(H8 + (size_t)t * DM) + lane)[64 * j] = pk4_fp8(h[0] * 16.0f, h[1] * 16.0f, h[2] * 16.0f, h[3] * 16.0f); } else { u32x2 o; o.x = cvt_pk_bf16(h[0], h[1]); o.y = cvt_pk_bf16(h[2], h[3]); ((u32x2*)(H + (size_t)t * DM) + lane)[64 * j] = o; }
#pragma unroll
            for (int e = 0; e < 8; ++e) { const f32x4 rt = *(const LAS f32x4*)(RT + e * DM + 256 * j + 4 * lane); L[e] += (h[0] * rt[0] + h[1] * rt[1]) + (h[2] * rt[2] + h[3] * rt[3]); } }
#pragma unroll
        for (int e = 0; e < 8; ++e) L[e] = wave_sum(L[e]);
        int e0 = 0; float l0 = L[0];
#pragma unroll
        for (int e = 1; e < 8; ++e) if (L[e] > l0) { l0 = L[e]; e0 = e; }
        int e1 = -1; float l1 = -3.0e38f;
#pragma unroll
        for (int e = 0; e < 8; ++e) if (e != e0 && L[e] > l1) { l1 = L[e]; e1 = e; }
        const float ex = __expf(l1 - l0), w0 = 1.0f / (1.0f + ex), w1 = ex * w0;
        int lp0 = 0, lp1 = 0;
        if (lane == 0) { lp0 = (int)__hip_atomic_fetch_add(bc + e0, 1u, __ATOMIC_RELAXED, __HIP_MEMORY_SCOPE_WORKGROUP); lp1 = (int)__hip_atomic_fetch_add(bc + e1, 1u, __ATOMIC_RELAXED, __HIP_MEMORY_SCOPE_WORKGROUP); }
        lp0 = __builtin_amdgcn_readfirstlane(lp0); lp1 = __builtin_amdgcn_readfirstlane(lp1);
        if (lane == i) { ke0 = e0; ke1 = e1; kl0 = lp0; kl1 = lp1; kw0 = w0; kw1 = w1; }
    }
    __syncthreads();
    if (F.tid < 8 && !probe) bc[8 + F.tid] = __hip_atomic_fetch_add(cnt + 64 * F.tid, bc[F.tid], RLX_AGENT);
    __syncthreads();
    if (lane < i && !probe) { const int tt = F.gw + lane * F.NGW; const int p0 = (int)bc[8 + ke0] + kl0, p1 = (int)bc[8 + ke1] + kl1;
        re[2 * tt] = ke0; re[2 * tt + 1] = ke1; rp[2 * tt] = p0; rp[2 * tt + 1] = p1; rw[2 * tt] = kw0; rw[2 * tt + 1] = kw1; perm[(size_t)ke0 * T_ + p0] = tt; perm[(size_t)ke1 * T_ + p1] = tt; }
    __syncthreads();
}

template <int DQK, int DV, bool BAND>
__device__ __forceinline__ void attn_naive(const Frame& F, const bf16_t* Q, int ldq, const bf16_t* K, int ldk, const bf16_t* V, int ldv, bf16_t* O, int ldo, int nheads, const float* bias, float scale) {
    constexpr int QS = DQK + 4, KS = DQK + 8, VS = DV + 8, DG = DV / 8;
    LAS float* Qs = (LAS float*)F.lds; LAS bf16_t* Ks = (LAS bf16_t*)(Qs + 64 * QS); LAS bf16_t* Vs = Ks + 64 * KS; LAS float* Ss = (LAS float*)(Vs + 64 * VS);
    LAS float* mS = Ss + 64 * 65; LAS float* lS = mS + 64; LAS float* aS = lS + 64; LAS float* bS = aS + 64;
    const int tid = F.tid, qi = tid & 63, kw = tid >> 6, nunits = NBATCH * nheads * NCHK;
    for (int un = F.vcu; un < nunits; un += F.G) {
        const int c = (NCHK - 1) - un / (NBATCH * nheads), bh = un % (NBATCH * nheads), b = bh / nheads, h = bh % nheads;
        const size_t row0 = (size_t)b * SEQ + (size_t)c * 64;
        __syncthreads();
        for (int idx = tid; idx < 64 * DQK / 4; idx += 512) { const int r = idx / (DQK / 4), c4 = idx % (DQK / 4);
            const u32x2 a = *(const u32x2*)(Q + (row0 + r) * ldq + h * DQK + c4 * 4);
            *(LAS f32x4*)(Qs + r * QS + c4 * 4) = (f32x4){bf2f(a.x & 0xffffu), bf2f(a.x >> 16), bf2f(a.y & 0xffffu), bf2f(a.y >> 16)}; }
        if (tid < 64) { mS[tid] = -3.0e38f; lS[tid] = 0.f; }
        if (BAND) for (int idx = tid; idx < NREL; idx += 512) bS[idx] = bias[h * NREL + idx];
        float o[DG];
#pragma unroll
        for (int d = 0; d < DG; ++d) o[d] = 0.f;
        const int kc0 = BAND ? (c - 8 > 0 ? c - 8 : 0) : 0;
        for (int kc = kc0; kc <= c; ++kc) {
            const size_t krow0 = (size_t)b * SEQ + (size_t)kc * 64;
            __syncthreads();
            for (int idx = tid; idx < 64 * DQK / 8; idx += 512) { const int r = idx / (DQK / 8), c8 = idx % (DQK / 8);
                *(LAS u32x4*)(Ks + r * KS + c8 * 8) = *(const u32x4*)(K + (krow0 + r) * ldk + h * DQK + c8 * 8); }
            for (int idx = tid; idx < 64 * DV / 8; idx += 512) { const int r = idx / (DV / 8), c8 = idx % (DV / 8);
                *(LAS u32x4*)(Vs + r * VS + c8 * 8) = *(const u32x4*)(V + (krow0 + r) * ldv + h * DV + c8 * 8); }
            __syncthreads();
            float s[8] = {0.f, 0.f, 0.f, 0.f, 0.f, 0.f, 0.f, 0.f};
            for (int d = 0; d < DQK; d += 8) {
                const f32x4 qa = *(const LAS f32x4*)(Qs + qi * QS + d), qb = *(const LAS f32x4*)(Qs + qi * QS + d + 4);
#pragma unroll
                for (int j = 0; j < 8; ++j) { const u32x4 kk = *(const LAS u32x4*)(Ks + (kw + 8 * j) * KS + d);
                    s[j] += qa[0] * bf2f(kk.x & 0xffffu) + qa[1] * bf2f(kk.x >> 16) + qa[2] * bf2f(kk.y & 0xffffu) + qa[3] * bf2f(kk.y >> 16)
                          + qb[0] * bf2f(kk.z & 0xffffu) + qb[1] * bf2f(kk.z >> 16) + qb[2] * bf2f(kk.w & 0xffffu) + qb[3] * bf2f(kk.w >> 16); }
            }
#pragma unroll
            for (int j = 0; j < 8; ++j) { const int kj = kw + 8 * j; float sv = s[j] * scale;
                if (BAND) { int rel = (c * 64 + qi) - (kc * 64 + kj); rel = rel < -63 ? -63 : (rel > 256 ? 256 : rel); sv += bS[rel + 63]; }
                Ss[qi * 65 + kj] = sv; }
            __syncthreads();
            if (tid < 64) { float mo = mS[tid], mx = mo;
                for (int j = 0; j < 64; ++j) mx = fmaxf(mx, Ss[tid * 65 + j]);
                const float al = __expf(mo - mx); float sum = 0.f;
                for (int j = 0; j < 64; ++j) { const float p = __expf(Ss[tid * 65 + j] - mx); Ss[tid * 65 + j] = p; sum += p; }
                lS[tid] = lS[tid] * al + sum; mS[tid] = mx; aS[tid] = al; }
            __syncthreads();
            { const float al = aS[qi];
#pragma unroll
              for (int d = 0; d < DG; ++d) o[d] *= al;
              for (int kj = 0; kj < 64; ++kj) { const float p = Ss[qi * 65 + kj];
#pragma unroll
                  for (int d8 = 0; d8 < DG / 8; ++d8) { const u32x4 vv = *(const LAS u32x4*)(Vs + kj * VS + kw * DG + d8 * 8);
                      o[d8 * 8 + 0] += p * bf2f(vv.x & 0xffffu); o[d8 * 8 + 1] += p * bf2f(vv.x >> 16); o[d8 * 8 + 2] += p * bf2f(vv.y & 0xffffu); o[d8 * 8 + 3] += p * bf2f(vv.y >> 16);
                      o[d8 * 8 + 4] += p * bf2f(vv.z & 0xffffu); o[d8 * 8 + 5] += p * bf2f(vv.z >> 16); o[d8 * 8 + 6] += p * bf2f(vv.w & 0xffffu); o[d8 * 8 + 7] += p * bf2f(vv.w >> 16); } } }
        }
        { const float li = 1.0f / lS[qi]; bf16_t* op = O + (row0 + qi) * ldo + h * DV + kw * DG;
#pragma unroll
          for (int d8 = 0; d8 < DG / 8; ++d8) { u32x4 w; w.x = pk2(o[d8 * 8 + 0] * li, o[d8 * 8 + 1] * li); w.y = pk2(o[d8 * 8 + 2] * li, o[d8 * 8 + 3] * li);
              w.z = pk2(o[d8 * 8 + 4] * li, o[d8 * 8 + 5] * li); w.w = pk2(o[d8 * 8 + 6] * li, o[d8 * 8 + 7] * li); *(u32x4*)(op + d8 * 8) = w; } }
    }
    __syncthreads();
}


namespace att {
typedef float f32x16 __attribute__((ext_vector_type(16)));
typedef short v4i16_t __attribute__((ext_vector_type(4)));
constexpr float THR = 8.0f;
__device__ __forceinline__ float vmax3(float a, float b, float c) { float r; asm("v_max3_f32 %0, %1, %2, %3" : "=v"(r) : "v"(a), "v"(b), "v"(c)); return r; }
__device__ __forceinline__ int crow(int r, int hi) { return (r & 3) + 8 * (r >> 2) + 4 * hi; }
__device__ __forceinline__ s16x4 vtr(const LAS unsigned char* p) { return __builtin_bit_cast(s16x4, __builtin_amdgcn_ds_read_tr16_b64_v4i16((LAS v4i16_t*)p)); }
__device__ __forceinline__ unsigned cvtpk(float lo, float hi) { typedef __bf16 bf16x2_t __attribute__((ext_vector_type(2))); f32x2 v = {lo, hi}; bf16x2_t b = __builtin_convertvector(v, bf16x2_t); return __builtin_bit_cast(unsigned, b); }

template <int DQK, int BS>
__device__ __forceinline__ void qk_tile(const LAS unsigned char* Kb, const bf16x8 (&qr)[DQK / 16], f32x16& p0, f32x16& p1, const int r32, const int hi) {
#pragma unroll
    for (int r = 0; r < 16; ++r) { p0[r] = 0.f; p1[r] = 0.f; }
    const LAS unsigned char* kp = Kb + hi * 1024 + r32 * 16;
    if constexpr (BS == 0) {
#pragma unroll
        for (int d0 = 0; d0 < DQK / 16; ++d0) { const bf16x8 b0 = *(const LAS bf16x8*)(kp + d0 * 2048), b1 = *(const LAS bf16x8*)(kp + d0 * 2048 + 512);
            p0 = __builtin_amdgcn_mfma_f32_32x32x16_bf16(b0, qr[d0], p0, 0, 0, 0); p1 = __builtin_amdgcn_mfma_f32_32x32x16_bf16(b1, qr[d0], p1, 0, 0, 0); }
        return; }
    constexpr int NB = DQK / 16 / (BS ? BS : 1);
    bf16x8 fa[2 * (BS ? BS : 1)], fb[2 * (BS ? BS : 1)];
#define QK_LD(f, g) do { _Pragma("unroll") for (int i_ = 0; i_ < BS; ++i_) { f[2 * i_] = *(const LAS bf16x8*)(kp + ((g) * BS + i_) * 2048); f[2 * i_ + 1] = *(const LAS bf16x8*)(kp + ((g) * BS + i_) * 2048 + 512); } } while (0)
#define QK_MM(f, g) do { _Pragma("unroll") for (int i_ = 0; i_ < BS; ++i_) { p0 = __builtin_amdgcn_mfma_f32_32x32x16_bf16(f[2 * i_], qr[(g) * BS + i_], p0, 0, 0, 0); p1 = __builtin_amdgcn_mfma_f32_32x32x16_bf16(f[2 * i_ + 1], qr[(g) * BS + i_], p1, 0, 0, 0); } } while (0)
    QK_LD(fa, 0);
#pragma unroll
    for (int g = 0; g < NB; g += 2) {
        if (g + 1 < NB) { QK_LD(fb, g + 1); __builtin_amdgcn_sched_barrier(0); }
        QK_MM(fa, g); __builtin_amdgcn_sched_barrier(0);
        if (g + 2 < NB) { QK_LD(fa, g + 2); __builtin_amdgcn_sched_barrier(0); }
        if (g + 1 < NB) { QK_MM(fb, g + 1); __builtin_amdgcn_sched_barrier(0); }
    }
#undef QK_LD
#undef QK_MM
}
template <int DV, bool BIAS, bool VDB = true>
__device__ __forceinline__ void sm_pv_tile(f32x16& p0, f32x16& p1, const LAS unsigned char* Vb, f32x16 (&o)[DV / 32], float& m, float& l, const float C,
                                           const LAS float* btab, const int bbase, LAS float* wsf, const int r32, const int hi, const int lane) {
    if (BIAS) {
#pragma unroll
        for (int r = 0; r < 16; ++r) { const int kj = crow(r, hi); p0[r] = fmaf(p0[r], C, btab[bbase - kj]); p1[r] = fmaf(p1[r], C, btab[bbase - kj - 32]); }
    }
    float pm, pq;
    pm = vmax3(p0[0], p0[1], p0[2]); pq = vmax3(p1[0], p1[1], p1[2]);
#pragma unroll
    for (int r = 3; r < 15; r += 2) { pm = vmax3(pm, p0[r], p0[r + 1]); pq = vmax3(pq, p1[r], p1[r + 1]); }
    pm = vmax3(pm, p0[15], pq); pm = fmaxf(pm, p1[15]);
    { auto rr = __builtin_amdgcn_permlane32_swap(__float_as_uint(pm), __float_as_uint(pm), false, false); pm = fmaxf(__uint_as_float(rr[0]), __uint_as_float(rr[1])); }
    if (!BIAS) pm *= C;
    if (__any(pm > m + THR)) {
        const float mn = fmaxf(m, pm), al = __builtin_amdgcn_exp2f(m - mn); m = mn; l *= al;
        if (hi == 0) wsf[r32] = al;
        asm volatile("s_waitcnt lgkmcnt(0)" ::: "memory");
#pragma unroll
        for (int r = 0; r < 16; ++r) { const float a = wsf[crow(r, hi)];
#pragma unroll
            for (int d = 0; d < DV / 32; ++d) o[d][r] *= a; }
    }
    const float nm = -m;
    { const f32x2 nm2 = (f32x2){nm, nm}, C2 = (f32x2){C, C}; f32x2 sa = (f32x2){0.f, 0.f}, sb = (f32x2){0.f, 0.f};
#pragma unroll
      for (int i = 0; i < 8; ++i) { f32x2 a = (f32x2){p0[2 * i], p0[2 * i + 1]}, b = (f32x2){p1[2 * i], p1[2 * i + 1]};
          if (BIAS) { a = a + nm2; b = b + nm2; } else { a = a * C2 + nm2; b = b * C2 + nm2; }
          a.x = __builtin_amdgcn_exp2f(a.x); a.y = __builtin_amdgcn_exp2f(a.y); b.x = __builtin_amdgcn_exp2f(b.x); b.y = __builtin_amdgcn_exp2f(b.y);
          p0[2 * i] = a.x; p0[2 * i + 1] = a.y; p1[2 * i] = b.x; p1[2 * i + 1] = b.y; sa += a; sb += b; }
      sa += sb; l += sa.x + sa.y; }
#define PV_PK(ks_) ({ u32x4 w_; if ((ks_) < 2) { const int b_ = 8 * (ks_); w_.x = cvtpk(p0[b_], p0[b_ + 1]); w_.y = cvtpk(p0[b_ + 2], p0[b_ + 3]); w_.z = cvtpk(p0[b_ + 4], p0[b_ + 5]); w_.w = cvtpk(p0[b_ + 6], p0[b_ + 7]); } \
        else { const int b_ = 8 * ((ks_) - 2); w_.x = cvtpk(p1[b_], p1[b_ + 1]); w_.y = cvtpk(p1[b_ + 2], p1[b_ + 3]); w_.z = cvtpk(p1[b_ + 4], p1[b_ + 5]); w_.w = cvtpk(p1[b_ + 6], p1[b_ + 7]); } __builtin_bit_cast(bf16x8, w_); })
    bf16x8 pa[4];
    if constexpr (VDB) {
#pragma unroll
        for (int ks = 0; ks < 4; ++ks) pa[ks] = PV_PK(ks); }
    const LAS unsigned char* vp = Vb + ((lane >> 4) & 1) * 32 + (lane & 3) * 8 + (4 * hi + ((lane & 15) >> 2)) * 64;
    bf16x8 va[4], vb[4];
#define PV_LD(f, d0_) do { _Pragma("unroll") for (int ks_ = 0; ks_ < 4; ++ks_) { const s16x4 lo_ = vtr(vp + ((d0_) * 4 + ks_) * 1024), hh_ = vtr(vp + ((d0_) * 4 + ks_) * 1024 + 512); \
        f[ks_] = (bf16x8){lo_[0], lo_[1], lo_[2], lo_[3], hh_[0], hh_[1], hh_[2], hh_[3]}; } } while (0)
#define PV_MM(f, d0_) do { _Pragma("unroll") for (int ks_ = 0; ks_ < 4; ++ks_) o[d0_] = __builtin_amdgcn_mfma_f32_32x32x16_bf16(pa[ks_], f[ks_], o[d0_], 0, 0, 0); } while (0)
    if constexpr (!VDB) {
#pragma unroll
        for (int ks = 0; ks < 4; ++ks) { const bf16x8 pk_ = PV_PK(ks);
#pragma unroll
            for (int d0 = 0; d0 < DV / 32; ++d0) { const s16x4 lo_ = vtr(vp + (d0 * 4 + ks) * 1024), hh_ = vtr(vp + (d0 * 4 + ks) * 1024 + 512);
                o[d0] = __builtin_amdgcn_mfma_f32_32x32x16_bf16(pk_, (bf16x8){lo_[0], lo_[1], lo_[2], lo_[3], hh_[0], hh_[1], hh_[2], hh_[3]}, o[d0], 0, 0, 0); } }
    } else {
    PV_LD(va, 0);
#pragma unroll
    for (int d0 = 0; d0 < DV / 32; d0 += 2) {
        PV_LD(vb, d0 + 1); __builtin_amdgcn_sched_barrier(0); PV_MM(va, d0); __builtin_amdgcn_sched_barrier(0);
        if (d0 + 2 < DV / 32) { PV_LD(va, d0 + 2); __builtin_amdgcn_sched_barrier(0); }
        PV_MM(vb, d0 + 1); __builtin_amdgcn_sched_barrier(0);
    }
    }
#undef PV_LD
#undef PV_MM
#undef PV_PK
}

template <int DQK, int DV, int NHU, bool BIAS, bool PIPE, int ORD>
__device__ __forceinline__ void attn_unit(LAS unsigned char* lds, const unsigned ldsb, const int tid, const int lane, const int wid, const bf16_t* Q, const int ldq, const bf16_t* K, const int ldk, const bf16_t* V, const int ldv, const int vhs,
                                          bf16_t* O, const int ldo, const float* bias, const float C, const int b, const int head0, const int cbase, const unsigned klane, const unsigned vlane, const int probe = 0, const bool fill_bias = true) {
    constexpr int KBLK = DQK / 8, VBLK = DV / 8, KSZ = NHU * KBLK * 1024, VSZ = NHU * VBLK * 1024, SLOT = KSZ + VSZ, CPU_ = 4 / NHU, DPW = NHU * (KBLK + VBLK) / 8;
    const int r32 = lane & 31, hi = lane >> 5;
    const int hh = NHU == 2 ? (wid >> 2) : 0, cj = NHU == 2 ? ((wid >> 1) & 1) : (wid >> 1), half = wid & 1;
    LAS float* wsf = (LAS float*)(lds + 3 * SLOT) + wid * 64;
    LAS float* btab = (LAS float*)(lds + 3 * SLOT + 2048);
    const int cq = cbase + cj, kc_hi = cbase + CPU_ - 1;
    const int kc_lo = BIAS ? (cbase - 8 > 0 ? cbase - 8 : 0) : 0, w_lo = BIAS ? (cq - 8 > 0 ? cq - 8 : 0) : 0;
    const size_t qrow0 = (size_t)b * SEQ + (size_t)cq * 64 + half * 32;
    bf16x8 qr[DQK / 16];
    { const bf16_t* qp = Q + (qrow0 + r32) * ldq + (head0 + hh) * DQK + hi * 8;
#pragma unroll
      for (int d0 = 0; d0 < DQK / 16; ++d0) qr[d0] = *(const bf16x8*)(qp + d0 * 16);
#pragma unroll
      for (int d0 = 0; d0 < DQK / 16; ++d0) asm volatile("s_waitcnt vmcnt(0)" : "+v"(qr[d0])); }
    if (BIAS && fill_bias) for (int idx = tid; idx < NHU * 640; idx += 512) { const int h2 = idx / 640, i = idx % 640; btab[idx] = bias[(head0 + h2) * NREL + (i < NREL - 1 ? i : NREL - 1)] * 1.4426950408889634f; }
    f32x16 o[DV / 32];
#pragma unroll
    for (int d = 0; d < DV / 32; ++d)
#pragma unroll
        for (int r = 0; r < 16; ++r) o[d][r] = 0.f;
    float m = -1.0e30f, l = 0.f;
#define ATT_DMA(kc_, slot_) do { const int so_ = (slot_) * SLOT; \
    _Pragma("unroll") for (int j_ = 0; j_ < NHU * KBLK / 8; ++j_) { const int id_ = wid + 8 * j_, hd_ = id_ / KBLK, bi_ = id_ % KBLK; \
        glds16_s(klane, (const char*)(K + ((size_t)((b * ldk + head0 + hd_) * NCHK + (kc_)) * KBLK + bi_) * 512), ldsb + (unsigned)(so_ + id_ * 1024)); } \
    _Pragma("unroll") for (int j_ = 0; j_ < NHU * VBLK / 8; ++j_) { const int id_ = wid + 8 * j_, hd_ = id_ / VBLK, vb_ = id_ % VBLK; \
        glds16_s(vlane, (const char*)(V + ((size_t)((b * ldk + head0 + hd_) * NCHK + (kc_)) * VBLK + vb_) * 512), ldsb + (unsigned)(so_ + KSZ + id_ * 1024)); } } while (0)
    constexpr int QBS = DQK > 64 ? 2 : 4;
    if constexpr (!PIPE) {
    f32x16 p0, p1;
#pragma unroll
    for (int r = 0; r < 16; ++r) { p0[r] = 0.f; p1[r] = 0.f; }
    int s_cur = 0, s_nn = 2;
    if (probe != 2) { ATT_DMA(kc_lo, 0); if (kc_lo + 1 <= kc_hi) ATT_DMA(kc_lo + 1, 1); }
    for (int kc = kc_lo; kc <= kc_hi; ++kc) {
        if (kc + 1 <= kc_hi) asm volatile("s_waitcnt vmcnt(%0) lgkmcnt(0)\n\ts_barrier" :: "n"(DPW) : "memory");
        else                 asm volatile("s_waitcnt vmcnt(0) lgkmcnt(0)\n\ts_barrier" ::: "memory");
        if (kc + 2 <= kc_hi && probe != 2) ATT_DMA(kc + 2, s_nn);
        if (kc >= w_lo && kc <= cq && probe != 1) {
            const LAS unsigned char* Kb = lds + s_cur * SLOT + hh * KBLK * 1024; const LAS unsigned char* Vb = lds + s_cur * SLOT + KSZ + hh * VBLK * 1024;
            if (probe == 5 || probe == 6) {
                if (probe == 5) {
#pragma unroll
                    for (int d0 = 0; d0 < DQK / 16; ++d0) { p0 = __builtin_amdgcn_mfma_f32_32x32x16_bf16(qr[d0], qr[d0], p0, 0, 0, 0); p1 = __builtin_amdgcn_mfma_f32_32x32x16_bf16(qr[d0], qr[d0], p1, 0, 0, 0); } }
                else { const LAS unsigned char* kp = Kb + hi * 1024 + r32 * 16; bf16x8 acc_ = qr[0];
#pragma unroll
                    for (int d0 = 0; d0 < DQK / 16; ++d0) { const bf16x8 b0 = *(const LAS bf16x8*)(kp + d0 * 2048), b1 = *(const LAS bf16x8*)(kp + d0 * 2048 + 512); acc_ ^= b0 ^ b1; }
                    asm volatile("" :: "v"(acc_)); }
            }
            else if (probe != 4) { qk_tile<DQK, QBS>(Kb, qr, p0, p1, r32, hi); __builtin_amdgcn_sched_barrier(0); }
            if (probe == 5 || probe == 6) { asm volatile("" : "+v"(p0), "+v"(p1)); }
            else if (probe != 3) sm_pv_tile<DV, BIAS>(p0, p1, Vb, o, m, l, C, btab + hh * 640, (cq - kc) * 64 + half * 32 + r32 + 63, wsf, r32, hi, lane);
            else { asm volatile("" : "+v"(p0), "+v"(p1)); }
        }
        s_cur = s_cur == 2 ? 0 : s_cur + 1; s_nn = s_nn == 2 ? 0 : s_nn + 1;
    }
    } else {
    f32x16 pA0, pA1, pB0, pB1;
#pragma unroll
    for (int r = 0; r < 16; ++r) { pA0[r] = 0.f; pA1[r] = 0.f; pB0[r] = 0.f; pB1[r] = 0.f; }
    int s_cur = 0, s_n1 = 1, s_nn = 2;
#define ATT_ADV() do { const int t_ = s_cur; s_cur = s_n1; s_n1 = s_nn; s_nn = t_; } while (0)
#define ATT_SYNC(kc_) do { asm volatile("s_waitcnt vmcnt(0) lgkmcnt(0)\n\ts_barrier" ::: "memory");     \
        if ((kc_) + 2 <= kc_hi) ATT_DMA((kc_) + 2, s_nn); } while (0)
#define ATT_A(N0, N1) qk_tile<DQK, QBS>(lds + s_n1 * SLOT + hh * KBLK * 1024, qr, N0, N1, r32, hi)
#define ATT_B(C0, C1, kc_) sm_pv_tile<DV, BIAS, (DQK <= 64)>(C0, C1, lds + s_cur * SLOT + KSZ + hh * VBLK * 1024, o, m, l, C, btab + hh * 640, (cq - (kc_)) * 64 + half * 32 + r32 + 63, wsf, r32, hi, lane)
#define ATT_AB(N0, N1, C0, C1, kc_) do { if (ORD == 0) { ATT_A(N0, N1); __builtin_amdgcn_sched_barrier(0); ATT_B(C0, C1, kc_); } else { ATT_B(C0, C1, kc_); __builtin_amdgcn_sched_barrier(0); ATT_A(N0, N1); } } while (0)
    ATT_DMA(kc_lo, 0); if (kc_lo + 1 <= kc_hi) ATT_DMA(kc_lo + 1, 1);
    if (kc_lo + 1 <= kc_hi) asm volatile("s_waitcnt vmcnt(%0) lgkmcnt(0)\n\ts_barrier" :: "n"(DPW) : "memory"); else asm volatile("s_waitcnt vmcnt(0) lgkmcnt(0)\n\ts_barrier" ::: "memory");
    int kc = kc_lo;
    if (w_lo == kc_lo) { qk_tile<DQK, QBS>(lds + hh * KBLK * 1024, qr, pA0, pA1, r32, hi); }
    else { for (; kc < w_lo - 1; ++kc) { ATT_SYNC(kc); ATT_ADV(); } ATT_SYNC(kc); ATT_A(pA0, pA1); ATT_ADV(); ++kc; }
    int n = cq - w_lo;
    if (n & 1) { ATT_SYNC(kc); ATT_AB(pB0, pB1, pA0, pA1, kc); ATT_ADV(); ++kc; --n; pA0 = pB0; pA1 = pB1; }
    for (; n > 0; n -= 2) {
        ATT_SYNC(kc); ATT_AB(pB0, pB1, pA0, pA1, kc); ATT_ADV(); ++kc;
        ATT_SYNC(kc); ATT_AB(pA0, pA1, pB0, pB1, kc); ATT_ADV(); ++kc; }
    ATT_SYNC(kc); ATT_B(pA0, pA1, kc); ATT_ADV(); ++kc;
    for (; kc <= kc_hi; ++kc) { ATT_SYNC(kc); ATT_ADV(); }
#undef ATT_ADV
#undef ATT_SYNC
#undef ATT_A
#undef ATT_B
#undef ATT_AB
    }
#undef ATT_DMA
    { auto rr = __builtin_amdgcn_permlane32_swap(__float_as_uint(l), __float_as_uint(l), false, false); l = __uint_as_float(rr[0]) + __uint_as_float(rr[1]); }
    if (hi == 0) wsf[32 + r32] = 1.0f / l;
    asm volatile("s_waitcnt lgkmcnt(0)" ::: "memory");
    int r32s = r32, his = hi; asm volatile("" : "+v"(r32s), "+v"(his));
    bf16_t* op = O + qrow0 * ldo + (head0 + hh) * DV + r32s;
    if (probe == 0) {
    if (vhs) {
    unsigned char* op8 = (unsigned char*)O + qrow0 * ldo + (head0 + hh) * DV + r32s;
#pragma unroll
    for (int r = 0; r < 16; ++r) { const int q = crow(r, his); const float rl = wsf[32 + q] * 16.0f;
#pragma unroll
        for (int d0 = 0; d0 < DV / 32; ++d0) { const float v_ = __builtin_amdgcn_fmed3f(o[d0][r] * rl, -448.0f, 448.0f); op8[(size_t)q * ldo + d0 * 32] = (unsigned char)(__builtin_amdgcn_cvt_pk_fp8_f32(v_, v_, 0u, false) & 0xffu); } }
    } else {
#pragma unroll
    for (int r = 0; r < 16; ++r) { const int q = crow(r, his); const float rl = wsf[32 + q];
#pragma unroll
        for (int d0 = 0; d0 < DV / 32; ++d0) op[(size_t)q * ldo + d0 * 32] = (bf16_t)f2bf(o[d0][r] * rl); } } }
}
template <int DQK, int DV, int NHU, bool BIAS, bool PIPE>
__device__ __forceinline__ void attn_mfma(const Frame& F, const bf16_t* Q, int ldq, const bf16_t* K, int ldk, const bf16_t* V, int ldv, int vhs, bf16_t* O, int ldo, int nheads, const float* bias, const float C, const int probe = 0) {
    constexpr int CPU_ = 4 / NHU;
    const int lane = F.lane, wid = F.wave;
    LAS unsigned char* lds = F.lds;
    const unsigned ldsb = (unsigned)__builtin_amdgcn_readfirstlane((int)(unsigned)(uintptr_t)lds);
    const int nunits = NBATCH * (nheads / NHU) * (NCHK / CPU_);
    const unsigned klane = (unsigned)lane * 16u, vlane = klane;
    int prev_h0 = -1;
    for (int L = F.vcu; L < nunits; L += F.G) {
        int b, head0, cbase;
        if (NHU == 1) { const int vv = L & 255, ii = L >> 8, c8 = vv & 7, grp = vv >> 3;
            const int bh = grp * 4 + ii, qb = (ii & 1) ? 7 - c8 : c8;
            b = bh / nheads; head0 = bh % nheads; cbase = qb * 4; }
        else { const int vv = L & 255, bhp = vv >> 1, g = 2 * (L >> 8) + (vv & 1); b = bhp >> 3; head0 = (bhp & 7) * 2; cbase = g * 2; }
        asm volatile("s_waitcnt lgkmcnt(0)\n\ts_barrier" ::: "memory");
        if constexpr (PIPE) { if (wid < 4) attn_unit<DQK, DV, NHU, BIAS, true, 0>(lds, ldsb, F.tid, lane, wid, Q, ldq, K, ldk, V, ldv, vhs, O, ldo, bias, C, b, head0, cbase, klane, vlane, probe, head0 != prev_h0);
                              else         attn_unit<DQK, DV, NHU, BIAS, true, 1>(lds, ldsb, F.tid, lane, wid, Q, ldq, K, ldk, V, ldv, vhs, O, ldo, bias, C, b, head0, cbase, klane, vlane, probe, head0 != prev_h0); }
        else attn_unit<DQK, DV, NHU, BIAS, false, 0>(lds, ldsb, F.tid, lane, wid, Q, ldq, K, ldk, V, ldv, vhs, O, ldo, bias, C, b, head0, cbase, klane, vlane, probe, head0 != prev_h0);
        prev_h0 = head0;
    }
    asm volatile("s_waitcnt vmcnt(0) lgkmcnt(0)\n\ts_barrier" ::: "memory");
}
}

struct Args { const void* in[50]; float* out; unsigned char* ws; int ph_lo, ph_hi; };
#define NAIVE(g) (((NAIVE_MASK) >> (g)) & 1)
constexpr int N_PHASES = 2 * (13 + NAIVE(5)) + 1;

__global__ void __launch_bounds__(512, 2) fwd(Args args) {
    extern __shared__ __attribute__((aligned(16))) unsigned char lds_raw[];
    Frame F;
    F.lds = (LAS unsigned char*)lds_raw;
    F.tid = threadIdx.x; F.lane = F.tid & 63; F.wave = __builtin_amdgcn_readfirstlane(F.tid >> 6);
    F.G = gridDim.x; { const int bx = blockIdx.x; F.vcu = (F.G % 8 == 0) ? (bx % 8) * (F.G / 8) + bx / 8 : bx; }
    F.gw = F.vcu * 8 + F.wave; F.NGW = F.G * 8;
    volatile LAS unsigned* MISC = (volatile LAS unsigned*)(F.lds + MISC_OFF);
    gu32* ctl = (gu32*)(args.ws + WS_CTL);
    for (int u = F.tid; u < (LDS_BYTES - LDSCTL_OFF) / 4; u += 512) ((LAS unsigned*)(F.lds + LDSCTL_OFF))[u] = 0u;
    __syncthreads();
    XcdBarrier bar; bar.bar = (unsigned*)(ctl + CW_BAR); bar.x = 0; bar.st = nullptr;
    if (!MK_PER_PHASE) bar = xcd_barrier_post((unsigned*)(ctl + CW_BAR), MISC + 8);
    const int lo = args.ph_lo, hi = args.ph_hi;
    int ph = 0;
#ifndef PH_MASK
#define PH_MASK 0xFFFFFFFFu
#endif
#ifndef DUP_MASK
#define DUP_MASK 0u
#endif
#ifndef EPI_PROBE
#define EPI_PROBE 0
#endif
#ifndef E0_PROBE
#define E0_PROBE 0
#endif
#ifndef BAR_PROBE
#define BAR_PROBE 0
#endif
#ifndef ATT_PROBE
#define ATT_PROBE 0
#endif
#define PHASE_BEGIN(k) if (ph >= lo && ph < hi) { if ((PH_MASK >> (k)) & 1u) for (int rep_ = 0; rep_ < 1 + (int)((DUP_MASK >> (k)) & 1u); ++rep_) { asm volatile("; PHASE_MARK %0" :: "n"(k)); { unsigned z_ = 0u; asm volatile("" : "+v"(z_)); F.lane = (int)__builtin_amdgcn_mbcnt_hi(~0u, __builtin_amdgcn_mbcnt_lo(~0u, z_)); } F.tid = F.wave * 64 + F.lane; asm volatile("" : "+s"(F.wave), "+s"(F.vcu), "+s"(F.gw));
#define PHASE_END   } if (!MK_PER_PHASE && ph + 1 < hi) { unsigned z_ = 0u; asm volatile("" : "+v"(z_)); xcd_barrier(bar, (int)(F.wave * 64 + __builtin_amdgcn_mbcnt_hi(~0u, __builtin_amdgcn_mbcnt_lo(~0u, z_)))); if (BAR_PROBE) xcd_barrier(bar, (int)(F.wave * 64 + __builtin_amdgcn_mbcnt_hi(~0u, __builtin_amdgcn_mbcnt_lo(~0u, z_)))); } } ++ph;

#define XB2 ((bf16_t*)args.out)
#define H8B ((unsigned char*)args.out + (size_t)64 * MiB)
#define H ((bf16_t*)(args.ws + WS_H))
#define W (args.ws + WS_W)
#define BIG (args.ws + WS_BIG)
#define route_e ((int*)(args.ws + WS_ROUTE_E))
#define route_p ((int*)(args.ws + WS_ROUTE_P))
#define route_w ((float*)(args.ws + WS_ROUTE_W))
#define perm_g ((int*)(args.ws + WS_PERM))
#define Ybuf ((bf16_t*)(BIG + B_Y))
#define positions ((const int*)args.in[1])

#pragma unroll 1
    for (int lp = 0; lp < 2; ++lp) {
#define FFN8 (((FFN8_MASK) >> lp) & 1)
#define QKV8 (((QKV8_MASK) >> lp) & 1)
#define AO8 (((AO8_MASK) >> lp) & 1)
#define IN8 (((IN8_MASK) >> lp) & 1)
#define MLAUP8 (((MLAUP8_MASK) >> lp) & 1)
#define BO8 (((BO8_MASK) >> lp) & 1)
#define EIN(k) ((const float*)args.in[2 + lp * 24 + (k)])
#define OIN(k) ((const float*)args.in[15 + lp * 24 + (k)])
#define e_attn_norm EIN(0)
#define e_w_in EIN(1)
#define e_qa EIN(2)
#define e_kva EIN(3)
#define e_w_uq EIN(4)
#define e_w_ukv EIN(5)
#define e_qn EIN(6)
#define e_kn EIN(7)
#define e_w_o EIN(8)
#define e_ffn_norm EIN(9)
#define e_wg EIN(10)
#define e_wu EIN(11)
#define e_wd EIN(12)
#define o_attn_norm OIN(0)
#define o_w_qkv OIN(1)
#define o_qn OIN(2)
#define o_kn OIN(3)
#define o_bias OIN(4)
#define o_w_o OIN(5)
#define o_ffn_norm OIN(6)
#define o_router OIN(7)
#define o_wg OIN(8)
#define o_wu OIN(9)
#define o_wd OIN(10)
#define cnt_prev (ctl + CW_CNT + (lp ? (lp - 1) : 0) * 512)
#define cnt_cur (ctl + CW_CNT + lp * 512)
#define A1 ((bf16_t*)(BIG + B_A1))
#define VM ((bf16_t*)(BIG + B_VM))
#define QN ((bf16_t*)(BIG + B_QN))
#define KN ((bf16_t*)(BIG + B_KN))
#define OM ((bf16_t*)(BIG + B_OM))
#define ACT ((bf16_t*)(BIG + B_ACT))
#define CQ ((bf16_t*)(BIG + B_CQ))
#define CK ((bf16_t*)(BIG + B_CK))
#define CV ((bf16_t*)(BIG + B_CV))
#define CO ((bf16_t*)(BIG + B_CO))
        PHASE_BEGIN(0)
          for (int r2_ = 0; r2_ < ((E0_PROBE && lp == 0) ? 2 : 1); ++r2_) {
            { EvenConv ec{e_w_in, e_w_uq, e_qa, e_w_ukv, e_kva, e_w_o, e_wg, e_wu, e_ffn_norm, e_wd, (unsigned char*)W, MLAUP8, AO8, FFN8, IN8, e_attn_norm}; conv_even(F, ec); }
            MoeCombine mc; mc.re = route_e; mc.rp = route_p; mc.rw = route_w; mc.Y = Ybuf;
            static_assert((IN8_MASK) == 0, "the input projection reads the raw bf16 residual rows (rstd in its epilogue, gain folded into w_in)");
            if (lp == 0) { res_rows<false, false, true, false, false>(F, args.in[0], XB2, nullptr, nullptr, nullptr, mc, false, (float*)(args.ws + WS_SSX)); }
            else { mc.mi.load(cnt_prev); res_rows<true, true, true, false, false>(F, H, XB2, nullptr, nullptr, nullptr, mc, false, (float*)(args.ws + WS_SSX)); }
          }
        PHASE_END
        PHASE_BEGIN(1)
            if (NAIVE(0)) { naive_gemm<false>(F, T_ / 64, AIN, DM, H, DM, [](int r) { return r; }, [&](int, const float*& b1, const float*& b2) { b1 = e_w_in; b2 = e_w_in; }, AIN,
                              [&](int r, int c, float v, float) { A1[(size_t)r * AINP + c] = (bf16_t)f2bf(v); }); }
            else { pg8::Gemm g{(const char*)XB2, (const char*)(W + WE_IN), DM, DM, DM, 2, 0u, 0u}; pg8::DenseOrder S; S.init(T_ / 256, AINP / 256, F.G, (int)blockIdx.x);
                static_assert((MLAUP8_MASK) == 0, "the fp8 input projection below stores bf16 latents");
                pg8::EpiA1<false> E{A1, AINP, (float*)(args.ws + WS_SSQ), (const float*)(args.ws + WS_SSX), (LAS float*)(F.lds + LDSCTL_OFF + 8192)};
                if (((IN8_MASK) != 0) && IN8) { g.A = (const char*)H8B; g.es = 1; E.iscale = 1.0f / 4096.0f; pg8::gemm_phase<pg8::EpiA1<false>, pg8::DenseOrder, false, true>(F.lds, F.wave, g, S, E); }
                else if ((IN8_MASK) != 3) pg8::gemm_phase<pg8::EpiA1<false>, pg8::DenseOrder, false>(F.lds, F.wave, g, S, E); }
        PHASE_END
        PHASE_BEGIN(3)
            { { LAS float* GL = (LAS float*)(F.lds + LDSCTL_OFF + 5120); if (F.tid < QKD) { GL[F.tid] = e_qn[F.tid]; GL[192 + F.tid] = e_kn[F.tid]; } __syncthreads(); }
              pg8::Gemm g{(const char*)A1, (const char*)(W + WE_QKVF), 256, AINP, 256, 2, 0u, 0u}; pg8::MlaOrder S; S.d.init(T_ / 256, 20, F.G, (int)blockIdx.x);
              pg8::EpiMlaQKV E{(LAS float*)(F.lds + LDSCTL_OFF + 1024), QN, (size_t)(B_KN - B_QN) / 2, VM, (const float*)(args.ws + WS_SSQ), e_qn, e_kn, positions, (LAS float*)(F.lds + LDSCTL_OFF + 8192)};
              if (((MLAUP8_MASK) != 0) && MLAUP8) { g.es = 1; E.iscale = 1.0f / 4096.0f; pg8::gemm_phase<pg8::EpiMlaQKV, pg8::MlaOrder, false, true>(F.lds, F.wave, g, S, E); }
              else if ((MLAUP8_MASK) != 3) { E.nostore = rep_ && EPI_PROBE == 2; pg8::gemm_phase<pg8::EpiMlaQKV, pg8::MlaOrder, false>(F.lds, F.wave, g, S, E); } }
        PHASE_END
        PHASE_BEGIN(5)
#if NAIVE_ATTN & 1
            attn_naive<QKD, VD, false>(F, QN, 1536, KN, 1536, VM, DM, OM, DM, MLA_H, nullptr, 0.07216878364870322f);
#else
            att::attn_mfma<QKD, VD, 1, false, MLA_PIPE>(F, QN, 1536, KN, MLA_H, VM, 0, AO8, OM, DM, MLA_H, nullptr, 0.07216878364870322f * 1.4426950408889634f, rep_ ? ATT_PROBE : 0);
#endif
        PHASE_END
        PHASE_BEGIN(6)
            if (NAIVE(2)) { naive_gemm<false>(F, T_ / 64, DM, DM, OM, DM, [](int r) { return r; }, [&](int, const float*& b1, const float*& b2) { b1 = e_w_o; b2 = e_w_o; }, DM,
                              [&](int r, int c, float v, float) { H[(size_t)r * DM + c] = (bf16_t)f2bf(bf2f(H[(size_t)r * DM + c]) + v); }); }
            else { pg8::Gemm g{(const char*)OM, (const char*)(W + WE_O), DM, DM, DM, 2, 0u, 0u}; pg8::DenseOrder S; S.init(T_ / 256, DM / 256, F.G, (int)blockIdx.x);
                const bf16_t* xin_ = rep_ ? H : XB2; const float sc_ = rep_ ? 0.0f : 1.0f; float* ssx_ = (float*)(args.ws + WS_SSX); LAS float* P_ = (LAS float*)(F.lds + LDSCTL_OFF + 8192);
                if (HAS_G3(1, 1) && AO8 && FFN8) { g.es = 1; pg8::EpiResid16<true, true> E{xin_, H, ssx_, P_, sc_ / 4096.0f, H8B}; pg8::gemm_phase<pg8::EpiResid16<true, true>, pg8::DenseOrder, false, true>(F.lds, F.wave, g, S, E); }
                else if (HAS_G3(1, 0) && AO8) { g.es = 1; pg8::EpiResid16<true> E{xin_, H, ssx_, P_, sc_ / 4096.0f}; pg8::gemm_phase<pg8::EpiResid16<true>, pg8::DenseOrder, false, true>(F.lds, F.wave, g, S, E); }
                else if (HAS_G3(0, 1) && FFN8) { pg8::EpiResid16<true, true> E{xin_, H, ssx_, P_, sc_, H8B}; pg8::gemm_phase<pg8::EpiResid16<true, true>, pg8::DenseOrder, false>(F.lds, F.wave, g, S, E); }
                else if (HAS_G3(0, 0)) { pg8::EpiResid16<true> E{xin_, H, ssx_, P_, sc_}; pg8::gemm_phase<pg8::EpiResid16<true>, pg8::DenseOrder, false>(F.lds, F.wave, g, S, E); } }
        PHASE_END
        PHASE_BEGIN(8)
            if (NAIVE(3)) { naive_gemm<true>(F, T_ / 64, FF, DM, H, DM, [](int r) { return r; }, [&](int, const float*& b1, const float*& b2) { b1 = e_wg; b2 = e_wu; }, FF,
                              [&](int r, int c, float v, float v2) { ACT[(size_t)r * FF + c] = (bf16_t)f2bf(silu_f(v) * v2); }); }
            else { pg8::Gemm g{(const char*)H, (const char*)(W + WE_GU), DM, DM, DM, 2, 0u, 0u}; pg8::DenseOrder S; S.init(T_ / 256, 2 * FF / 256, F.G, (int)blockIdx.x); g.probe = rep_ ? KL_PROBE : 0;
                if (FFN8) { g.A = (const char*)H8B; g.es = 1;
                    pg8::EpiSwiglu8R E{(unsigned char*)ACT, FF, 1.0f / 2048.0f, 4.0f, (const float*)(args.ws + WS_SSX), (LAS float*)(F.lds + LDSCTL_OFF + 8192)}; pg8::gemm_phase<pg8::EpiSwiglu8R, pg8::DenseOrder, false, true>(F.lds, F.wave, g, S, E); }
                else { pg8::EpiSwiglu E{ACT, FF, (const float*)(args.ws + WS_SSX), rep_ && EPI_PROBE, (LAS float*)(F.lds + LDSCTL_OFF + 8192)}; pg8::gemm_phase<pg8::EpiSwiglu, pg8::DenseOrder, false>(F.lds, F.wave, g, S, E); } }
        PHASE_END
        PHASE_BEGIN(9)
            if (NAIVE(4)) { naive_gemm<false>(F, T_ / 64, DM, FF, ACT, FF, [](int r) { return r; }, [&](int, const float*& b1, const float*& b2) { b1 = e_wd; b2 = e_wd; }, DM,
                              [&](int r, int c, float v, float) { H[(size_t)r * DM + c] = (bf16_t)f2bf(bf2f(H[(size_t)r * DM + c]) + v); }); }
            else { pg8::Gemm g{(const char*)ACT, (const char*)(W + WE_D), FF, FF, FF, 2, 0u, 0u}; pg8::DenseOrder S; S.init(T_ / 256, DM / 256, F.G, (int)blockIdx.x);
                const float sc_ = rep_ ? 0.0f : 1.0f; float* ssx_ = (float*)(args.ws + WS_SSX); LAS float* P_ = (LAS float*)(F.lds + LDSCTL_OFF + 8192);
                if (HAS_G5(1, 1) && FFN8 && QKV8) { g.es = 1; pg8::EpiResid16<true, true> E{H, H, ssx_, P_, sc_ / 1024.0f, H8B}; pg8::gemm_phase<pg8::EpiResid16<true, true>, pg8::DenseOrder, false, true>(F.lds, F.wave, g, S, E); }
                else if (HAS_G5(1, 0) && FFN8) { g.es = 1; pg8::EpiResid16<true> E{H, H, ssx_, P_, sc_ / 1024.0f}; pg8::gemm_phase<pg8::EpiResid16<true>, pg8::DenseOrder, false, true>(F.lds, F.wave, g, S, E); }
                else if (HAS_G5(0, 1) && QKV8) { pg8::EpiResid16<true, true> E{H, H, ssx_, P_, sc_, H8B}; pg8::gemm_phase<pg8::EpiResid16<true, true>, pg8::DenseOrder, false>(F.lds, F.wave, g, S, E); }
                else if (HAS_G5(0, 0)) { pg8::EpiResid16<true> E{H, H, ssx_, P_, sc_}; pg8::gemm_phase<pg8::EpiResid16<true>, pg8::DenseOrder, false>(F.lds, F.wave, g, S, E); } }
            if (rep_ == 0) {
            if (QKV8) conv_matrix<true>(F, MapQkvCA{o_w_qkv}, DM, DM, 3 * DM, (unsigned char*)(W + WO_QKV), o_attn_norm, 256.0f);
            else conv_matrix(F, MapQkvCA{o_w_qkv}, DM, DM, 3 * DM, (bf16_t*)(W + WO_QKV), o_attn_norm);
            if (BO8) conv_matrix<true>(F, MapPlain{o_w_o, DM}, DM, DM, DM, (unsigned char*)(W + WO_O), nullptr, 256.0f);
            else conv_matrix(F, MapPlain{o_w_o, DM}, DM, DM, DM, (bf16_t*)(W + WO_O));
#pragma unroll 1
            for (int e = 0; e < NE; ++e) {
#if MOE_FP8
                conv_matrix<true>(F, MapGateUp{o_wg + (size_t)e * DM * EFF, o_wu + (size_t)e * DM * EFF, EFF}, DM, DM, 2 * EFF, (unsigned char*)(W + WO_GU) + (size_t)e * 2 * EFF * DM, nullptr, 256.0f);
                conv_matrix<true>(F, MapPlain{o_wd + (size_t)e * EFF * DM, DM}, EFF, EFF, DM, (unsigned char*)(W + WO_D) + (size_t)e * DM * EFF, nullptr, 256.0f);
#else
                conv_matrix(F, MapGateUp{o_wg + (size_t)e * DM * EFF, o_wu + (size_t)e * DM * EFF, EFF}, DM, DM, 2 * EFF, (bf16_t*)(W + WO_GU) + (size_t)e * 2 * EFF * DM);
                conv_matrix(F, MapPlain{o_wd + (size_t)e * EFF * DM, DM}, EFF, EFF, DM, (bf16_t*)(W + WO_D) + (size_t)e * DM * EFF);
#endif
            }
            }
        PHASE_END

        PHASE_BEGIN(11)
            if (NAIVE(5)) {
                naive_gemm<false>(F, T_ / 64, 3 * DM, DM, H, DM, [](int r) { return r; }, [&](int, const float*& b1, const float*& b2) { b1 = o_w_qkv; b2 = o_w_qkv; }, 3 * DM,
                                  [&](int r, int c, float v, float) { bf16_t* dst = c < DM ? CQ : (c < 2 * DM ? CK : CV); dst[(size_t)r * DM + (c & (DM - 1))] = (bf16_t)f2bf(v); });
                __syncthreads(); VM_WAIT();
            } else { { LAS float* GL = (LAS float*)(F.lds + LDSCTL_OFF + 5120); if (F.tid < CA_D) { GL[F.tid] = o_qn[F.tid]; GL[192 + F.tid] = o_kn[F.tid]; } __syncthreads(); }
                pg8::Gemm g{(const char*)H, (const char*)(W + WO_QKV), DM, DM, DM, 2, 0u, 0u}; pg8::DenseOrder S; S.init(T_ / 256, 3 * DM / 256, F.G, (int)blockIdx.x);
                pg8::EpiQkvNorm E{(LAS float*)(F.lds + LDSCTL_OFF + 8192), (LAS float*)(F.lds + LDSCTL_OFF + 5120), CQ, (size_t)(B_CK - B_CQ) / 2, o_qn, o_kn, (const float*)(args.ws + WS_SSX)};
                if (QKV8) { g.A = (const char*)H8B; g.es = 1; E.iscale = 1.0f / 2048.0f; pg8::gemm_phase<pg8::EpiQkvNorm, pg8::DenseOrder, false, true>(F.lds, F.wave, g, S, E); }
                else pg8::gemm_phase<pg8::EpiQkvNorm, pg8::DenseOrder, false>(F.lds, F.wave, g, S, E); }
        PHASE_END
#if NAIVE(5)
        PHASE_BEGIN(12)
            ca_head_norm(F, CQ, o_qn); ca_head_norm(F, CK, o_kn);
        PHASE_END
#endif
        PHASE_BEGIN(13)
#if NAIVE_ATTN & 2
            attn_naive<CA_D, CA_D, true>(F, CQ, DM, CK, DM, CV, DM, CO, DM, CA_H, o_bias, 0.125f);
#else
            att::attn_mfma<CA_D, CA_D, 2, true, BAND_PIPE>(F, CQ, DM, CK, CA_H, CV, 0, BO8, CO, DM, CA_H, o_bias, 0.125f * 1.4426950408889634f, rep_ ? ATT_PROBE : 0);
#endif
        PHASE_END
        PHASE_BEGIN(14)
            if (NAIVE(2)) { naive_gemm<false>(F, T_ / 64, DM, DM, CO, DM, [](int r) { return r; }, [&](int, const float*& b1, const float*& b2) { b1 = o_w_o; b2 = o_w_o; }, DM,
                              [&](int r, int c, float v, float) { H[(size_t)r * DM + c] = (bf16_t)f2bf(bf2f(H[(size_t)r * DM + c]) + v); }); }
            else { pg8::Gemm g{(const char*)CO, (const char*)(W + WO_O), DM, DM, DM, 2, 0u, 0u}; pg8::DenseOrder S; S.init(T_ / 256, DM / 256, F.G, (int)blockIdx.x);
                pg8::EpiResid16<false> E{H, H, nullptr, nullptr, rep_ ? 0.0f : 1.0f};
                if (((BO8_MASK) != 0) && BO8) { g.es = 1; E.scale *= 1.0f / 4096.0f; pg8::gemm_phase<pg8::EpiResid16<false>, pg8::DenseOrder, false, true>(F.lds, F.wave, g, S, E); }
                else if ((BO8_MASK) != 3) pg8::gemm_phase<pg8::EpiResid16<false>, pg8::DenseOrder, false>(F.lds, F.wave, g, S, E); }
        PHASE_END
        PHASE_BEGIN(15)
            norm_router<MOE_FP8 != 0>(F, H, o_ffn_norm, o_router, H8B, route_e, route_p, route_w, perm_g, cnt_cur, rep_ != 0);
        PHASE_END
        PHASE_BEGIN(16)
            pg8::MoeInfo mi; mi.load(cnt_cur);
            if (NAIVE(6)) {
                naive_gemm<true>(F, mi.total * 4, EFF, DM, H, DM,
                    [&](int r) { const int pm = r >> 8, e = mi.expert_of(pm), p = (pm - mi.start_of(e)) * 256 + (r & 255); return p < mi.cnt_of(e) ? perm_g[(size_t)e * T_ + p] : -1; },
                    [&](int mt, const float*& b1, const float*& b2) { const int e = mi.expert_of(mt >> 2); b1 = o_wg + (size_t)e * DM * EFF; b2 = o_wu + (size_t)e * DM * EFF; }, EFF,
                    [&](int r, int c, float v, float v2) { ACT[(size_t)r * EFF + c] = (bf16_t)f2bf(silu_f(v) * v2); });
            } else {
                pg8::Gemm g{(const char*)H8B, (const char*)(W + WO_GU), DM, DM, DM, 2, 0u, 0u}; LAS int* tb = (LAS int*)(F.lds + LDSCTL_OFF + 1024); pg8::moe_tables(mi, tb, F.tid);
                pg8::MoeOrder S; S.d.init(mi.total, 2 * EFF / 256, F.G, (int)blockIdx.x); S.perm = perm_g; S.tb = tb; S.gather = true;
#if MOE_FP8
                g.es = 1;
                pg8::EpiSwiglu8 E{(unsigned char*)ACT, EFF, 1.0f / 4096.0f, 4.0f, rep_ && EPI_PROBE}; pg8::gemm_phase<pg8::EpiSwiglu8, pg8::MoeOrder, true, true>(F.lds, F.wave, g, S, E);
#else
                pg8::EpiSwiglu E{ACT, EFF, nullptr, false, nullptr}; pg8::gemm_phase<pg8::EpiSwiglu, pg8::MoeOrder, true>(F.lds, F.wave, g, S, E);
#endif
            }
        PHASE_END
        PHASE_BEGIN(17)
            pg8::MoeInfo mi; mi.load(cnt_cur);
            if (NAIVE(7)) {
                naive_gemm<false>(F, mi.total * 4, DM, EFF, ACT, EFF,
                    [&](int r) { const int pm = r >> 8, e = mi.expert_of(pm), p = (pm - mi.start_of(e)) * 256 + (r & 255); return p < mi.cnt_of(e) ? r : -1; },
                    [&](int mt, const float*& b1, const float*& b2) { const int e = mi.expert_of(mt >> 2); b1 = o_wd + (size_t)e * EFF * DM; b2 = b1; }, DM,
                    [&](int r, int c, float v, float) { Ybuf[(size_t)r * DM + c] = (bf16_t)f2bf(v); });
            } else {
                pg8::Gemm g{(const char*)ACT, (const char*)(W + WO_D), EFF, EFF, EFF, 2, 0u, 0u}; LAS int* tb = (LAS int*)(F.lds + LDSCTL_OFF + 1024); pg8::moe_tables(mi, tb, F.tid);
                pg8::MoeOrder S; S.d.init(mi.total, DM / 256, F.G, (int)blockIdx.x); S.perm = perm_g; S.tb = tb; S.gather = false;
#if MOE_FP8
                g.es = 1;
                pg8::EpiStoreBf16 E{Ybuf, DM, 1.0f / 1024.0f}; pg8::gemm_phase<pg8::EpiStoreBf16, pg8::MoeOrder, false, true>(F.lds, F.wave, g, S, E);
#else
                pg8::EpiStoreBf16 E{Ybuf, DM, 1.0f}; pg8::gemm_phase<pg8::EpiStoreBf16, pg8::MoeOrder, false>(F.lds, F.wave, g, S, E);
#endif
            }
        PHASE_END
    }
    PHASE_BEGIN(31)
        MoeCombine mc; mc.re = route_e; mc.rp = route_p; mc.rw = route_w; mc.Y = Ybuf; mc.mi.load(ctl + CW_CNT + 512);
        res_rows<true, true, false, false, true>(F, H, nullptr, nullptr, nullptr, args.out, mc);
    PHASE_END
}

#undef XB2
#undef H8B
#undef H
#undef W
#undef BIG
#undef route_e
#undef route_p
#undef route_w
#undef perm_g
#undef Ybuf
#undef positions
#undef EIN
#undef FFN8
#undef QKV8
#undef AO8
#undef IN8
#undef MLAUP8
#undef BO8
#undef OIN
#undef e_attn_norm
#undef e_w_in
#undef e_qa
#undef e_kva
#undef e_w_uq
#undef e_w_ukv
#undef e_qn
#undef e_kn
#undef e_w_o
#undef e_ffn_norm
#undef e_wg
#undef e_wu
#undef e_wd
#undef o_attn_norm
#undef o_w_qkv
#undef o_qn
#undef o_kn
#undef o_bias
#undef o_w_o
#undef o_ffn_norm
#undef o_router
#undef o_wg
#undef o_wu
#undef o_wd
#undef cnt_prev
#undef cnt_cur
#undef A1
#undef QRAW
#undef KVRAW
#undef QN
#undef KN
#undef OM
#undef ACT
#undef CQ
#undef CK
#undef CV
#undef CO
extern "C" void kernel_launch(void* const* d_in, const int* in_sizes, int n_in, void* d_out, int out_size, void* d_ws, size_t ws_size, hipStream_t stream) {
    static int grid = 0;
    if (grid == 0) {
        if (n_in != 50 || out_size != T_ * DM || ws_size < WS_END) { fprintf(stderr, "kernel_launch: shape mismatch n_in %d out %d ws %zu (need %zu)\n", n_in, out_size, ws_size, (size_t)WS_END); grid = -1; return; }
        int dev = 0, cus = 0, per_cu = 0;
        if (hipGetDevice(&dev) != hipSuccess || hipDeviceGetAttribute(&cus, hipDeviceAttributeMultiprocessorCount, dev) != hipSuccess) { grid = -1; return; }
        if (hipFuncSetAttribute((const void*)fwd, hipFuncAttributeMaxDynamicSharedMemorySize, LDS_BYTES) != hipSuccess) { fprintf(stderr, "kernel_launch: hipFuncSetAttribute failed\n"); grid = -1; return; }
        if (hipOccupancyMaxActiveBlocksPerMultiprocessor(&per_cu, (const void*)fwd, 512, LDS_BYTES) != hipSuccess || per_cu < 1) { fprintf(stderr, "kernel_launch: occupancy query says %d\n", per_cu); }
        (void)hipGetLastError();
        grid = cus;
    }
    if (grid < 0) return;
    (void)hipMemsetAsync((char*)d_ws + WS_CTL, 0, CTL_ZERO_BYTES, stream);
    Args a{};
    for (int i = 0; i < 50; ++i) a.in[i] = d_in[i];
    a.out = (float*)d_out; a.ws = (unsigned char*)d_ws;
#if MK_PER_PHASE
    for (int p = 0; p < N_PHASES; ++p) { a.ph_lo = p; a.ph_hi = p + 1; hipLaunchKernelGGL(fwd, dim3(grid), dim3(512), LDS_BYTES, stream, a); }
#else
    a.ph_lo = 0; a.ph_hi = N_PHASES; hipLaunchKernelGGL(fwd, dim3(grid), dim3(512), LDS_BYTES, stream, a);
#endif
    const hipError_t le = hipPeekAtLastError();
    if (le != hipSuccess) fprintf(stderr, "kernel_launch: launch failed: %s\n", hipGetErrorName(le));
}
```

```cpp
#include <hip/hip_runtime.h>
#include <cstdio>
#include <cstdint>

#ifndef MK_PER_PHASE
#define MK_PER_PHASE 0
#endif
#ifndef NAIVE_MASK
#define NAIVE_MASK 0x0
#endif
#ifndef MOE_FP8
#define MOE_FP8 1
#endif
#ifndef FFN8_MASK
#define FFN8_MASK 2
#endif
#ifndef QKV8_MASK
#define QKV8_MASK 3
#endif
#ifndef MLAUP8_MASK
#define MLAUP8_MASK 0
#endif
#ifndef IN8_MASK
#define IN8_MASK 0
#endif
#ifndef AO8_MASK
#define AO8_MASK 3
#endif
#ifndef BO8_MASK
#define BO8_MASK 3
#endif
#define HAS_G3(f, q) ((((AO8_MASK) & 1) == (f) && ((FFN8_MASK) & 1) == (q)) || ((((AO8_MASK) >> 1) & 1) == (f) && (((FFN8_MASK) >> 1) & 1) == (q)))
#define HAS_G5(f, q) ((((FFN8_MASK) & 1) == (f) && ((QKV8_MASK) & 1) == (q)) || ((((FFN8_MASK) >> 1) & 1) == (f) && (((QKV8_MASK) >> 1) & 1) == (q)))
#ifndef KL_PROBE
#define KL_PROBE 0
#endif
#ifndef MLA_PIPE
#define MLA_PIPE false
#endif
#ifndef BAND_PIPE
#define BAND_PIPE true
#endif
#ifndef NAIVE_ATTN
#define NAIVE_ATTN 0
#endif

#define GAS __attribute__((address_space(1)))
#define LAS __attribute__((address_space(3)))
typedef unsigned short bf16_t;
typedef short bf16x8 __attribute__((ext_vector_type(8)));
typedef short s16x4 __attribute__((ext_vector_type(4)));
typedef float f32x4 __attribute__((ext_vector_type(4)));
typedef float f32x2 __attribute__((ext_vector_type(2)));
typedef unsigned u32x4 __attribute__((ext_vector_type(4)));
typedef unsigned u32x2 __attribute__((ext_vector_type(2)));
typedef GAS unsigned gu32;

constexpr int T_ = 32768, DM = 1024, SEQ = 2048, NBATCH = 16, NCHK = 32;
constexpr float EPS = 1e-6f;
constexpr int MLA_H = 8, QKD = 192, NOPE = 128, ROPE = 64, VD = 128, QLORA = 256, KVLORA = 128, AIN = 448, AINP = 512;
constexpr int CA_H = 16, CA_D = 64, NREL = 320;
constexpr int FF = 2816, NE = 8, EFF = 3584;
constexpr int MAXROWS = 2 * T_ + NE * 256;

constexpr size_t MiB = 1u << 20;
constexpr size_t WS_CTL = 0, CTL_ZERO_BYTES = 1 * MiB;
constexpr size_t WS_ROUTE_E = 1 * MiB;
constexpr size_t WS_ROUTE_P = WS_ROUTE_E + (size_t)T_ * 8;
constexpr size_t WS_ROUTE_W = WS_ROUTE_P + (size_t)T_ * 8;
constexpr size_t WS_PERM = 2 * MiB;
constexpr size_t WS_W = 4 * MiB;
constexpr size_t WS_H = 184 * MiB;
constexpr size_t WS_BIG = 248 * MiB;
constexpr size_t WS_END = WS_BIG + 644 * MiB;
constexpr size_t WE_IN = 0, WE_O = 3 * MiB, WE_GU = 5 * MiB, WE_D = 16 * MiB, WE_QKVF = 22 * MiB;
constexpr size_t WS_CS = WS_W + 160 * MiB;
constexpr size_t WS_SSX = WS_W + 172 * MiB;
constexpr size_t WS_SSQ = WS_W + 170 * MiB;
constexpr size_t WO_QKV = 32 * MiB, WO_O = 38 * MiB, WO_GU = 40 * MiB, WO_D = 96 * MiB;
constexpr size_t B_A1 = 0, B_VM = 32 * MiB, B_QN = 256 * MiB, B_KN = 352 * MiB, B_OM = 448 * MiB;
constexpr size_t B_ACT = 0;
constexpr size_t B_CQ = 0, B_CK = 64 * MiB, B_CV = 128 * MiB, B_CO = 192 * MiB;
constexpr size_t B_Y = 512 * MiB;
static_assert(B_Y + (size_t)MAXROWS * 1024 * 2 <= 644 * MiB && (size_t)MAXROWS * EFF * 2 <= B_Y, "BIG map");
constexpr int CW_TMO = 0, CW_BAR = 4096, CW_CNT = 8192;

static_assert(MOE_FP8 == 1, "the odd-layer weight map (WO_*) is sized for fp8 expert weights");
constexpr int RING_BYTES = 131072, LDSCTL_OFF = RING_BYTES, MISC_OFF = LDSCTL_OFF + 320, LDS_BYTES = 147456;

#define RLX_AGENT __ATOMIC_RELAXED, __HIP_MEMORY_SCOPE_AGENT
#define LDS_WAIT() asm volatile("s_waitcnt lgkmcnt(0)" ::: "memory")
#define VM_WAIT() asm volatile("s_waitcnt vmcnt(0)" ::: "memory")
__device__ __forceinline__ float bf2f(unsigned b) { return __uint_as_float(b << 16); }
__device__ __forceinline__ unsigned f2bf(float f) { unsigned u = __float_as_uint(f); return (u + 0x7fffu + ((u >> 16) & 1u)) >> 16; }
__device__ __forceinline__ unsigned pk2(float lo, float hi) { return f2bf(lo) | (f2bf(hi) << 16); }
__device__ __forceinline__ unsigned cvt_pk_bf16(float lo, float hi) { unsigned r; asm volatile("v_cvt_pk_bf16_f32 %0, %1, %2" : "=v"(r) : "v"(lo), "v"(hi)); return r; }
template <int CTRL, int ROWMASK>
__device__ __forceinline__ float dpp_f(float v) { return __uint_as_float((unsigned)__builtin_amdgcn_update_dpp(0, (int)__float_as_uint(v), CTRL, ROWMASK, 0xF, false)); }
__device__ __forceinline__ float sum_x16_x32(float p) {
    const auto a = __builtin_amdgcn_permlane16_swap(__float_as_uint(p), __float_as_uint(p), false, false); p = __uint_as_float(a[0]) + __uint_as_float(a[1]);
    const auto b = __builtin_amdgcn_permlane32_swap(__float_as_uint(p), __float_as_uint(p), false, false); return __uint_as_float(b[0]) + __uint_as_float(b[1]);
}
__device__ __forceinline__ float wave_sum(float v) {
    v += dpp_f<0xB1, 0xF>(v); v += dpp_f<0x4E, 0xF>(v); v += dpp_f<0x141, 0xF>(v); v += dpp_f<0x140, 0xF>(v);
    v += dpp_f<0x142, 0xA>(v); v += dpp_f<0x143, 0xC>(v);
    return __uint_as_float((unsigned)__builtin_amdgcn_readlane((int)__float_as_uint(v), 63));
}
__device__ __forceinline__ float silu_f(float g) { return g * __builtin_amdgcn_rcpf(1.0f + __builtin_amdgcn_exp2f(g * -1.4426950408889634f)); }
__device__ __forceinline__ float swiglu_s(float g, float u, float c1  , float c2  ) { return (g * u) * (c2 * __builtin_amdgcn_rcpf(1.0f + __builtin_amdgcn_exp2f(g * c1))); }
__device__ __forceinline__ void swiglu8(const f32x4 g0, const f32x4 g1, const f32x4 u0, const f32x4 u1, const float c1, const float k, f32x4& o0, f32x4& o1) {
    const f32x4 t0 = g0 * c1, t1 = g1 * c1; f32x4 e0, e1, r0, r1;
#pragma unroll
    for (int j = 0; j < 4; ++j) { e0[j] = __builtin_amdgcn_exp2f(t0[j]); e1[j] = __builtin_amdgcn_exp2f(t1[j]); }
    const f32x4 d0 = e0 * k + k, d1 = e1 * k + k, p0 = g0 * u0, p1 = g1 * u1;
#pragma unroll
    for (int j = 0; j < 4; ++j) { r0[j] = __builtin_amdgcn_rcpf(d0[j]); r1[j] = __builtin_amdgcn_rcpf(d1[j]); }
    o0 = p0 * r0; o1 = p1 * r1;
}
__device__ __forceinline__ float clamp8(float x) { return __builtin_amdgcn_fmed3f(x, -448.0f, 448.0f); }
__device__ __forceinline__ unsigned pk4_fp8(float a, float b, float c, float d) {
    unsigned w = 0u; w = __builtin_amdgcn_cvt_pk_fp8_f32(clamp8(a), clamp8(b), w, false); w = __builtin_amdgcn_cvt_pk_fp8_f32(clamp8(c), clamp8(d), w, true); return w; }

#ifndef WT_STORES
#define WT_STORES 0
#endif
__device__ __forceinline__ void st16(void* p, u32x4 v) {
#if WT_STORES
    asm volatile("global_store_dwordx4 %0, %1, off sc1" :: "v"(p), "v"(v) : "memory");
#else
    *(u32x4*)p = v;
#endif
}
__device__ __forceinline__ void st8(void* p, u32x2 v) {
#if WT_STORES
    asm volatile("global_store_dwordx2 %0, %1, off sc1" :: "v"(p), "v"(v) : "memory");
#else
    *(u32x2*)p = v;
#endif
}
__device__ __forceinline__ void glds16_s(unsigned voff, const char* sbase, unsigned ldsaddr) { unsigned keep;
    asm volatile("s_mov_b32 %0, m0\n\ts_mov_b32 m0, %3\n\ts_nop 0\n\tglobal_load_lds_dwordx4 %1, %2\n\ts_mov_b32 m0, %0" : "=&s"(keep) : "v"(voff), "s"(sbase), "s"(ldsaddr) : "memory"); }

__device__ __forceinline__ void glds4_s(unsigned voff, const char* sbase, unsigned ldsaddr) { unsigned keep;
    asm volatile("s_mov_b32 %0, m0\n\ts_mov_b32 m0, %3\n\ts_nop 0\n\tglobal_load_lds_dword %1, %2\n\ts_mov_b32 m0, %0" : "=&s"(keep) : "v"(voff), "s"(sbase), "s"(ldsaddr) : "memory"); }

#define XB_TMO      128
#define XB_XCNT(j)  (256  + 64 * (j))
#define XB_XSUB(j)  (1280 + 64 * (j))
#define XB_XGEN(j)  (2304 + 64 * (j))
#define XB_TOP      3328
#define XB_TOPGEN   3392
#define XCD_BAR_WORDS 3456
#define XB_SPIN_CAP (1u << 18)
__device__ __forceinline__ unsigned xb_ld(unsigned* p)              { return __hip_atomic_load(p, __ATOMIC_RELAXED, __HIP_MEMORY_SCOPE_AGENT); }
__device__ __forceinline__ unsigned xb_add(unsigned* p, unsigned v) { return __hip_atomic_fetch_add(p, v, __ATOMIC_RELAXED, __HIP_MEMORY_SCOPE_AGENT); }
__device__ __forceinline__ unsigned xb_xcc_id() { return (unsigned)__builtin_amdgcn_s_getreg((3 << 11) | 20) & 0xFu; }
#define XB_SPIN(cond, bar) do { unsigned _sp = 0; while (cond) { __builtin_amdgcn_s_sleep(1); \
    if ((++_sp & 255u) == 0u) { if (xb_ld(&(bar)[XB_TMO])) break; if (_sp > XB_SPIN_CAP) { atomicAdd(&(bar)[XB_TMO], 1u); break; } } } } while (0)
struct XcdBarrier { unsigned* bar; unsigned x; volatile LAS unsigned* st; };
__device__ __forceinline__ XcdBarrier xcd_barrier_post(unsigned* bar, volatile LAS unsigned* st) {
    XcdBarrier b; b.bar = bar; b.x = xb_xcc_id(); b.st = st;
    if (threadIdx.x == 0) (void)xb_add(&bar[XB_XCNT(b.x)], 1u);
    return b;
}
__device__ __forceinline__ void xcd_barrier_complete(unsigned* bar, unsigned x, unsigned& nloc, unsigned& nx) {
    const unsigned G = gridDim.x * gridDim.y * gridDim.z;
    unsigned sum, cnt, mine, sp = 0u;
    for (;;) {
        sum = 0u; cnt = 0u; mine = 0u;
#pragma unroll
        for (unsigned j = 0; j < 16; ++j) { const unsigned c = xb_ld(&bar[XB_XCNT(j)]); sum += c; cnt += (c > 0u) ? 1u : 0u; mine = (j == x) ? c : mine; }
        if (sum == G) break;
        __builtin_amdgcn_s_sleep(1);
        if ((++sp & 255u) == 0u) { if (xb_ld(&bar[XB_TMO])) break; if (sp > XB_SPIN_CAP) { atomicAdd(&bar[XB_TMO], 1u); break; } }
    }
    nloc = mine > 0u ? mine : 1u; nx = cnt > 0u ? cnt : 1u;
}
__device__ __forceinline__ void xcd_barrier(const XcdBarrier& b, const int tid) {
    asm volatile("s_waitcnt vmcnt(0)" ::: "memory");
    __syncthreads();
    if (tid == 0) {
        unsigned* bar = b.bar;
        __builtin_amdgcn_s_waitcnt(0);
        unsigned nloc = b.st[0], nx = b.st[1];
        if (nloc == 0u) { xcd_barrier_complete(bar, b.x, nloc, nx); b.st[0] = nloc; b.st[1] = nx; }
        const unsigned old = xb_add(&bar[XB_XSUB(b.x)], 1u);
        const unsigned gen = old / nloc;
        if (old + 1u == (gen + 1u) * nloc) {
            __builtin_amdgcn_fence(__ATOMIC_RELEASE, "agent");
            asm volatile("s_waitcnt vmcnt(0)" ::: "memory");
            const unsigned og = xb_add(&bar[XB_TOP], 1u);
            const unsigned tg = og / nx;
            if (og + 1u == (tg + 1u) * nx) xb_add(&bar[XB_TOPGEN], 1u);
            else XB_SPIN(xb_ld(&bar[XB_TOPGEN]) == tg, bar);
            __builtin_amdgcn_fence(__ATOMIC_ACQUIRE, "agent");
            xb_add(&bar[XB_XGEN(b.x)], 1u);
            asm volatile("s_waitcnt vmcnt(0)" ::: "memory");
        } else {
            XB_SPIN(xb_ld(&bar[XB_XGEN(b.x)]) == gen, bar);
            __builtin_amdgcn_fence(__ATOMIC_ACQUIRE, "agent");
            asm volatile("s_waitcnt vmcnt(0)" ::: "memory");
        }
    }
    __syncthreads();
}

namespace pg8 {
constexpr int BM = 256, BK = 64, HALF = 128, HTB = HALF * BK * 2, STAGE_BYTES = 8 * HTB, NXCD = 8, WGM = 8;
__host__ __device__ __forceinline__ int lds_byte(int r, int c) { const int st = (r >> 4) * 2 + (c >> 5), rr = r & 15, cc = c & 31, ob = rr * 64 + cc * 2; return st * 1024 + (ob ^ (((ob >> 9) & 1) << 5)); }
__host__ __device__ __forceinline__ void stage_rc(int b, int& R, int& C) { const int st = b / 1024, sb = b % 1024, swz = sb ^ (((sb >> 9) & 1) << 5); R = (st >> 1) * 16 + swz / 64; C = (st & 1) * 32 + (swz % 64) / 2; }
__host__ __device__ __forceinline__ int perm32(int rho) { const int n = rho >> 4, i = rho & 15; return 8 * (i >> 2) + 4 * n + (i & 3); }

struct Unit { int pm, pn; };
typedef int v4i_t __attribute__((ext_vector_type(4)));
struct Gemm { const char* A; const char* Bt; int K, lda, ldb, es; unsigned sw, sa; int probe = 0; };

struct DenseOrder {
    int nM, nN, nwg, G, c;
    __device__ __forceinline__ void init(int nM_, int nN_, int G_, int c_) { nM = nM_; nN = nN_; nwg = nM * nN; G = G_; c = c_; }
    __device__ __forceinline__ bool next(int i, Unit& u) const {
        const long L = (long)i * G + c; if (L >= nwg) return false;
        int wgid = (int)L; { const int q = nwg / NXCD, r = nwg % NXCD, xcd = wgid % NXCD, off = wgid / NXCD; wgid = (xcd < r ? xcd * (q + 1) : r * (q + 1) + (xcd - r) * q) + off; }
        const int nig = WGM * nN, gid = wgid / nig, fm = gid * WGM, gsz = (nM - fm) < WGM ? (nM - fm) : WGM;
        u.pm = fm + ((wgid % nig) % gsz); u.pn = (wgid % nig) / gsz; return true;
    }
    __device__ __forceinline__ const char* a_base(const Gemm& g, const Unit& u) const { return g.A + (size_t)u.pm * 256 * g.lda * g.es; }
    __device__ __forceinline__ const char* b_base(const Gemm& g, const Unit& u) const { return g.Bt + (size_t)u.pn * 256 * g.ldb * g.es; }
    __device__ __forceinline__ const int* toklist(const Unit&) const { return nullptr; }
    __device__ __forceinline__ LAS unsigned* ofs() const { return nullptr; }
};
struct MoeInfo {
    int c0, c1, c2, c3, c4, c5, c6, c7;
    int s1, s2, s3, s4, s5, s6, s7, total;
    __device__ __forceinline__ void load(const gu32* cnt) {
        c0 = (int)__hip_atomic_load(cnt + 0 * 64, RLX_AGENT); c1 = (int)__hip_atomic_load(cnt + 1 * 64, RLX_AGENT); c2 = (int)__hip_atomic_load(cnt + 2 * 64, RLX_AGENT); c3 = (int)__hip_atomic_load(cnt + 3 * 64, RLX_AGENT);
        c4 = (int)__hip_atomic_load(cnt + 4 * 64, RLX_AGENT); c5 = (int)__hip_atomic_load(cnt + 5 * 64, RLX_AGENT); c6 = (int)__hip_atomic_load(cnt + 6 * 64, RLX_AGENT); c7 = (int)__hip_atomic_load(cnt + 7 * 64, RLX_AGENT);
        c0 = __builtin_amdgcn_readfirstlane(c0); c1 = __builtin_amdgcn_readfirstlane(c1); c2 = __builtin_amdgcn_readfirstlane(c2); c3 = __builtin_amdgcn_readfirstlane(c3);
        c4 = __builtin_amdgcn_readfirstlane(c4); c5 = __builtin_amdgcn_readfirstlane(c5); c6 = __builtin_amdgcn_readfirstlane(c6); c7 = __builtin_amdgcn_readfirstlane(c7);
        s1 = (c0 + 255) >> 8; s2 = s1 + ((c1 + 255) >> 8); s3 = s2 + ((c2 + 255) >> 8); s4 = s3 + ((c3 + 255) >> 8);
        s5 = s4 + ((c4 + 255) >> 8); s6 = s5 + ((c5 + 255) >> 8); s7 = s6 + ((c6 + 255) >> 8); total = s7 + ((c7 + 255) >> 8);
    }
    __device__ __forceinline__ int expert_of(int pm) const { return (pm >= s1) + (pm >= s2) + (pm >= s3) + (pm >= s4) + (pm >= s5) + (pm >= s6) + (pm >= s7); }
    __device__ __forceinline__ int start_of(int e) const { return e == 0 ? 0 : e == 1 ? s1 : e == 2 ? s2 : e == 3 ? s3 : e == 4 ? s4 : e == 5 ? s5 : e == 6 ? s6 : s7; }
    __device__ __forceinline__ int cnt_of(int e) const { return e == 0 ? c0 : e == 1 ? c1 : e == 2 ? c2 : e == 3 ? c3 : e == 4 ? c4 : e == 5 ? c5 : e == 6 ? c6 : c7; }
};
struct MoeOrder {
    static constexpr int TBN = 272;
    DenseOrder d; const int* perm; const LAS int* tb; bool gather;
    __device__ __forceinline__ bool next(int i, Unit& u) const { return d.next(i, u); }
    __device__ __forceinline__ const char* a_base(const Gemm& g, const Unit& u) const { return gather ? g.A : g.A + (size_t)u.pm * 256 * g.lda * g.es; }
    __device__ __forceinline__ const char* b_base(const Gemm& g, const Unit& u) const { const int e = __builtin_amdgcn_readfirstlane(tb[u.pm]); return g.Bt + ((size_t)e * d.nN + u.pn) * 256 * g.ldb * g.es; }
    __device__ __forceinline__ const int* toklist(const Unit& u) const { return perm + __builtin_amdgcn_readfirstlane(tb[2 * TBN + u.pm]); }
    __device__ __forceinline__ LAS unsigned* ofs() const { return (LAS unsigned*)(tb + 3 * TBN); }
};
__device__ __forceinline__ void moe_tables(const MoeInfo& mi, LAS int* tb, int tid) {
    if (tid < MoeOrder::TBN) { int e = 0, rem = 0, base = 0;
        if (tid < mi.total) { e = mi.expert_of(tid); const int lt = tid - mi.start_of(e); rem = mi.cnt_of(e) - lt * 256; base = e * T_ + lt * 256; }
        tb[tid] = e; tb[MoeOrder::TBN + tid] = rem; tb[2 * MoeOrder::TBN + tid] = base; }
    __syncthreads();
}

struct EpiStoreBf16 {
    static constexpr bool PERM = true, PREFETCH = false;
    bf16_t* O; int ldc; float scale;
    __device__ __forceinline__ void operator()(const f32x4 (&acc)[2][2][4][2], const Unit& u, int wr, int wc, int fr, int fq) const {
        const int row0 = u.pm * BM + wr * 64 + fr, col0 = u.pn * BM + wc * 32 + 8 * fq;
#pragma unroll
        for (int ai = 0; ai < 2; ++ai)
#pragma unroll
            for (int m = 0; m < 4; ++m) { bf16_t* rowp = O + (size_t)(row0 + ai * HALF + m * 16) * ldc + col0;
#pragma unroll
                for (int bj = 0; bj < 2; ++bj) { const f32x4 v0 = acc[ai][bj][m][0] * scale, v1 = acc[ai][bj][m][1] * scale;
                    u32x4 w; w.x = cvt_pk_bf16(v0[0], v0[1]); w.y = cvt_pk_bf16(v0[2], v0[3]); w.z = cvt_pk_bf16(v1[0], v1[1]); w.w = cvt_pk_bf16(v1[2], v1[3]);
                    st16(rowp + bj * HALF, w); } }
    }
};
struct EpiResid {
    static constexpr bool PERM = true, PREFETCH = false;
    float* X; int ldc; float scale;
    __device__ __forceinline__ void operator()(const f32x4 (&acc)[2][2][4][2], const Unit& u, int wr, int wc, int fr, int fq) const {
        const int row0 = u.pm * BM + wr * 64 + fr, col0 = u.pn * BM + wc * 32 + 8 * fq;
#pragma unroll
        for (int ai = 0; ai < 2; ++ai)
#pragma unroll
            for (int m = 0; m < 4; ++m) { float* rowp = X + (size_t)(row0 + ai * HALF + m * 16) * ldc + col0;
#pragma unroll
                for (int bj = 0; bj < 2; ++bj) { f32x4* p = (f32x4*)(rowp + bj * HALF); f32x4 a = p[0], b = p[1]; a += acc[ai][bj][m][0] * scale; b += acc[ai][bj][m][1] * scale; p[0] = a; p[1] = b; } }
    }
};
template <bool STATS, bool W8 = false>
struct EpiResid16 {
    static constexpr bool PERM = true, PREFETCH = false;
    const bf16_t* XBin; bf16_t* XB; float* ss; LAS float* P; float scale; unsigned char* X8 = nullptr;
    __device__ __forceinline__ void operator()(const f32x4 (&acc)[2][2][4][2], const Unit& u, int wr, int wc, int fr, int fq) const {
        const int col0 = u.pn * BM + wc * 32 + 8 * fq;
#pragma unroll
        for (int ai = 0; ai < 2; ++ai) { u32x4 xin[4][2];
#pragma unroll
            for (int m = 0; m < 4; ++m)
#pragma unroll
                for (int bj = 0; bj < 2; ++bj) xin[m][bj] = *(const u32x4*)(XBin + (size_t)(u.pm * BM + ai * HALF + wr * 64 + m * 16 + fr) * DM + col0 + bj * HALF);
#pragma unroll
            for (int m = 0; m < 4; ++m) { const int rl = ai * HALF + wr * 64 + m * 16 + fr; bf16_t* rowb = XB + (size_t)(u.pm * BM + rl) * DM + col0; float p = 0.f;
#pragma unroll
                for (int bj = 0; bj < 2; ++bj) { const u32x4 xi = xin[m][bj];
                    f32x4 a = (f32x4){bf2f(xi.x & 0xffffu), bf2f(xi.x >> 16), bf2f(xi.y & 0xffffu), bf2f(xi.y >> 16)}, b = (f32x4){bf2f(xi.z & 0xffffu), bf2f(xi.z >> 16), bf2f(xi.w & 0xffffu), bf2f(xi.w >> 16)};
                    a += acc[ai][bj][m][0] * scale; b += acc[ai][bj][m][1] * scale;
                    if constexpr (STATS) p += ((a[0] * a[0] + a[1] * a[1]) + (a[2] * a[2] + a[3] * a[3])) + ((b[0] * b[0] + b[1] * b[1]) + (b[2] * b[2] + b[3] * b[3]));
                    u32x4 w; w.x = cvt_pk_bf16(a[0], a[1]); w.y = cvt_pk_bf16(a[2], a[3]); w.z = cvt_pk_bf16(b[0], b[1]); w.w = cvt_pk_bf16(b[2], b[3]); st16(rowb + bj * HALF, w);
                    if constexpr (W8) { u32x2 w8; w8.x = pk4_fp8(a[0] * 8.0f, a[1] * 8.0f, a[2] * 8.0f, a[3] * 8.0f); w8.y = pk4_fp8(b[0] * 8.0f, b[1] * 8.0f, b[2] * 8.0f, b[3] * 8.0f); st8(X8 + (size_t)(u.pm * BM + rl) * DM + col0 + bj * HALF, w8); } }
                if constexpr (STATS) { p = sum_x16_x32(p); if (fq == 0) P[rl * 4 + wc] = p; } }
            asm volatile("" ::: "memory"); }
        if constexpr (STATS) {
            asm volatile("s_waitcnt lgkmcnt(0)" ::: "memory"); __builtin_amdgcn_s_barrier(); asm volatile("" ::: "memory");
            if (wc == 0 && fq == 0) {
#pragma unroll
                for (int ai = 0; ai < 2; ++ai)
#pragma unroll
                    for (int m = 0; m < 4; ++m) { const int rl = ai * HALF + wr * 64 + m * 16 + fr; const f32x4 p4 = *(const LAS f32x4*)(P + rl * 4);
                        ss[(size_t)(u.pm * BM + rl) * 4 + u.pn] = (p4[0] + p4[1]) + (p4[2] + p4[3]); } } }
    }
};
struct EpiSwiglu {
    static constexpr bool PERM = true, PREFETCH = true;
    bf16_t* O; int ldc; const float* ss; bool skip; LAS float* P;
    __device__ __forceinline__ void prefetch(const Unit& u, int wid, int lane) const {
        if (ss && wid < 4) glds16_s((unsigned)lane * 16u, (const char*)(ss + (size_t)(u.pm * BM + wid * 64) * 4), (unsigned)__builtin_amdgcn_readfirstlane((int)(unsigned)(uintptr_t)P) + (unsigned)wid * 1024u); }
    __device__ __forceinline__ void operator()(const f32x4 (&acc)[2][2][4][2], const Unit& u, int wr, int wc, int fr, int fq) const {
        if (skip) return;
        const int row0 = u.pm * BM + wr * 64 + fr, col0 = u.pn * HALF + wc * 32 + 8 * fq;
        float rs8[8], kv8[8];
        if (ss) {
#pragma unroll
            for (int r8 = 0; r8 < 8; ++r8) { const f32x4 s4 = *(const LAS f32x4*)(P + ((r8 >> 2) * HALF + wr * 64 + (r8 & 3) * 16 + fr) * 4); kv8[r8] = ((s4[0] + s4[1]) + (s4[2] + s4[3])) * (1.0f / DM) + EPS; rs8[r8] = rsqrtf(kv8[r8]); } }
        else {
#pragma unroll
            for (int r8 = 0; r8 < 8; ++r8) { rs8[r8] = 1.0f; kv8[r8] = 1.0f; } }
#pragma unroll
        for (int ai = 0; ai < 2; ++ai)
#pragma unroll
            for (int m = 0; m < 4; ++m) { bf16_t* rowp = O + (size_t)(row0 + ai * HALF + m * 16) * ldc + col0;
                const float rs = rs8[ai * 4 + m], kv = kv8[ai * 4 + m];
                f32x4 o0, o1; swiglu8(acc[ai][0][m][0], acc[ai][0][m][1], acc[ai][1][m][0], acc[ai][1][m][1], rs * -1.4426950408889634f, kv, o0, o1);
                u32x4 w; w.x = cvt_pk_bf16(o0[0], o0[1]); w.y = cvt_pk_bf16(o0[2], o0[3]); w.z = cvt_pk_bf16(o1[0], o1[1]); w.w = cvt_pk_bf16(o1[2], o1[3]);
                st16(rowp, w); }
    }
};
struct EpiSwiglu8 {
    static constexpr bool PERM = true, PREFETCH = false;
    unsigned char* O; int ldc; float iscale, oscale; bool skip;
    __device__ __forceinline__ void operator()(const f32x4 (&acc)[2][2][4][2], const Unit& u, int wr, int wc, int fr, int fq) const {
        if (skip) return;
        const int row0 = u.pm * BM + wr * 64 + fr, col0 = u.pn * HALF + wc * 32 + 8 * fq;
#pragma unroll
        for (int ai = 0; ai < 2; ++ai)
#pragma unroll
            for (int m = 0; m < 4; ++m) { unsigned char* rowp = O + (size_t)(row0 + ai * HALF + m * 16) * ldc + col0;
                const float c1 = iscale * -1.4426950408889634f, kk = 1.0f / (iscale * iscale * oscale);
                f32x4 o0, o1; swiglu8(acc[ai][0][m][0], acc[ai][0][m][1], acc[ai][1][m][0], acc[ai][1][m][1], c1, kk, o0, o1);
                u32x2 w; w.x = pk4_fp8(o0[0], o0[1], o0[2], o0[3]); w.y = pk4_fp8(o1[0], o1[1], o1[2], o1[3]);
                st8(rowp, w); }
    }
};
struct EpiSwiglu8R {
    static constexpr bool PERM = true, PREFETCH = true;
    unsigned char* O; int ldc; float iscale, oscale; const float* ss; LAS float* P;
    __device__ __forceinline__ void prefetch(const Unit& u, int wid, int lane) const {
        if (wid < 4) glds16_s((unsigned)lane * 16u, (const char*)(ss + (size_t)(u.pm * BM + wid * 64) * 4), (unsigned)__builtin_amdgcn_readfirstlane((int)(unsigned)(uintptr_t)P) + (unsigned)wid * 1024u); }
    __device__ __forceinline__ void operator()(const f32x4 (&acc)[2][2][4][2], const Unit& u, int wr, int wc, int fr, int fq) const {
        const int row0 = u.pm * BM + wr * 64 + fr, col0 = u.pn * HALF + wc * 32 + 8 * fq;
        float rs8[8], kv8[8]; const float ik = 1.0f / (iscale * iscale * oscale);
#pragma unroll
        for (int r8 = 0; r8 < 8; ++r8) { const f32x4 s4 = *(const LAS f32x4*)(P + ((r8 >> 2) * HALF + wr * 64 + (r8 & 3) * 16 + fr) * 4); const float var = ((s4[0] + s4[1]) + (s4[2] + s4[3])) * (1.0f / DM) + EPS; rs8[r8] = rsqrtf(var) * iscale; kv8[r8] = var * ik; }
#pragma unroll
        for (int ai = 0; ai < 2; ++ai)
#pragma unroll
            for (int m = 0; m < 4; ++m) { unsigned char* rowp = O + (size_t)(row0 + ai * HALF + m * 16) * ldc + col0;
                f32x4 o0, o1; swiglu8(acc[ai][0][m][0], acc[ai][0][m][1], acc[ai][1][m][0], acc[ai][1][m][1], rs8[ai * 4 + m] * -1.4426950408889634f, kv8[ai * 4 + m], o0, o1);
                u32x2 w; w.x = pk4_fp8(o0[0], o0[1], o0[2], o0[3]); w.y = pk4_fp8(o1[0], o1[1], o1[2], o1[3]);
                st8(rowp, w); }
    }
};
template <bool OUT8 = false>
struct EpiA1 {
    static constexpr bool PERM = true, PREFETCH = true;
    bf16_t* O; int ldc; float* ss; const float* ssin; LAS float* P; float iscale = 1.0f;
    __device__ __forceinline__ void prefetch(const Unit& u, int wid, int lane) const {
        if (wid < 4) glds16_s((unsigned)lane * 16u, (const char*)(ssin + (size_t)(u.pm * BM + wid * 64) * 4), (unsigned)__builtin_amdgcn_readfirstlane((int)(unsigned)(uintptr_t)P) + (unsigned)wid * 1024u); }
    __device__ __forceinline__ void operator()(const f32x4 (&acc)[2][2][4][2], const Unit& u, int wr, int wc, int fr, int fq) const {
        const int row0 = u.pm * BM + wr * 64 + fr, col0 = u.pn * BM + wc * 32 + 8 * fq;
        float rs8[8];
#pragma unroll
        for (int r8 = 0; r8 < 8; ++r8) { const f32x4 s4 = *(const LAS f32x4*)(P + ((r8 >> 2) * HALF + wr * 64 + (r8 & 3) * 16 + fr) * 4); rs8[r8] = rsqrtf(((s4[0] + s4[1]) + (s4[2] + s4[3])) * (1.0f / DM) + EPS) * iscale; }
        float* sp = ss + (size_t)u.pn * T_ * 4 + wc;
#pragma unroll
        for (int ai = 0; ai < 2; ++ai)
#pragma unroll
            for (int m = 0; m < 4; ++m) { const int row = row0 + ai * HALF + m * 16; bf16_t* rowp = O + (size_t)row * ldc + col0; float p = 0.f;
#pragma unroll
                for (int bj = 0; bj < 2; ++bj) { const float rs = rs8[ai * 4 + m]; const f32x4 v0 = acc[ai][bj][m][0] * rs, v1 = acc[ai][bj][m][1] * rs;
                    if (bj == 0 || u.pn == 0) p += ((v0[0] * v0[0] + v0[1] * v0[1]) + (v0[2] * v0[2] + v0[3] * v0[3])) + ((v1[0] * v1[0] + v1[1] * v1[1]) + (v1[2] * v1[2] + v1[3] * v1[3]));
                    if constexpr (OUT8) { u32x2 w8; w8.x = pk4_fp8(v0[0] * 16.0f, v0[1] * 16.0f, v0[2] * 16.0f, v0[3] * 16.0f); w8.y = pk4_fp8(v1[0] * 16.0f, v1[1] * 16.0f, v1[2] * 16.0f, v1[3] * 16.0f);
                        *(u32x2*)((unsigned char*)O + (size_t)row * ldc + col0 + bj * HALF) = w8; }
                    else { u32x4 w; w.x = cvt_pk_bf16(v0[0], v0[1]); w.y = cvt_pk_bf16(v0[2], v0[3]); w.z = cvt_pk_bf16(v1[0], v1[1]); w.w = cvt_pk_bf16(v1[2], v1[3]);
                    *(u32x4*)(rowp + bj * HALF) = w; } }
                p = sum_x16_x32(p);
                if (fq == 0) sp[(size_t)row * 4] = p; }
    }
};
struct EpiMlaQKV {
    static constexpr bool PERM = true, PREFETCH = true;
    LAS float* SS4;
    __device__ __forceinline__ void prefetch(const Unit& u, int wid, int lane) const {
        if (wid < 4) { const float* ssp = ss + (u.pn < 8 ? (size_t)0 : (size_t)T_ * 4);
            glds16_s((unsigned)lane * 16u, (const char*)(ssp + (size_t)(u.pm * BM + wid * 64) * 4), (unsigned)__builtin_amdgcn_readfirstlane((int)(unsigned)(uintptr_t)SS4) + (unsigned)wid * 1024u);
            glds4_s((unsigned)lane * 4u, (const char*)(positions + u.pm * BM + wid * 64), (unsigned)__builtin_amdgcn_readfirstlane((int)(unsigned)(uintptr_t)(P + 1280)) + (unsigned)wid * 256u); } }
    bf16_t* QN; size_t kn_off; bf16_t* VM; const float* ss; const float* gq; const float* gk; const int* positions; LAS float* P; float iscale = 1.0f; bool nostore = false;
    __device__ __forceinline__ void operator()(const f32x4 (&acc)[2][2][4][2], const Unit& u, int wr, int wc, int fr, int fq) const {
        asm volatile("" : "+v"(fr), "+v"(fq));
        const int pn = u.pn, row0 = u.pm * BM + wr * 64 + fr;
        if (pn >= 16) {
#pragma unroll
            for (int ai = 0; ai < 2; ++ai) { f32x4 s4[4];
#pragma unroll
                for (int m = 0; m < 4; ++m) s4[m] = *(const LAS f32x4*)(SS4 + (ai * HALF + wr * 64 + m * 16 + fr) * 4);
#pragma unroll
                for (int m = 0; m < 4; ++m) { const int row = row0 + ai * HALF + m * 16;
                    const float rs = rsqrtf(((s4[m][0] + s4[m][1]) + (s4[m][2] + s4[m][3])) * (1.0f / KVLORA) + EPS) * iscale;
                    const int sq_ = row & (SEQ - 1), bb_ = row >> 11;
                    bf16_t* rowp = VM + ((size_t)((bb_ * MLA_H + 2 * (pn - 16)) * NCHK + (sq_ >> 6)) * 16 + wc * 4 + ((sq_ >> 4) & 3)) * 512 + (sq_ & 15) * 32 + 8 * fq;
#pragma unroll
                    for (int bj = 0; bj < 2; ++bj) { const f32x4 v0 = acc[ai][bj][m][0] * rs, v1 = acc[ai][bj][m][1] * rs;
                        u32x4 w; w.x = cvt_pk_bf16(v0[0], v0[1]); w.y = cvt_pk_bf16(v0[2], v0[3]); w.z = cvt_pk_bf16(v1[0], v1[1]); w.w = cvt_pk_bf16(v1[2], v1[3]);
                        if (!nostore) *(u32x4*)(rowp + (size_t)bj * (NCHK * 16 * 512)) = w; } }
                asm volatile("" ::: "memory"); }
            asm volatile("s_waitcnt lgkmcnt(0)" ::: "memory"); __builtin_amdgcn_s_barrier(); asm volatile("" ::: "memory");
            return;
        }
        const bool isq = pn < 8; const int h = isq ? pn : pn - 8;
        const float invn = isq ? 1.0f / QLORA : 1.0f / KVLORA;
        LAS float* RS = P + 1024; LAS int* POS = (LAS int*)(P + 1280);
#pragma unroll
        for (int ai = 0; ai < 2; ++ai) { f32x4 s4[4];
#pragma unroll
            for (int m = 0; m < 4; ++m) s4[m] = *(const LAS f32x4*)(SS4 + (ai * HALF + wr * 64 + m * 16 + fr) * 4);
#pragma unroll
            for (int m = 0; m < 4; ++m) { const float rs = rsqrtf(((s4[m][0] + s4[m][1]) + (s4[m][2] + s4[m][3])) * invn + EPS) * iscale, rr = isq ? rs : iscale;
                const f32x4 a0 = acc[ai][0][m][0], a1 = acc[ai][0][m][1], b0 = acc[ai][1][m][0], b1 = acc[ai][1][m][1];
                float p = (((a0[0] * a0[0] + a0[1] * a0[1]) + (a0[2] * a0[2] + a0[3] * a0[3])) + ((a1[0] * a1[0] + a1[1] * a1[1]) + (a1[2] * a1[2] + a1[3] * a1[3]))) * (rs * rs)
                        + (((b0[0] * b0[0] + b0[1] * b0[1]) + (b0[2] * b0[2] + b0[3] * b0[3])) + ((b1[0] * b1[0] + b1[1] * b1[1]) + (b1[2] * b1[2] + b1[3] * b1[3]))) * (rr * rr);
                p = sum_x16_x32(p);
                const int rl = ai * HALF + wr * 64 + m * 16 + fr;
                if (fq == 0) { P[rl * 4 + wc] = p; if (wc == 0) RS[rl] = rs; } }
            asm volatile("" ::: "memory"); }
        asm volatile("s_waitcnt lgkmcnt(0)" ::: "memory"); __builtin_amdgcn_s_barrier(); asm volatile("" ::: "memory");
        f32x4 gn[2], g1, g2;
        const LAS float* GL = SS4 + 1024 + (isq ? 0 : 192);
#pragma unroll
        for (int n = 0; n < 2; ++n) gn[n] = *(const LAS f32x4*)(GL + wc * 32 + 8 * fq + 4 * n);
        const int ib = (wc & 1) * 16 + 4 * fq;
        g1 = *(const LAS f32x4*)(GL + NOPE + ib); g2 = *(const LAS f32x4*)(GL + NOPE + 32 + ib);
        f32x2 gp[4];
#pragma unroll
        for (int j = 0; j < 4; ++j) { gp[j] = (f32x2){g1[j], g2[j]}; asm volatile("" : "+v"(gp[j])); }
        float irev[4];
#pragma unroll
        for (int j = 0; j < 4; ++j) irev[j] = __builtin_amdgcn_exp2f(-(float)(ib + j) * (13.287712379549449f / 32.0f)) * 0.15915494309189535f;
        bf16_t* Ob = QN + (isq ? (size_t)0 : kn_off) + h * QKD;
#pragma unroll
        for (int ai = 0; ai < 2; ++ai)
#pragma unroll
            for (int m = 0; m < 4; ++m) { const int rl = ai * HALF + wr * 64 + m * 16 + fr, row = u.pm * BM + rl; const f32x4 p4 = *(const LAS f32x4*)(P + rl * 4);
                const float rs = RS[rl];
                const float rinv = rsqrtf(((p4[0] + p4[1]) + (p4[2] + p4[3])) * (1.0f / QKD) + EPS), fn = rs * rinv, fr_ = (isq ? rs : iscale) * rinv;
                const int sq_ = row & (SEQ - 1); bf16_t* kt_ = QN + kn_off + ((size_t)((row >> 11) * MLA_H + h) * NCHK + (sq_ >> 6)) * (24 * 512) + (sq_ & 63) * 8;
                bf16_t* rowp = Ob + (size_t)row * (MLA_H * QKD);
                { const f32x4 v0 = acc[ai][0][m][0] * fn * gn[0], v1 = acc[ai][0][m][1] * fn * gn[1];
                  u32x4 w; w.x = cvt_pk_bf16(v0[0], v0[1]); w.y = cvt_pk_bf16(v0[2], v0[3]); w.z = cvt_pk_bf16(v1[0], v1[1]); w.w = cvt_pk_bf16(v1[2], v1[3]);
                  if (!nostore) { if (isq) *(u32x4*)(rowp + wc * 32 + 8 * fq) = w; else *(u32x4*)(kt_ + (4 * wc + fq) * 512) = w; } }
                if (wc < 2) { const float pos = (float)POS[rl]; float cs_[4], sn_[4];
#pragma unroll
                    for (int j = 0; j < 4; ++j) { const float rev = __builtin_amdgcn_fractf(pos * irev[j]); cs_[j] = __builtin_amdgcn_cosf(rev); sn_[j] = __builtin_amdgcn_sinf(rev); }
                    const f32x4 b0 = acc[ai][1][m][0], b1 = acc[ai][1][m][1];
                    f32x2 ro[4];
#pragma unroll
                    for (int j = 0; j < 4; ++j) { const f32x2 xy = (j == 0 ? (f32x2){b0[0], b0[1]} : j == 1 ? (f32x2){b0[2], b0[3]} : j == 2 ? (f32x2){b1[0], b1[1]} : (f32x2){b1[2], b1[3]}) * gp[j];
                        const float cf = cs_[j] * fr_, sf = sn_[j] * fr_;
                        ro[j] = xy * (f32x2){cf, cf} + (f32x2){xy.y, xy.x} * (f32x2){-sf, sf}; }
                    u32x2 o1, o2;
                    o1.x = cvt_pk_bf16(ro[0].x, ro[1].x); o1.y = cvt_pk_bf16(ro[2].x, ro[3].x);
                    o2.x = cvt_pk_bf16(ro[0].y, ro[1].y); o2.y = cvt_pk_bf16(ro[2].y, ro[3].y);
                    if (nostore) {} else if (isq) { *(u32x2*)(rowp + NOPE + ib) = o1; *(u32x2*)(rowp + NOPE + 32 + ib) = o2; }
                    else { bf16_t* kr_ = kt_ + (16 + 2 * wc + (fq >> 1)) * 512 + 4 * (fq & 1); *(u32x2*)kr_ = o1; *(u32x2*)(kr_ + 4 * 512) = o2; } }
            }
    }
};
struct MlaOrder {
    DenseOrder d;
    __device__ __forceinline__ bool next(int i, Unit& u) const { return d.next(i, u); }
    __device__ __forceinline__ const char* a_base(const Gemm& g, const Unit& u) const { return g.A + (size_t)u.pm * 256 * g.lda * g.es + (u.pn >= 8 ? 256 * g.es : 0); }
    __device__ __forceinline__ const char* b_base(const Gemm& g, const Unit& u) const { return g.Bt + (size_t)u.pn * 256 * g.ldb * g.es; }
    __device__ __forceinline__ const int* toklist(const Unit&) const { return nullptr; }
    __device__ __forceinline__ LAS unsigned* ofs() const { return nullptr; }
};
struct EpiQkvNorm {
    static constexpr bool PERM = true, PREFETCH = true;
    LAS float* P; LAS float* GL;
    __device__ __forceinline__ void prefetch(const Unit& u, int wid, int lane) const {
        if (wid < 4) glds16_s((unsigned)lane * 16u, (const char*)(ss + (size_t)(u.pm * BM + wid * 64) * 4), (unsigned)__builtin_amdgcn_readfirstlane((int)(unsigned)(uintptr_t)P) + (unsigned)wid * 1024u); }
    bf16_t* Q; size_t sect_stride; const float *gq, *gk; const float* ss; float iscale = 1.0f;
    __device__ __forceinline__ void operator()(const f32x4 (&acc)[2][2][4][2], const Unit& u, int wr, int wc, int fr, int fq) const {
        const int sect = u.pn >> 2, head = 4 * (u.pn & 3) + wc;
        bf16_t* O = Q + (size_t)sect * sect_stride + head * 64 + 8 * fq;
        f32x4 g[2][2], ga[2][2], gb[2][2];
#pragma unroll
        for (int bj = 0; bj < 2; ++bj)
#pragma unroll
            for (int n = 0; n < 2; ++n) { ga[bj][n] = *(const LAS f32x4*)(GL + 8 * fq + 32 * bj + 4 * n); gb[bj][n] = *(const LAS f32x4*)(GL + 192 + 8 * fq + 32 * bj + 4 * n); }
        const int row0 = u.pm * BM + wr * 64 + fr;
        float rs8[8];
#pragma unroll
        for (int r8 = 0; r8 < 8; ++r8) { const f32x4 s4 = *(const LAS f32x4*)(P + ((r8 >> 2) * HALF + wr * 64 + (r8 & 3) * 16 + fr) * 4); rs8[r8] = rsqrtf(((s4[0] + s4[1]) + (s4[2] + s4[3])) * (1.0f / DM) + EPS) * iscale; }
#pragma unroll
        for (int bj = 0; bj < 2; ++bj)
#pragma unroll
            for (int n = 0; n < 2; ++n) g[bj][n] = sect == 0 ? ga[bj][n] : (sect == 1 ? gb[bj][n] : (f32x4){1.f, 1.f, 1.f, 1.f});
#pragma unroll
        for (int ai = 0; ai < 2; ++ai)
#pragma unroll
            for (int m = 0; m < 4; ++m) {
                float hs = 0.f;
#pragma unroll
                for (int bj = 0; bj < 2; ++bj)
#pragma unroll
                    for (int n = 0; n < 2; ++n) { const f32x4 x = acc[ai][bj][m][n]; hs += (x[0] * x[0] + x[1] * x[1]) + (x[2] * x[2] + x[3] * x[3]); }
                hs = sum_x16_x32(hs);
                const float rs = rs8[ai * 4 + m];
                const float rinv = sect < 2 ? rs * rsqrtf(hs * rs * rs * (1.0f / 64.0f) + EPS) : rs;
                const int row = row0 + ai * HALF + m * 16, sq_ = row & (SEQ - 1);
                bf16_t* rowp = O + (size_t)row * DM;
                bf16_t* tb_ = Q + (size_t)sect * sect_stride + ((size_t)((row >> 11) * CA_H + head) * NCHK + (sq_ >> 6)) * (8 * 512);
#pragma unroll
                for (int bj = 0; bj < 2; ++bj) { const f32x4 v0 = acc[ai][bj][m][0] * rinv * g[bj][0], v1 = acc[ai][bj][m][1] * rinv * g[bj][1];
                    u32x4 w; w.x = cvt_pk_bf16(v0[0], v0[1]); w.y = cvt_pk_bf16(v0[2], v0[3]); w.z = cvt_pk_bf16(v1[0], v1[1]); w.w = cvt_pk_bf16(v1[2], v1[3]);
                    if (sect == 0) st16(rowp + 32 * bj, w);
                    else if (sect == 1) st16(tb_ + (4 * bj + fq) * 512 + (sq_ & 63) * 8, w);
                    else st16(tb_ + (4 * bj + ((sq_ >> 4) & 3)) * 512 + (sq_ & 15) * 32 + 8 * fq, w); }
            }
    }
};

template <class Epi, class Sched, bool GATHER, bool FP8 = false>
__device__ __forceinline__ void gemm_phase(LAS unsigned char* lds, const int wid, const Gemm g, const Sched& S, const Epi& E) {
    const int wr = wid >> 2, wc = wid & 3;
    constexpr unsigned ES = FP8 ? 1u : 2u;
    const int K = g.K, nt = FP8 ? K / (2 * BK) : K / BK;
    int tid, fr, fq, aoff, boff; unsigned voffB[2], cvA0[2], cvA1[2];
#define PG8_LANE(SETA) do { unsigned z_ = 0u; asm volatile("" : "+v"(z_)); const int lane_ = (int)__builtin_amdgcn_mbcnt_hi(~0u, __builtin_amdgcn_mbcnt_lo(~0u, z_)); \
        tid = wid * 64 + lane_; fr = lane_ & 15; fq = lane_ >> 4; aoff = lds_byte(wr * 64 + fr, fq * 8); boff = lds_byte(wc * 32 + fr, fq * 8); \
        _Pragma("unroll") for (int i = 0; i < 2; ++i) { int R, C; stage_rc(tid * 16 + i * 8192, R, C); const int Rb = Epi::PERM ? ((R & ~31) + perm32(R & 31)) : R; \
            voffB[i] = (unsigned)(Rb * g.ldb) * ES + (unsigned)C * 2u; if (SETA) { cvA0[i] = (unsigned)(R * g.lda) * ES + (unsigned)C * 2u; cvA1[i] = cvA0[i]; } } } while (0)
    PG8_LANE(true);
    const size_t kstep = (size_t)(BK * 2);
    const size_t hstepB = (size_t)HALF * g.ldb * ES;
    const size_t hstepA = GATHER ? (size_t)0 : (size_t)HALF * g.lda * ES;
    const unsigned ldsw = (unsigned)wid * 1024u;
    const unsigned ldsbase = (unsigned)__builtin_amdgcn_readfirstlane((int)(unsigned)(uintptr_t)lds) + ldsw;
#define PG8_SA(b, h) (((b) * 2 + (h)) * HTB)
#define PG8_SB(b, h) ((4 + (b) * 2 + (h)) * HTB)
#define PG8_STAGE(bufoff, gbase, voff) do { if (KL_PROBE && g.probe == 2) break; _Pragma("unroll") for (int _i = 0; _i < 2; ++_i) { unsigned keep_; \
        asm volatile("s_mov_b32 %0, m0\n\ts_mov_b32 m0, %3\n\ts_nop 0\n\tglobal_load_lds_dwordx4 %1, %2\n\ts_mov_b32 m0, %0" \
                     : "=&s"(keep_) : "v"((voff)[_i]), "s"((const char*)(gbase)), "s"(ldsbase + (unsigned)((bufoff) + _i * 8192)) : "memory"); } } while (0)
#define PG8_LDA(dst, b, h) do { _Pragma("unroll") for (int m = 0; m < 4; ++m) _Pragma("unroll") for (int k = 0; k < 2; ++k) dst[m][k] = *(const LAS bf16x8*)(lds + PG8_SA(b, h) + aoff + m * 2048 + k * 1024); } while (0)
#define PG8_LDB(dst, b, h) do { _Pragma("unroll") for (int n = 0; n < 2; ++n) _Pragma("unroll") for (int k = 0; k < 2; ++k) dst[n][k] = *(const LAS bf16x8*)(lds + PG8_SB(b, h) + boff + n * 2048 + k * 1024); } while (0)
#define PG8_CAT(x0, x1) __builtin_shufflevector(__builtin_bit_cast(v4i_t, x0), __builtin_bit_cast(v4i_t, x1), 0, 1, 2, 3, 4, 5, 6, 7)
#define PG8_MMA(ai, bj, At, Bt) do { if (KL_PROBE && g.probe == 1) break; __builtin_amdgcn_s_setprio(1); if constexpr (FP8) { _Pragma("unroll") for (int m = 0; m < 4; ++m) _Pragma("unroll") for (int n = 0; n < 2; ++n) \
        asm("v_mfma_f32_16x16x128_f8f6f4 %0, %1, %2, %0" : "+v"(acc[ai][bj][m][n]) : "v"(PG8_CAT(Bt[n][0], Bt[n][1])), "v"(PG8_CAT(At[m][0], At[m][1]))); } else { \
        _Pragma("unroll") for (int m = 0; m < 4; ++m) _Pragma("unroll") for (int n = 0; n < 2; ++n) _Pragma("unroll") for (int k = 0; k < 2; ++k) \
        acc[ai][bj][m][n] = __builtin_amdgcn_mfma_f32_16x16x32_bf16(Bt[n][k], At[m][k], acc[ai][bj][m][n], 0, 0, 0); } __builtin_amdgcn_s_setprio(0); } while (0)
#define PG8_WAIT_V(n) asm volatile("s_waitcnt vmcnt(" #n ")" ::: "memory")
#define PG8_WAIT_L(n) asm volatile("s_waitcnt lgkmcnt(" #n ")" ::: "memory")
#define PG8_BAR __builtin_amdgcn_s_barrier()
#define PG8_SCHED __builtin_amdgcn_sched_barrier(0)
#define PG8_TOKC(x) ((unsigned)(x) < (unsigned)T_ ? (unsigned)(x) : 0u)
#define PG8_GOFF_G(u, o0, o1) do { const int* tl_ = S.toklist(u); _Pragma("unroll") for (int _i = 0; _i < 2; ++_i) { int R_, C_; stage_rc(tid * 16 + _i * 8192, R_, C_); \
        o0[_i] = PG8_TOKC(tl_[R_]) * (unsigned)g.lda * ES + (unsigned)C_ * 2u; o1[_i] = PG8_TOKC(tl_[HALF + R_]) * (unsigned)g.lda * ES + (unsigned)C_ * 2u; } } while (0)
#define PG8_GOFF_L(par, o0, o1) do { const LAS unsigned* tl_ = S.ofs() + (par) * 256; _Pragma("unroll") for (int _i = 0; _i < 2; ++_i) { int R_, C_; stage_rc(tid * 16 + _i * 8192, R_, C_); \
        o0[_i] = PG8_TOKC(tl_[R_]) * (unsigned)g.lda * ES + (unsigned)C_ * 2u; o1[_i] = PG8_TOKC(tl_[HALF + R_]) * (unsigned)g.lda * ES + (unsigned)C_ * 2u; } } while (0)
    Unit cur, nxt; int ui = 0;
    if (!S.next(0, cur)) return;
    f32x4 acc[2][2][4][2];
#pragma unroll
    for (int a = 0; a < 2; ++a)
#pragma unroll
        for (int b = 0; b < 2; ++b)
#pragma unroll
            for (int m = 0; m < 4; ++m)
#pragma unroll
                for (int n = 0; n < 2; ++n) acc[a][b][m][n] = (f32x4){0.f, 0.f, 0.f, 0.f};
    bf16x8 At[4][2], B0[2][2], B1[2][2];
    const char* cA = S.a_base(g, cur); const char* cB = S.b_base(g, cur);
    if constexpr (GATHER) { PG8_GOFF_G(cur, cvA0, cvA1); }
    PG8_STAGE(PG8_SB(0, 0), cB, voffB); PG8_STAGE(PG8_SB(0, 1), cB + hstepB, voffB); PG8_STAGE(PG8_SA(0, 0), cA, cvA0); PG8_STAGE(PG8_SA(0, 1), cA + hstepA, cvA1);
    if (wr == 1) PG8_BAR;
    PG8_WAIT_V(2); PG8_BAR;
    PG8_STAGE(PG8_SB(1, 0), cB + kstep, voffB); PG8_STAGE(PG8_SA(1, 0), cA + kstep, cvA0); PG8_STAGE(PG8_SB(1, 1), cB + hstepB + kstep, voffB);
    PG8_WAIT_V(6); PG8_BAR;
    for (;;) {
        const bool has_next = S.next(ui + 1, nxt);
        const char* nA = has_next ? S.a_base(g, nxt) : cA; const char* nB = has_next ? S.b_base(g, nxt) : cB;
        if constexpr (GATHER) { if (has_next && wid < 4) {
            unsigned keep_; const unsigned dst_ = (unsigned)__builtin_amdgcn_readfirstlane((int)(unsigned)(uintptr_t)S.ofs()) + (unsigned)(((ui + 1) & 1) * 1024 + wid * 256);
            asm volatile("s_mov_b32 %0, m0\n\ts_mov_b32 m0, %3\n\ts_nop 0\n\tglobal_load_lds_dword %1, %2\n\ts_mov_b32 m0, %0"
                         : "=&s"(keep_) : "v"((unsigned)tid * 4u), "s"((const char*)S.toklist(nxt)), "s"(dst_) : "memory"); } }
        for (int t = 0; t < nt; t += 2) {
            const bool last = (t == nt - 2);
            const char* a1 = cA + (size_t)(t + 1) * kstep;
            const char* a2 = last ? nA : cA + (size_t)(t + 2) * kstep; const char* b2 = last ? nB : cB + (size_t)(t + 2) * kstep;
            const char* a3 = a2 + kstep; const char* b3 = b2 + kstep;
            if constexpr (Epi::PREFETCH) { if (last) E.prefetch(cur, wid, tid & 63); }
            PG8_LDB(B0, 0, 0); PG8_LDB(B1, 0, 1); PG8_SCHED; PG8_LDA(At, 0, 0); PG8_STAGE(PG8_SA(1, 1), a1 + hstepA, cvA1);
            if constexpr (GATHER) { if (last && has_next) { PG8_GOFF_L((ui + 1) & 1, cvA0, cvA1); } }
            PG8_WAIT_V(8); PG8_WAIT_L(0); PG8_BAR; PG8_MMA(0, 0, At, B0); PG8_MMA(0, 1, At, B1); PG8_BAR; PG8_SCHED;
            PG8_LDA(At, 0, 1); PG8_STAGE(PG8_SB(0, 0), b2, voffB); PG8_STAGE(PG8_SB(0, 1), b2 + hstepB, voffB); PG8_STAGE(PG8_SA(0, 0), a2, cvA0);
            PG8_WAIT_V(8); PG8_WAIT_L(0); PG8_BAR; PG8_MMA(1, 0, At, B0); PG8_MMA(1, 1, At, B1); PG8_BAR; PG8_SCHED;
            PG8_LDB(B0, 1, 0); PG8_LDB(B1, 1, 1); PG8_SCHED; PG8_LDA(At, 1, 0); PG8_STAGE(PG8_SA(0, 1), a2 + hstepA, cvA1);
            PG8_WAIT_V(8); PG8_WAIT_L(0); PG8_BAR; PG8_MMA(0, 0, At, B0); PG8_MMA(0, 1, At, B1); PG8_BAR; PG8_SCHED;
            PG8_LDA(At, 1, 1); PG8_STAGE(PG8_SB(1, 0), b3, voffB); PG8_STAGE(PG8_SB(1, 1), b3 + hstepB, voffB); PG8_STAGE(PG8_SA(1, 0), a3, cvA0);
            PG8_WAIT_V(8); PG8_WAIT_L(0); PG8_BAR; PG8_MMA(1, 0, At, B0); PG8_MMA(1, 1, At, B1); PG8_BAR; PG8_SCHED;
        }
        if (wr == 0) PG8_BAR;
        if constexpr (FP8) asm volatile("s_nop 15\n\ts_nop 7" ::: "memory");
        E(acc, cur, wr, wc, fr, fq);
        if (!has_next) break;
        PG8_LANE(!GATHER);
#pragma unroll
        for (int a = 0; a < 2; ++a)
#pragma unroll
            for (int b = 0; b < 2; ++b)
#pragma unroll
                for (int m = 0; m < 4; ++m)
#pragma unroll
                    for (int n = 0; n < 2; ++n) acc[a][b][m][n] = (f32x4){0.f, 0.f, 0.f, 0.f};
        cur = nxt; cA = nA; cB = nB; ++ui;
        if (wr == 1) PG8_BAR;
    }
    PG8_WAIT_V(0);
    PG8_BAR;
#undef PG8_SA
#undef PG8_SB
#undef PG8_STAGE
#undef PG8_LDA
#undef PG8_LDB
#undef PG8_MMA
#undef PG8_CAT
#undef PG8_WAIT_V
#undef PG8_WAIT_L
#undef PG8_BAR
#undef PG8_SCHED
#undef PG8_LANE
#undef PG8_GOFF_G
#undef PG8_GOFF_L
#undef PG8_TOKC
}
}

struct Frame { LAS unsigned char* lds; int tid, lane, wave, vcu, G, gw, NGW; };

typedef float f32x4n __attribute__((ext_vector_type(4)));
template <bool DUAL, class RowFn, class WFn, class EpiFn>
__device__ __forceinline__ void naive_gemm(const Frame& F, int nRowTiles, int N, int K, const bf16_t* A, int lda, RowFn rowfn, WFn wfn, int ldb, EpiFn epi) {
    LAS bf16_t* sA = (LAS bf16_t*)F.lds; LAS bf16_t* sB1 = sA + 64 * 40; LAS bf16_t* sB2 = sB1 + 64 * 40;
    const int ntn = N / 64, tiles = nRowTiles * ntn, wm = F.wave & 1, wn = F.wave >> 1, l15 = F.lane & 15, quad = F.lane >> 4;
    for (int tile = F.vcu; tile < tiles; tile += F.G) {
        const int mt = tile / ntn, n0 = (tile % ntn) * 64;
        const float* B1; const float* B2; wfn(mt, B1, B2);
        const int ar = F.tid >> 3, ak = (F.tid & 7) * 4; const int srow = rowfn(mt * 64 + ar); const bf16_t* arow = A + (size_t)(srow < 0 ? 0 : srow) * lda + ak;
        f32x4n acc1[2] = {}, acc2[2] = {};
        for (int k0 = 0; k0 < K; k0 += 32) {
            *(LAS u32x2*)(sA + ar * 40 + ak) = *(const u32x2*)(arow + k0);
#pragma unroll
            for (int i = 0; i < 4; ++i) { const int idx = F.tid + 512 * i, k = idx >> 6, n = idx & 63;
                sB1[n * 40 + k] = (bf16_t)f2bf(B1[(size_t)(k0 + k) * ldb + n0 + n]);
                if (DUAL) sB2[n * 40 + k] = (bf16_t)f2bf(B2[(size_t)(k0 + k) * ldb + n0 + n]); }
            __syncthreads();
            const bf16x8 b1 = *(const LAS bf16x8*)(sB1 + (wn * 16 + l15) * 40 + quad * 8);
            bf16x8 b2 = b1; if (DUAL) b2 = *(const LAS bf16x8*)(sB2 + (wn * 16 + l15) * 40 + quad * 8);
#pragma unroll
            for (int mi = 0; mi < 2; ++mi) { const bf16x8 a = *(const LAS bf16x8*)(sA + (wm * 32 + mi * 16 + l15) * 40 + quad * 8);
                acc1[mi] = __builtin_amdgcn_mfma_f32_16x16x32_bf16(a, b1, acc1[mi], 0, 0, 0);
                if (DUAL) acc2[mi] = __builtin_amdgcn_mfma_f32_16x16x32_bf16(a, b2, acc2[mi], 0, 0, 0); }
            __syncthreads();
        }
#pragma unroll
        for (int mi = 0; mi < 2; ++mi)
#pragma unroll
            for (int j = 0; j < 4; ++j) { const int r = mt * 64 + wm * 32 + mi * 16 + quad * 4 + j, c = n0 + wn * 16 + l15;
                if (rowfn(r) >= 0) epi(r, c, acc1[mi][j], DUAL ? acc2[mi][j] : 0.f); }
    }
}

struct SrcBlk { const float* W; int ld; int col0; int mode; };
template <bool OUT8 = false, class Map>
__device__ __forceinline__ void conv_matrix(const Frame& F, const Map& map, int Ksrc, int Kd, int Nd, void* WTv, const float* kgain = nullptr, const float oscale = 1.0f) {
    bf16_t* WT = (bf16_t*)WTv; unsigned char* WT8 = (unsigned char*)WTv;
    LAS float* scr = (LAS float*)(F.lds + F.wave * 8704);
    const int nblk = Nd / 32, nitems = (Kd / 64) * nblk, lane = F.lane, lr = lane >> 3, lc = (lane & 7) * 4;
    f32x4 cur[8], nxt[8];
#define CONV_LOAD(item_, v_) do { const int kb_ = (item_) / nblk, nb_ = (item_) % nblk, k0_ = 64 * kb_; const SrcBlk sb_ = map(nb_); \
        _Pragma("unroll") for (int i_ = 0; i_ < 8; ++i_) { const int k_ = k0_ + lr + 8 * i_; \
            if (sb_.mode == 2) { const int c2_ = sb_.col0 + (lc >> 1); v_[i_] = (f32x4){k_ == c2_ ? 1.f : 0.f, k_ == c2_ + 32 ? 1.f : 0.f, k_ == c2_ + 1 ? 1.f : 0.f, k_ == c2_ + 33 ? 1.f : 0.f}; } \
            else { if (sb_.mode == 1) { f32x2 a_ = (f32x2){0.f, 0.f}, b_ = (f32x2){0.f, 0.f}; if (k_ < Ksrc) { const float* p_ = sb_.W + (size_t)k_ * sb_.ld + sb_.col0 + (lc >> 1); a_ = *(const f32x2*)p_; b_ = *(const f32x2*)(p_ + 32); } \
                    v_[i_] = (f32x4){a_.x, b_.x, a_.y, b_.y}; } \
                else v_[i_] = (sb_.W && k_ < Ksrc) ? *(const f32x4*)(sb_.W + (size_t)k_ * sb_.ld + sb_.col0 + lc) : (f32x4){0.f, 0.f, 0.f, 0.f}; \
                if (kgain) { const float g_ = k_ < Ksrc ? kgain[k_] : 0.f; v_[i_] *= g_; } } } } while (0)
    int item = F.gw;
    if (item < nitems) CONV_LOAD(item, cur);
    for (; item < nitems; item += F.NGW) {
        const int ni = item + F.NGW;
        if (ni < nitems) CONV_LOAD(ni, nxt);
        const int kb = item / nblk, nb = item % nblk, k0 = 64 * kb;
#pragma unroll
        for (int i = 0; i < 8; ++i)
#pragma unroll
            for (int j = 0; j < 4; ++j) scr[(lr + 8 * i) * 33 + lc + j] = cur[i][j];
        LDS_WAIT(); asm volatile("" ::: "memory");
        const int c = lane & 7;
#pragma unroll
        for (int j = 0; j < 4; ++j) { const int n = (lane >> 3) + 8 * j; const LAS float* sp = scr + (8 * c) * 33 + n;
            if constexpr (OUT8) { u32x2 o; o.x = pk4_fp8(sp[0 * 33] * oscale, sp[1 * 33] * oscale, sp[2 * 33] * oscale, sp[3 * 33] * oscale); o.y = pk4_fp8(sp[4 * 33] * oscale, sp[5 * 33] * oscale, sp[6 * 33] * oscale, sp[7 * 33] * oscale);
                *(u32x2*)(WT8 + (size_t)(nb * 32 + n) * Kd + k0 + 8 * c) = o; }
            else { u32x4 o; o.x = pk2(sp[0 * 33], sp[1 * 33]); o.y = pk2(sp[2 * 33], sp[3 * 33]); o.z = pk2(sp[4 * 33], sp[5 * 33]); o.w = pk2(sp[6 * 33], sp[7 * 33]);
                *(u32x4*)(WT + (size_t)(nb * 32 + n) * Kd + k0 + 8 * c) = o; } }
        LDS_WAIT(); asm volatile("" ::: "memory");
#pragma unroll
        for (int i = 0; i < 8; ++i) cur[i] = nxt[i];
    }
#undef CONV_LOAD
}
struct MapPlain { const float* W; int N;
    __device__ __forceinline__ SrcBlk operator()(int nb) const { SrcBlk s; s.W = (nb * 32 < N) ? W : nullptr; s.ld = N; s.col0 = nb * 32; s.mode = 0; return s; } };
struct MapGateUp { const float* Wg; const float* Wu; int N;
    __device__ __forceinline__ SrcBlk operator()(int nb) const { const int pn = nb >> 3, w = nb & 7; SrcBlk s; const uintptr_t m = (w < 4) ? (uintptr_t)0 : ~(uintptr_t)0; s.W = (const float*)(((uintptr_t)Wg & ~m) | ((uintptr_t)Wu & m)); s.ld = N; s.col0 = pn * 128 + (w & 3) * 32; s.mode = 0; return s; } };
struct MapQkvCA { const float* W;
    __device__ __forceinline__ SrcBlk operator()(int nb) const { const int pn = nb >> 3, blk = nb & 7, bj = blk >> 2, wc = blk & 3, sect = pn >> 2, t = pn & 3;
        SrcBlk s; s.W = W; s.ld = 3 * DM; s.col0 = sect * DM + (4 * t + wc) * 64 + 32 * bj; s.mode = 0; return s; } };

struct MapMlaQ { const float* W;
    __device__ __forceinline__ SrcBlk operator()(int nb) const { const int h = nb >> 3, blk = nb & 7; SrcBlk s; s.ld = MLA_H * QKD; s.W = blk < 6 ? W : nullptr;
        s.mode = (blk == 4 || blk == 5) ? 1 : 0; s.col0 = blk < 4 ? h * QKD + blk * 32 : h * QKD + NOPE + 16 * (blk & 1); return s; } };
struct MapMlaKV { const float* W;
    __device__ __forceinline__ SrcBlk operator()(int nb) const { const int tl = nb >> 3, blk = nb & 7; SrcBlk s; s.ld = MLA_H * 256; s.W = W; s.mode = 0;
        if (tl < 8) { if (blk < 4) s.col0 = tl * 256 + blk * 32; else if (blk < 6) { s.mode = 2; s.col0 = KVLORA + 16 * (blk - 4); } else { s.W = nullptr; s.col0 = 0; } }
        else { const int hv = 2 * (tl - 8) + (blk >> 2); s.col0 = hv * 256 + NOPE + (blk & 3) * 32; }
        return s; } };

struct ConvSel { SrcBlk sb; int Ksrc, Kd, k0, nb, out8; const float* kgain; unsigned char* WT; float oscale; };
template <class Map>
__device__ __forceinline__ bool conv_pick1(ConvSel& c, int& item, const Map& map, int Ksrc, int Kd, int Nd, void* WT, const float* kgain, int out8, float oscale) {
    const int nblk = Nd / 32, nitems = (Kd / 64) * nblk;
    if (item < nitems) { const int kb = item / nblk; c.nb = item - kb * nblk; c.k0 = 64 * kb; c.sb = map(c.nb); c.Ksrc = Ksrc; c.Kd = Kd; c.out8 = out8; c.kgain = kgain; c.WT = (unsigned char*)WT; c.oscale = oscale; return true; }
    item -= nitems; return false;
}
__device__ __forceinline__ void conv_load(const ConvSel& c, f32x4 (&v)[8], int lr, int lc) {
#pragma unroll
    for (int i = 0; i < 8; ++i) { const int k = c.k0 + lr + 8 * i;
        if (c.sb.mode == 2) { const int c2 = c.sb.col0 + (lc >> 1); v[i] = (f32x4){k == c2 ? 1.f : 0.f, k == c2 + 32 ? 1.f : 0.f, k == c2 + 1 ? 1.f : 0.f, k == c2 + 33 ? 1.f : 0.f}; }
        else { if (c.sb.mode == 1) { f32x2 a = (f32x2){0.f, 0.f}, b = (f32x2){0.f, 0.f}; if (k < c.Ksrc) { const float* q = c.sb.W + (size_t)k * c.sb.ld + c.sb.col0 + (lc >> 1); a = *(const f32x2*)q; b = *(const f32x2*)(q + 32); }
                v[i] = (f32x4){a.x, b.x, a.y, b.y}; }
            else v[i] = (c.sb.W && k < c.Ksrc) ? *(const f32x4*)(c.sb.W + (size_t)k * c.sb.ld + c.sb.col0 + lc) : (f32x4){0.f, 0.f, 0.f, 0.f};
            if (c.kgain) { const float g = k < c.Ksrc ? c.kgain[k] : 0.f; v[i] *= g; } } }
}
__device__ __forceinline__ void conv_store(const ConvSel& c, const f32x4 (&cur)[8], LAS float* scr, int lane, int lr, int lc) {
#pragma unroll
    for (int i = 0; i < 8; ++i)
#pragma unroll
        for (int j = 0; j < 4; ++j) scr[(lr + 8 * i) * 33 + lc + j] = cur[i][j];
    LDS_WAIT(); asm volatile("" ::: "memory");
    const int cc = lane & 7; const float os = c.oscale;
#pragma unroll
    for (int j = 0; j < 4; ++j) { const int n = (lane >> 3) + 8 * j; const LAS float* sp = scr + (8 * cc) * 33 + n;
        if (c.out8) { u32x2 o; o.x = pk4_fp8(sp[0 * 33] * os, sp[1 * 33] * os, sp[2 * 33] * os, sp[3 * 33] * os); o.y = pk4_fp8(sp[4 * 33] * os, sp[5 * 33] * os, sp[6 * 33] * os, sp[7 * 33] * os);
            *(u32x2*)(c.WT + (size_t)(c.nb * 32 + n) * c.Kd + c.k0 + 8 * cc) = o; }
        else { u32x4 o; o.x = pk2(sp[0 * 33], sp[1 * 33]); o.y = pk2(sp[2 * 33], sp[3 * 33]); o.z = pk2(sp[4 * 33], sp[5 * 33]); o.w = pk2(sp[6 * 33], sp[7 * 33]);
            *(u32x4*)((bf16_t*)c.WT + (size_t)(c.nb * 32 + n) * c.Kd + c.k0 + 8 * cc) = o; } }
    LDS_WAIT(); asm volatile("" ::: "memory");
}
struct EvenConv { const float *w_in, *w_uq, *qa, *w_ukv, *kva, *w_o, *wg, *wu, *ffn_norm, *wd; unsigned char* Wb; int up8, ao8, ffn8, in8; const float* attn_norm; };
__device__ __forceinline__ bool even_pick(const EvenConv& e, ConvSel& c, int item) {
    return conv_pick1(c, item, MapGateUp{e.wg, e.wu, FF}, DM, DM, 2 * FF, e.Wb + WE_GU, e.ffn_norm, e.ffn8, e.ffn8 ? 256.0f : 1.0f)
        || conv_pick1(c, item, MapPlain{e.wd, DM}, FF, FF, DM, e.Wb + WE_D, nullptr, e.ffn8, e.ffn8 ? 256.0f : 1.0f)
        || conv_pick1(c, item, MapPlain{e.w_o, DM}, DM, DM, DM, e.Wb + WE_O, nullptr, e.ao8, e.ao8 ? 256.0f : 1.0f)
        || conv_pick1(c, item, MapPlain{e.w_in, AIN}, DM, DM, AINP, e.Wb + WE_IN, e.attn_norm, e.in8, e.in8 ? 256.0f : 1.0f)
        || conv_pick1(c, item, MapMlaQ{e.w_uq}, QLORA, QLORA, MLA_H * 256, e.Wb + WE_QKVF, e.qa, e.up8, e.up8 ? 256.0f : 1.0f)
        || conv_pick1(c, item, MapMlaKV{e.w_ukv}, KVLORA, 256, 12 * 256, e.Wb + WE_QKVF + (size_t)MLA_H * 256 * 256 * (e.up8 ? 1 : 2), e.kva, e.up8, e.up8 ? 256.0f : 1.0f);
}
__device__ __forceinline__ void conv_even(const Frame& F, const EvenConv& e) {
    constexpr int TOTAL = (DM / 64) * (2 * FF / 32) + (FF / 64) * (DM / 32) + (DM / 64) * (DM / 32) + (DM / 64) * (AINP / 32) + (QLORA / 64) * (MLA_H * 256 / 32) + (256 / 64) * (12 * 256 / 32);
    LAS float* scr = (LAS float*)(F.lds + F.wave * 8704);
    const int lane = F.lane, lr = lane >> 3, lc = (lane & 7) * 4;
    f32x4 cur[8], nxt[8]; ConvSel cc, cn;
    int item = F.gw;
    if (item >= TOTAL) return;
    even_pick(e, cc, item); conv_load(cc, cur, lr, lc);
    for (; item < TOTAL; item += F.NGW) {
        const int ni = item + F.NGW < TOTAL ? item + F.NGW : TOTAL - 1;
        even_pick(e, cn, ni); conv_load(cn, nxt, lr, lc);
        conv_store(cc, cur, scr, lane, lr, lc);
#pragma unroll
        for (int i = 0; i < 8; ++i) cur[i] = nxt[i];
        cc = cn;
    }
}

__device__ __forceinline__ void rope_table(const Frame& F, const int* positions, f32x2* CS) {
    for (int idx = F.gw * 64 + F.lane; idx < T_ * 32; idx += F.NGW * 64) { const int t = idx >> 5, i = idx & 31;
        const float inv = exp2f(-(float)i * (13.287712379549449f / 32.0f)); float sn, cs; sincosf((float)positions[t] * inv, &sn, &cs); CS[idx] = (f32x2){cs, sn}; }
}
struct MoeCombine { const int* re; const int* rp; const float* rw; const bf16_t* Y; pg8::MoeInfo mi; };
struct NormRowData { f32x4 x[4]; u32x2 y0[4], y1[4]; float w0, w1; };
template <bool COMBINE>
__device__ __forceinline__ void norm_row_load(NormRowData& d, const float* src, int t, int lane, const MoeCombine& mc, int e0, int e1, int p0, int p1, float w0, float w1) {
    const f32x4* xr = (const f32x4*)(src + (size_t)t * DM) + lane;
#pragma unroll
    for (int j = 0; j < 4; ++j) d.x[j] = xr[64 * j];
    if constexpr (COMBINE) {
        const size_t r0 = (size_t)mc.mi.start_of(e0) * 256 + p0, r1 = (size_t)mc.mi.start_of(e1) * 256 + p1;
        const u32x2* y0 = (const u32x2*)(mc.Y + r0 * DM) + lane; const u32x2* y1 = (const u32x2*)(mc.Y + r1 * DM) + lane;
#pragma unroll
        for (int j = 0; j < 4; ++j) { d.y0[j] = y0[64 * j]; d.y1[j] = y1[64 * j]; }
        d.w0 = w0; d.w1 = w1;
    }
}
template <bool COMBINE, bool WRITE_X, bool WRITE_H, bool OUT8 = false>
__device__ __forceinline__ void norm_rows(const Frame& F, const float* src, float* X, const float* gain, bf16_t* H, const MoeCombine& mc) {
    const int lane = F.lane;
    f32x4 gl[4];
    if constexpr (WRITE_H) {
#pragma unroll
        for (int j = 0; j < 4; ++j) gl[j] = ((const f32x4*)gain)[lane + 64 * j]; }
    NormRowData d, dn;
    int e0n = 0, e1n = 0, p0n = 0, p1n = 0; float w0n = 0.f, w1n = 0.f;
    int t = F.gw;
    if (t < T_) { int e0 = 0, e1 = 0, p0 = 0, p1 = 0; float w0 = 0.f, w1 = 0.f;
        if constexpr (COMBINE) { e0 = mc.re[2 * t]; e1 = mc.re[2 * t + 1]; p0 = mc.rp[2 * t]; p1 = mc.rp[2 * t + 1]; w0 = mc.rw[2 * t]; w1 = mc.rw[2 * t + 1]; }
        norm_row_load<COMBINE>(d, src, t, lane, mc, e0, e1, p0, p1, w0, w1);
        const int t1 = t + F.NGW < T_ ? t + F.NGW : T_ - 1;
        if constexpr (COMBINE) { e0n = mc.re[2 * t1]; e1n = mc.re[2 * t1 + 1]; p0n = mc.rp[2 * t1]; p1n = mc.rp[2 * t1 + 1]; w0n = mc.rw[2 * t1]; w1n = mc.rw[2 * t1 + 1]; } }
    for (; t < T_; t += F.NGW) {
        const int t1 = t + F.NGW, t2 = t1 + F.NGW;
        if (t1 < T_) norm_row_load<COMBINE>(dn, src, t1, lane, mc, e0n, e1n, p0n, p1n, w0n, w1n);
        if constexpr (COMBINE) if (t2 < T_) { e0n = mc.re[2 * t2]; e1n = mc.re[2 * t2 + 1]; p0n = mc.rp[2 * t2]; p1n = mc.rp[2 * t2 + 1]; w0n = mc.rw[2 * t2]; w1n = mc.rw[2 * t2 + 1]; }
        f32x4 v[4];
#pragma unroll
        for (int j = 0; j < 4; ++j) v[j] = d.x[j];
        if constexpr (COMBINE) { const float w0 = d.w0, w1 = d.w1;
#pragma unroll
            for (int j = 0; j < 4; ++j) { const u32x2 a = d.y0[j], b = d.y1[j];
                v[j][0] += w0 * bf2f(a.x & 0xffffu) + w1 * bf2f(b.x & 0xffffu); v[j][1] += w0 * bf2f(a.x >> 16) + w1 * bf2f(b.x >> 16);
                v[j][2] += w0 * bf2f(a.y & 0xffffu) + w1 * bf2f(b.y & 0xffffu); v[j][3] += w0 * bf2f(a.y >> 16) + w1 * bf2f(b.y >> 16); } }
        if constexpr (WRITE_X) { f32x4* xo = (f32x4*)(X + (size_t)t * DM) + lane;
#pragma unroll
            for (int j = 0; j < 4; ++j) xo[64 * j] = v[j]; }
        if constexpr (WRITE_H) {
            float s = 0.f;
#pragma unroll
            for (int j = 0; j < 4; ++j) s += (v[j][0] * v[j][0] + v[j][1] * v[j][1]) + (v[j][2] * v[j][2] + v[j][3] * v[j][3]);
            const float rstd = rsqrtf(wave_sum(s) * (1.0f / DM) + EPS);
            u32x2* ho = (u32x2*)(H + (size_t)t * DM) + lane;
#pragma unroll
            for (int j = 0; j < 4; ++j) { const f32x4 g = gl[j];
                if constexpr (OUT8) { const float r16 = rstd * 16.0f; ((unsigned*)((unsigned char*)H + (size_t)t * DM) + lane)[64 * j] = pk4_fp8(v[j][0] * r16 * g[0], v[j][1] * r16 * g[1], v[j][2] * r16 * g[2], v[j][3] * r16 * g[3]); }
                else { u32x2 o; o.x = cvt_pk_bf16(v[j][0] * rstd * g[0], v[j][1] * rstd * g[1]); o.y = cvt_pk_bf16(v[j][2] * rstd * g[2], v[j][3] * rstd * g[3]); ho[64 * j] = o; } }
        }
        d = dn;
    }
}
struct ResRowData { f32x4 x[4]; u32x2 y0[4], y1[4]; float w0, w1; };
template <bool SRC16, bool COMBINE>
__device__ __forceinline__ void res_row_load(ResRowData& d, const void* src, int t, int lane, const MoeCombine& mc, int e0, int e1, int p0, int p1, float w0, float w1) {
    if constexpr (SRC16) { const u32x2* xr = (const u32x2*)((const bf16_t*)src + (size_t)t * DM) + lane;
#pragma unroll
        for (int j = 0; j < 4; ++j) { const u32x2 a = xr[64 * j]; d.x[j] = (f32x4){bf2f(a.x & 0xffffu), bf2f(a.x >> 16), bf2f(a.y & 0xffffu), bf2f(a.y >> 16)}; } }
    else { const f32x4* xr = (const f32x4*)((const float*)src + (size_t)t * DM) + lane;
#pragma unroll
        for (int j = 0; j < 4; ++j) d.x[j] = xr[64 * j]; }
    if constexpr (COMBINE) {
        const size_t r0 = (size_t)mc.mi.start_of(e0) * 256 + p0, r1 = (size_t)mc.mi.start_of(e1) * 256 + p1;
        const u32x2* y0 = (const u32x2*)(mc.Y + r0 * DM) + lane; const u32x2* y1 = (const u32x2*)(mc.Y + r1 * DM) + lane;
#pragma unroll
        for (int j = 0; j < 4; ++j) { d.y0[j] = y0[64 * j]; d.y1[j] = y1[64 * j]; }
        d.w0 = w0; d.w1 = w1;
    }
}
template <bool SRC16, bool COMBINE, bool WRITE_XB, bool WRITE_H, bool WRITE_F32>
__device__ __forceinline__ void res_rows(const Frame& F, const void* src, bf16_t* XB, const float* gain, bf16_t* H, float* OUT, const MoeCombine& mc, const bool h8 = false, float* ssout = nullptr) {
    const int lane = F.lane; float keep_s = 0.f; int irow = 0;
    f32x4 gl[4];
    if constexpr (WRITE_H) {
#pragma unroll
        for (int j = 0; j < 4; ++j) gl[j] = ((const f32x4*)gain)[lane + 64 * j]; }
    ResRowData d, dn;
    int e0n = 0, e1n = 0, p0n = 0, p1n = 0; float w0n = 0.f, w1n = 0.f;
    int t = F.gw;
    if (t < T_) { int e0 = 0, e1 = 0, p0 = 0, p1 = 0; float w0 = 0.f, w1 = 0.f;
        if constexpr (COMBINE) { e0 = mc.re[2 * t]; e1 = mc.re[2 * t + 1]; p0 = mc.rp[2 * t]; p1 = mc.rp[2 * t + 1]; w0 = mc.rw[2 * t]; w1 = mc.rw[2 * t + 1]; }
        res_row_load<SRC16, COMBINE>(d, src, t, lane, mc, e0, e1, p0, p1, w0, w1);
        const int t1 = t + F.NGW < T_ ? t + F.NGW : T_ - 1;
        if constexpr (COMBINE) { e0n = mc.re[2 * t1]; e1n = mc.re[2 * t1 + 1]; p0n = mc.rp[2 * t1]; p1n = mc.rp[2 * t1 + 1]; w0n = mc.rw[2 * t1]; w1n = mc.rw[2 * t1 + 1]; } }
    for (; t < T_; t += F.NGW) {
        const int t1 = t + F.NGW < T_ ? t + F.NGW : T_ - 1, t2 = t + 2 * F.NGW < T_ ? t + 2 * F.NGW : T_ - 1;
        res_row_load<SRC16, COMBINE>(dn, src, t1, lane, mc, e0n, e1n, p0n, p1n, w0n, w1n);
        if constexpr (COMBINE) { e0n = mc.re[2 * t2]; e1n = mc.re[2 * t2 + 1]; p0n = mc.rp[2 * t2]; p1n = mc.rp[2 * t2 + 1]; w0n = mc.rw[2 * t2]; w1n = mc.rw[2 * t2 + 1]; }
        f32x4 v[4];
#pragma unroll
        for (int j = 0; j < 4; ++j) v[j] = d.x[j];
        if constexpr (COMBINE) { const float w0 = d.w0, w1 = d.w1;
#pragma unroll
            for (int j = 0; j < 4; ++j) { const u32x2 a = d.y0[j], b = d.y1[j];
                v[j][0] += w0 * bf2f(a.x & 0xffffu) + w1 * bf2f(b.x & 0xffffu); v[j][1] += w0 * bf2f(a.x >> 16) + w1 * bf2f(b.x >> 16);
                v[j][2] += w0 * bf2f(a.y & 0xffffu) + w1 * bf2f(b.y & 0xffffu); v[j][3] += w0 * bf2f(a.y >> 16) + w1 * bf2f(b.y >> 16); } }
        if constexpr (WRITE_F32) { f32x4* xo = (f32x4*)(OUT + (size_t)t * DM) + lane;
#pragma unroll
            for (int j = 0; j < 4; ++j) xo[64 * j] = v[j]; }
        if constexpr (WRITE_XB) { u32x2* xo = (u32x2*)(XB + (size_t)t * DM) + lane;
#pragma unroll
            for (int j = 0; j < 4; ++j) { u32x2 o; o.x = cvt_pk_bf16(v[j][0], v[j][1]); o.y = cvt_pk_bf16(v[j][2], v[j][3]); xo[64 * j] = o; } }
        if constexpr (WRITE_XB && !WRITE_H) { if (ssout) {
            float s = 0.f;
#pragma unroll
            for (int j = 0; j < 4; ++j) s += (v[j][0] * v[j][0] + v[j][1] * v[j][1]) + (v[j][2] * v[j][2] + v[j][3] * v[j][3]);
            s = wave_sum(s); keep_s = lane == irow ? s : keep_s; } }
        ++irow;
        if constexpr (WRITE_H) {
            float s = 0.f;
#pragma unroll
            for (int j = 0; j < 4; ++j) s += (v[j][0] * v[j][0] + v[j][1] * v[j][1]) + (v[j][2] * v[j][2] + v[j][3] * v[j][3]);
            const float rstd = rsqrtf(wave_sum(s) * (1.0f / DM) + EPS);
            if (h8) { const float r16 = rstd * 16.0f; unsigned* ho8 = (unsigned*)((unsigned char*)H + (size_t)t * DM) + lane;
#pragma unroll
                for (int j = 0; j < 4; ++j) { const f32x4 g = gl[j]; ho8[64 * j] = pk4_fp8(v[j][0] * r16 * g[0], v[j][1] * r16 * g[1], v[j][2] * r16 * g[2], v[j][3] * r16 * g[3]); } }
            else { u32x2* ho = (u32x2*)(H + (size_t)t * DM) + lane;
#pragma unroll
            for (int j = 0; j < 4; ++j) { const f32x4 g = gl[j]; u32x2 o; o.x = cvt_pk_bf16(v[j][0] * rstd * g[0], v[j][1] * rstd * g[1]); o.y = cvt_pk_bf16(v[j][2] * rstd * g[2], v[j][3] * rstd * g[3]); ho[64 * j] = o; } }
        }
        d = dn;
    }
    if constexpr (WRITE_XB && !WRITE_H) { if (ssout && lane < irow) *(f32x4*)(ssout + (size_t)(F.gw + lane * F.NGW) * 4) = (f32x4){keep_s, 0.f, 0.f, 0.f}; }
}
struct MlaTok { u32x2 aq, akv, qraw[MLA_H], kraw[MLA_H], vraw[MLA_H]; float pos; };
__device__ __forceinline__ void mla_tok_load(MlaTok& d, int t, int lane, const bf16_t* Qraw, const bf16_t* KVraw, const bf16_t* A1, const int* positions) {
    const u32x2* ap = (const u32x2*)(A1 + (size_t)t * AINP) + lane;
    d.aq = ap[0]; d.akv = (u32x2){0u, 0u}; if (lane < 48) d.akv = ap[64];
    d.pos = (float)positions[t];
#pragma unroll
    for (int h = 0; h < MLA_H; ++h) { d.qraw[h] = (u32x2){0u, 0u}; d.kraw[h] = (u32x2){0u, 0u}; d.vraw[h] = (u32x2){0u, 0u};
        if (lane < 48) d.qraw[h] = *((const u32x2*)(Qraw + (size_t)t * 1536 + h * QKD) + lane);
        if (lane < 32) { d.kraw[h] = *((const u32x2*)(KVraw + (size_t)t * 2048 + h * 256) + lane); d.vraw[h] = *((const u32x2*)(KVraw + (size_t)t * 2048 + h * 256 + 128) + lane); } }
}
__device__ __forceinline__ void mla_qk_norm_rope(const Frame& F, const bf16_t* Qraw, bf16_t* KVraw, const bf16_t* A1, const int* positions, const float* gq, const float* gk, bf16_t* QN, bf16_t* KN) {
    const int lane = F.lane; const bool act = lane < 48, isrope = lane >= 32 && lane < 48, second = lane >= 40;
    const f32x4 gql = act ? ((const f32x4*)gq)[lane] : (f32x4){0.f, 0.f, 0.f, 0.f};
    const f32x4 gkl = act ? ((const f32x4*)gk)[lane] : (f32x4){0.f, 0.f, 0.f, 0.f};
    float invf[4];
#pragma unroll
    for (int j = 0; j < 4; ++j) invf[j] = exp2f(-(float)(4 * (lane & 7) + j) * (13.287712379549449f / 32.0f));
    MlaTok d, dn;
    int t = F.gw;
    if (t < T_) mla_tok_load(d, t, lane, Qraw, KVraw, A1, positions);
    for (; t < T_; t += F.NGW) {
        const int tn = t + F.NGW;
        if (tn < T_) mla_tok_load(dn, tn, lane, Qraw, KVraw, A1, positions);
        float cs[4], sn[4];
#pragma unroll
        for (int j = 0; j < 4; ++j) sincosf(d.pos * invf[j], &sn[j], &cs[j]);
        const u32x2 kr = d.akv;
        float rq, rkv;
        { const float q0 = bf2f(d.aq.x & 0xffffu), q1 = bf2f(d.aq.x >> 16), q2 = bf2f(d.aq.y & 0xffffu), q3 = bf2f(d.aq.y >> 16);
          const float k0 = bf2f(d.akv.x & 0xffffu), k1 = bf2f(d.akv.x >> 16), k2 = bf2f(d.akv.y & 0xffffu), k3 = bf2f(d.akv.y >> 16);
          rq = rsqrtf(wave_sum((q0 * q0 + q1 * q1) + (q2 * q2 + q3 * q3)) * (1.0f / QLORA) + EPS);
          rkv = rsqrtf(wave_sum(lane < 32 ? (k0 * k0 + k1 * k1) + (k2 * k2 + k3 * k3) : 0.f) * (1.0f / KVLORA) + EPS); }
#pragma unroll
        for (int h = 0; h < MLA_H; ++h) {
#pragma unroll
            for (int qk = 0; qk < 2; ++qk) {
                const u32x2 raw = qk == 0 ? d.qraw[h] : (lane < 32 ? d.kraw[h] : kr);
                const float sc = qk == 0 ? rq : (lane < 32 ? rkv : 1.0f);
                float v[4] = {bf2f(raw.x & 0xffffu) * sc, bf2f(raw.x >> 16) * sc, bf2f(raw.y & 0xffffu) * sc, bf2f(raw.y >> 16) * sc};
                const float ss = wave_sum(act ? (v[0] * v[0] + v[1] * v[1]) + (v[2] * v[2] + v[3] * v[3]) : 0.f);
                const float rinv = rsqrtf(ss * (1.0f / QKD) + EPS); const f32x4 g = qk == 0 ? gql : gkl;
                float y[4], o[4];
#pragma unroll
                for (int j = 0; j < 4; ++j) y[j] = v[j] * rinv * g[j];
#pragma unroll
                for (int j = 0; j < 4; ++j) { const float pr = __shfl_xor(y[j], 8);
                    o[j] = isrope ? (second ? (pr * sn[j] + y[j] * cs[j]) : (y[j] * cs[j] - pr * sn[j])) : y[j]; }
                if (act) { u32x2 w; w.x = pk2(o[0], o[1]); w.y = pk2(o[2], o[3]); *((u32x2*)((qk == 0 ? QN : KN) + (size_t)t * 1536 + h * QKD) + lane) = w; }
            }
            if (lane < 32) { const u32x2 r = d.vraw[h]; u32x2 w; w.x = pk2(bf2f(r.x & 0xffffu) * rkv, bf2f(r.x >> 16) * rkv); w.y = pk2(bf2f(r.y & 0xffffu) * rkv, bf2f(r.y >> 16) * rkv);
                *((u32x2*)(KVraw + (size_t)t * 2048 + h * 256 + 128) + lane) = w; }
        }
        d = dn;
    }
}
__device__ __forceinline__ void ca_head_norm(const Frame& F, bf16_t* Q, const float* g) {
    for (int t = F.gw; t < T_; t += F.NGW) {
#pragma unroll 1
        for (int hh = 0; hh < 4; ++hh) {
            u32x2* p = (u32x2*)(Q + (size_t)t * DM + hh * 256) + F.lane; const u32x2 a = *p;
            float v[4] = {bf2f(a.x & 0xffffu), bf2f(a.x >> 16), bf2f(a.y & 0xffffu), bf2f(a.y >> 16)};
            float ss = (v[0] * v[0] + v[1] * v[1]) + (v[2] * v[2] + v[3] * v[3]);
            ss += __shfl_xor(ss, 1); ss += __shfl_xor(ss, 2); ss += __shfl_xor(ss, 4); ss += __shfl_xor(ss, 8);
            const float rinv = rsqrtf(ss * (1.0f / 64.0f) + EPS); const f32x4 gg = ((const f32x4*)g)[F.lane & 15];
            u32x2 o; o.x = pk2(v[0] * rinv * gg[0], v[1] * rinv * gg[1]); o.y = pk2(v[2] * rinv * gg[2], v[3] * rinv * gg[3]); *p = o;
        }
    }
}
template <bool OUT8>
__device__ __forceinline__ void norm_router(const Frame& F, const bf16_t* X, const float* gain, const float* router, void* Hv, int* re, int* rp, float* rw, int* perm, gu32* cnt, const bool probe = false) {
    bf16_t* H = (bf16_t*)Hv; unsigned char* H8 = (unsigned char*)Hv;
    LAS unsigned* bc = (LAS unsigned*)(F.lds);
    LAS float* RT = (LAS float*)(F.lds + 256);
    if (F.tid < 16) bc[F.tid] = 0u;
    { const f32x4* rq = (const f32x4*)router + F.tid * 4; const f32x4 q0 = rq[0], q1 = rq[1], q2 = rq[2], q3 = rq[3]; const int k = F.tid * 2;
#pragma unroll
      for (int e = 0; e < 4; ++e) { RT[e * DM + k] = q0[e]; RT[(e + 4) * DM + k] = q1[e]; RT[e * DM + k + 1] = q2[e]; RT[(e + 4) * DM + k + 1] = q3[e]; } }
    __syncthreads();
    const int lane = F.lane; const bool b0 = lane & 1, b1 = lane & 2, b2 = lane & 4;
    f32x4 gl[4];
#pragma unroll
    for (int j = 0; j < 4; ++j) gl[j] = ((const f32x4*)gain)[lane + 64 * j];
    int ke0 = 0, ke1 = 0, kl0 = 0, kl1 = 0; float kw0 = 0.f, kw1 = 0.f; int i = 0;
    constexpr int R = 2;
    u32x2 v[R][4], vn[R][4];
#ifndef E5_PROBE
#define E5_PROBE 0
#endif
    const int nrows = (E5_PROBE && probe) ? 0 : (F.gw < T_ ? (T_ - F.gw + F.NGW - 1) / F.NGW : 0);
    int t = F.gw;
#pragma unroll
    for (int r = 0; r < R; ++r) { const int tr = t + r * F.NGW, tc = tr < T_ ? tr : T_ - 1; const u32x2* xr = (const u32x2*)(X + (size_t)tc * DM) + lane;
#pragma unroll
        for (int j = 0; j < 4; ++j) v[r][j] = xr[64 * j]; }
    for (; i + R <= nrows; t += R * F.NGW, i += R) {
#pragma unroll
        for (int r = 0; r < R; ++r) { const int tn = t + (R + r) * F.NGW, tc = tn < T_ ? tn : T_ - 1; const u32x2* xr = (const u32x2*)(X + (size_t)tc * DM) + lane;
#pragma unroll
            for (int j = 0; j < 4; ++j) vn[r][j] = xr[64 * j]; }
        float s[R], rstd[R];
#pragma unroll
        for (int r = 0; r < R; ++r) { s[r] = 0.f;
#pragma unroll
            for (int j = 0; j < 4; ++j) { const u32x2 a = v[r][j]; const float x0 = bf2f(a.x & 0xffffu), x1 = bf2f(a.x >> 16), x2 = bf2f(a.y & 0xffffu), x3 = bf2f(a.y >> 16); s[r] += (x0 * x0 + x1 * x1) + (x2 * x2 + x3 * x3); } }
#pragma unroll
        for (int r = 0; r < R; ++r) rstd[r] = rsqrtf(wave_sum(s[r]) * (1.0f / DM) + EPS);
        float lg[R][8];
#pragma unroll
        for (int r = 0; r < R; ++r)
#pragma unroll
            for (int e = 0; e < 8; ++e) lg[r][e] = 0.f;
#pragma unroll
        for (int j = 0; j < 4; ++j) { f32x4 h[R];
#pragma unroll
            for (int r = 0; r < R; ++r) { const int tr = t + r * F.NGW; const u32x2 a = v[r][j]; h[r] = (f32x4){bf2f(a.x & 0xffffu), bf2f(a.x >> 16), bf2f(a.y & 0xffffu), bf2f(a.y >> 16)} * rstd[r] * gl[j];
                if constexpr (OUT8) { ((unsigned*)(H8 + (size_t)tr * DM) + lane)[64 * j] = pk4_fp8(h[r][0] * 16.0f, h[r][1] * 16.0f, h[r][2] * 16.0f, h[r][3] * 16.0f); }
                else { u32x2 o; o.x = cvt_pk_bf16(h[r][0], h[r][1]); o.y = cvt_pk_bf16(h[r][2], h[r][3]); ((u32x2*)(H + (size_t)tr * DM) + lane)[64 * j] = o; } }
#pragma unroll
            for (int e = 0; e < 8; ++e) { const f32x4 rt = *(const LAS f32x4*)(RT + e * DM + 256 * j + 4 * lane);
#pragma unroll
                for (int r = 0; r < R; ++r) lg[r][e] += (h[r][0] * rt[0] + h[r][1] * rt[1]) + (h[r][2] * rt[2] + h[r][3] * rt[3]); } }
        int e0[R], e1[R]; float w0[R], w1[R];
#pragma unroll
        for (int r = 0; r < R; ++r) { float L[8];
#pragma unroll
            for (int e = 0; e < 8; ++e) L[e] = wave_sum(lg[r][e]);
            e0[r] = 0; float l0 = L[0];
#pragma unroll
            for (int e = 1; e < 8; ++e) if (L[e] > l0) { l0 = L[e]; e0[r] = e; }
            e1[r] = -1; float l1 = -3.0e38f;
#pragma unroll
            for (int e = 0; e < 8; ++e) if (e != e0[r] && L[e] > l1) { l1 = L[e]; e1[r] = e; }
            const float ex = __expf(l1 - l0); w0[r] = 1.0f / (1.0f + ex); w1[r] = ex * w0[r]; }
        int lp0[R], lp1[R];
#pragma unroll
        for (int r = 0; r < R; ++r) { lp0[r] = 0; lp1[r] = 0; }
        if (lane == 0) {
#pragma unroll
            for (int r = 0; r < R; ++r) { lp0[r] = (int)__hip_atomic_fetch_add(bc + e0[r], 1u, __ATOMIC_RELAXED, __HIP_MEMORY_SCOPE_WORKGROUP); lp1[r] = (int)__hip_atomic_fetch_add(bc + e1[r], 1u, __ATOMIC_RELAXED, __HIP_MEMORY_SCOPE_WORKGROUP); } }
#pragma unroll
        for (int r = 0; r < R; ++r) { const int q0 = __builtin_amdgcn_readfirstlane(lp0[r]), q1 = __builtin_amdgcn_readfirstlane(lp1[r]);
            if (lane == i + r) { ke0 = e0[r]; ke1 = e1[r]; kl0 = q0; kl1 = q1; kw0 = w0[r]; kw1 = w1[r]; } }
#pragma unroll
        for (int r = 0; r < R; ++r)
#pragma unroll
            for (int j = 0; j < 4; ++j) v[r][j] = vn[r][j];
    }
    for (; i < nrows; t += F.NGW, ++i) {
        const u32x2* xr = (const u32x2*)(X + (size_t)t * DM) + lane; f32x4 x[4]; float s = 0.f;
#pragma unroll
        for (int j = 0; j < 4; ++j) { const u32x2 a = xr[64 * j]; x[j] = (f32x4){bf2f(a.x & 0xffffu), bf2f(a.x >> 16), bf2f(a.y & 0xffffu), bf2f(a.y >> 16)}; s += (x[j][0] * x[j][0] + x[j][1] * x[j][1]) + (x[j][2] * x[j][2] + x[j][3] * x[j][3]); }
        const float rstd = rsqrtf(wave_sum(s) * (1.0f / DM) + EPS);
        float L[8];
#pragma unroll
        for (int e = 0; e < 8; ++e) L[e] = 0.f;
#pragma unroll
        for (int j = 0; j < 4; ++j) { const f32x4 h = x[j] * rstd * gl[j];
            if constexpr (OUT8) { ((unsigned*)(H8 + (size_t)t * DM) + lane)[64 * j] = pk4_fp8(h[0] * 16.0f, h[1] * 16.0f, h[2] * 16.0f, h[3] * 16.0f); } else { u32x2 o; o.x = cvt_pk_bf16(h[0], h[1]); o.y = cvt_pk_bf16(h[2], h[3]); ((u32x2*)(H + (size_t)t * DM) + lane)[64 * j] = o; }
#pragma unroll
            for (int e = 0; e < 8; ++e) { const f32x4 rt = *(const LAS f32x4*)(RT + e * DM + 256 * j + 4 * lane); L[e] += (h[0] * rt[0] + h[1] * rt[1]) + (h[2] * rt[2] + h[3] * rt[3]); } }
#pragma unroll
        for (int e = 0; e < 8; ++e) L[e] = wave_sum(L[e]);
        int e0 = 0; float l0 = L[0];
#pragma unroll
        for (int e = 1; e < 8; ++e) if (L[e] > l0) { l0 = L[e]; e0 = e; }
        int e1 = -1; float l1 = -3.0e38f;
#pragma unroll
        for (int e = 0; e < 8; ++e) if (e != e0 && L[e] > l1) { l1 = L[e]; e1 = e; }
        const float ex = __expf(l1 - l0), w0 = 1.0f / (1.0f + ex), w1 = ex * w0;
        int lp0 = 0, lp1 = 0;
        if (lane == 0) { lp0 = (int)__hip_atomic_fetch_add(bc + e0, 1u, __ATOMIC_RELAXED, __HIP_MEMORY_SCOPE_WORKGROUP); lp1 = (int)__hip_atomic_fetch_add(bc + e1, 1u, __ATOMIC_RELAXED, __HIP_MEMORY_SCOPE_WORKGROUP); }
        lp0 = __builtin_amdgcn_readfirstlane(lp0); lp1 = __builtin_amdgcn_readfirstlane(lp1);
        if (lane == i) { ke0 = e0; ke1 = e1; kl0 = lp0; kl1 = lp1; kw0 = w0; kw1 = w1; }
    }
    __syncthreads();
    if (F.tid < 8 && !probe) bc[8 + F.tid] = __hip_atomic_fetch_add(cnt + 64 * F.tid, bc[F.tid], RLX_AGENT);
    __syncthreads();
    if (lane < i && !probe) { const int tt = F.gw + lane * F.NGW; const int p0 = (int)bc[8 + ke0] + kl0, p1 = (int)bc[8 + ke1] + kl1;
        re[2 * tt] = ke0; re[2 * tt + 1] = ke1; rp[2 * tt] = p0; rp[2 * tt + 1] = p1; rw[2 * tt] = kw0; rw[2 * tt + 1] = kw1; perm[(size_t)ke0 * T_ + p0] = tt; perm[(size_t)ke1 * T_ + p1] = tt; }
    __syncthreads();
}

template <int DQK, int DV, bool BAND>
__device__ __forceinline__ void attn_naive(const Frame& F, const bf16_t* Q, int ldq, const bf16_t* K, int ldk, const bf16_t* V, int ldv, bf16_t* O, int ldo, int nheads, const float* bias, float scale) {
    constexpr int QS = DQK + 4, KS = DQK + 8, VS = DV + 8, DG = DV / 8;
    LAS float* Qs = (LAS float*)F.lds; LAS bf16_t* Ks = (LAS bf16_t*)(Qs + 64 * QS); LAS bf16_t* Vs = Ks + 64 * KS; LAS float* Ss = (LAS float*)(Vs + 64 * VS);
    LAS float* mS = Ss + 64 * 65; LAS float* lS = mS + 64; LAS float* aS = lS + 64; LAS float* bS = aS + 64;
    const int tid = F.tid, qi = tid & 63, kw = tid >> 6, nunits = NBATCH * nheads * NCHK;
    for (int un = F.vcu; un < nunits; un += F.G) {
        const int c = (NCHK - 1) - un / (NBATCH * nheads), bh = un % (NBATCH * nheads), b = bh / nheads, h = bh % nheads;
        const size_t row0 = (size_t)b * SEQ + (size_t)c * 64;
        __syncthreads();
        for (int idx = tid; idx < 64 * DQK / 4; idx += 512) { const int r = idx / (DQK / 4), c4 = idx % (DQK / 4);
            const u32x2 a = *(const u32x2*)(Q + (row0 + r) * ldq + h * DQK + c4 * 4);
            *(LAS f32x4*)(Qs + r * QS + c4 * 4) = (f32x4){bf2f(a.x & 0xffffu), bf2f(a.x >> 16), bf2f(a.y & 0xffffu), bf2f(a.y >> 16)}; }
        if (tid < 64) { mS[tid] = -3.0e38f; lS[tid] = 0.f; }
        if (BAND) for (int idx = tid; idx < NREL; idx += 512) bS[idx] = bias[h * NREL + idx];
        float o[DG];
#pragma unroll
        for (int d = 0; d < DG; ++d) o[d] = 0.f;
        const int kc0 = BAND ? (c - 8 > 0 ? c - 8 : 0) : 0;
        for (int kc = kc0; kc <= c; ++kc) {
            const size_t krow0 = (size_t)b * SEQ + (size_t)kc * 64;
            __syncthreads();
            for (int idx = tid; idx < 64 * DQK / 8; idx += 512) { const int r = idx / (DQK / 8), c8 = idx % (DQK / 8);
                *(LAS u32x4*)(Ks + r * KS + c8 * 8) = *(const u32x4*)(K + (krow0 + r) * ldk + h * DQK + c8 * 8); }
            for (int idx = tid; idx < 64 * DV / 8; idx += 512) { const int r = idx / (DV / 8), c8 = idx % (DV / 8);
                *(LAS u32x4*)(Vs + r * VS + c8 * 8) = *(const u32x4*)(V + (krow0 + r) * ldv + h * DV + c8 * 8); }
            __syncthreads();
            float s[8] = {0.f, 0.f, 0.f, 0.f, 0.f, 0.f, 0.f, 0.f};
            for (int d = 0; d < DQK; d += 8) {
                const f32x4 qa = *(const LAS f32x4*)(Qs + qi * QS + d), qb = *(const LAS f32x4*)(Qs + qi * QS + d + 4);
#pragma unroll
                for (int j = 0; j < 8; ++j) { const u32x4 kk = *(const LAS u32x4*)(Ks + (kw + 8 * j) * KS + d);
                    s[j] += qa[0] * bf2f(kk.x & 0xffffu) + qa[1] * bf2f(kk.x >> 16) + qa[2] * bf2f(kk.y & 0xffffu) + qa[3] * bf2f(kk.y >> 16)
                          + qb[0] * bf2f(kk.z & 0xffffu) + qb[1] * bf2f(kk.z >> 16) + qb[2] * bf2f(kk.w & 0xffffu) + qb[3] * bf2f(kk.w >> 16); }
            }
#pragma unroll
            for (int j = 0; j < 8; ++j) { const int kj = kw + 8 * j; float sv = s[j] * scale;
                if (BAND) { int rel = (c * 64 + qi) - (kc * 64 + kj); rel = rel < -63 ? -63 : (rel > 256 ? 256 : rel); sv += bS[rel + 63]; }
                Ss[qi * 65 + kj] = sv; }
            __syncthreads();
            if (tid < 64) { float mo = mS[tid], mx = mo;
                for (int j = 0; j < 64; ++j) mx = fmaxf(mx, Ss[tid * 65 + j]);
                const float al = __expf(mo - mx); float sum = 0.f;
                for (int j = 0; j < 64; ++j) { const float p = __expf(Ss[tid * 65 + j] - mx); Ss[tid * 65 + j] = p; sum += p; }
                lS[tid] = lS[tid] * al + sum; mS[tid] = mx; aS[tid] = al; }
            __syncthreads();
            { const float al = aS[qi];
#pragma unroll
              for (int d = 0; d < DG; ++d) o[d] *= al;
              for (int kj = 0; kj < 64; ++kj) { const float p = Ss[qi * 65 + kj];
#pragma unroll
                  for (int d8 = 0; d8 < DG / 8; ++d8) { const u32x4 vv = *(const LAS u32x4*)(Vs + kj * VS + kw * DG + d8 * 8);
                      o[d8 * 8 + 0] += p * bf2f(vv.x & 0xffffu); o[d8 * 8 + 1] += p * bf2f(vv.x >> 16); o[d8 * 8 + 2] += p * bf2f(vv.y & 0xffffu); o[d8 * 8 + 3] += p * bf2f(vv.y >> 16);
                      o[d8 * 8 + 4] += p * bf2f(vv.z & 0xffffu); o[d8 * 8 + 5] += p * bf2f(vv.z >> 16); o[d8 * 8 + 6] += p * bf2f(vv.w & 0xffffu); o[d8 * 8 + 7] += p * bf2f(vv.w >> 16); } } }
        }
        { const float li = 1.0f / lS[qi]; bf16_t* op = O + (row0 + qi) * ldo + h * DV + kw * DG;
#pragma unroll
          for (int d8 = 0; d8 < DG / 8; ++d8) { u32x4 w; w.x = pk2(o[d8 * 8 + 0] * li, o[d8 * 8 + 1] * li); w.y = pk2(o[d8 * 8 + 2] * li, o[d8 * 8 + 3] * li);
              w.z = pk2(o[d8 * 8 + 4] * li, o[d8 * 8 + 5] * li); w.w = pk2(o[d8 * 8 + 6] * li, o[d8 * 8 + 7] * li); *(u32x4*)(op + d8 * 8) = w; } }
    }
    __syncthreads();
}


namespace att {
typedef float f32x16 __attribute__((ext_vector_type(16)));
typedef short v4i16_t __attribute__((ext_vector_type(4)));
constexpr float THR = 8.0f;
__device__ __forceinline__ float vmax3(float a, float b, float c) { float r; asm("v_max3_f32 %0, %1, %2, %3" : "=v"(r) : "v"(a), "v"(b), "v"(c)); return r; }
__device__ __forceinline__ int crow(int r, int hi) { return (r & 3) + 8 * (r >> 2) + 4 * hi; }
__device__ __forceinline__ s16x4 vtr(const LAS unsigned char* p) { return __builtin_bit_cast(s16x4, __builtin_amdgcn_ds_read_tr16_b64_v4i16((LAS v4i16_t*)p)); }
__device__ __forceinline__ unsigned cvtpk(float lo, float hi) { typedef __bf16 bf16x2_t __attribute__((ext_vector_type(2))); f32x2 v = {lo, hi}; bf16x2_t b = __builtin_convertvector(v, bf16x2_t); return __builtin_bit_cast(unsigned, b); }

template <int DQK, int BS>
__device__ __forceinline__ void qk_tile(const LAS unsigned char* Kb, const bf16x8 (&qr)[DQK / 16], f32x16& p0, f32x16& p1, const int r32, const int hi) {
#pragma unroll
    for (int r = 0; r < 16; ++r) { p0[r] = 0.f; p1[r] = 0.f; }
    const LAS unsigned char* kp = Kb + hi * 1024 + r32 * 16;
    if constexpr (BS == 0) {
#pragma unroll
        for (int d0 = 0; d0 < DQK / 16; ++d0) { const bf16x8 b0 = *(const LAS bf16x8*)(kp + d0 * 2048), b1 = *(const LAS bf16x8*)(kp + d0 * 2048 + 512);
            p0 = __builtin_amdgcn_mfma_f32_32x32x16_bf16(b0, qr[d0], p0, 0, 0, 0); p1 = __builtin_amdgcn_mfma_f32_32x32x16_bf16(b1, qr[d0], p1, 0, 0, 0); }
        return; }
    constexpr int NB = DQK / 16 / (BS ? BS : 1);
    bf16x8 fa[2 * (BS ? BS : 1)], fb[2 * (BS ? BS : 1)];
#define QK_LD(f, g) do { _Pragma("unroll") for (int i_ = 0; i_ < BS; ++i_) { f[2 * i_] = *(const LAS bf16x8*)(kp + ((g) * BS + i_) * 2048); f[2 * i_ + 1] = *(const LAS bf16x8*)(kp + ((g) * BS + i_) * 2048 + 512); } } while (0)
#define QK_MM(f, g) do { _Pragma("unroll") for (int i_ = 0; i_ < BS; ++i_) { p0 = __builtin_amdgcn_mfma_f32_32x32x16_bf16(f[2 * i_], qr[(g) * BS + i_], p0, 0, 0, 0); p1 = __builtin_amdgcn_mfma_f32_32x32x16_bf16(f[2 * i_ + 1], qr[(g) * BS + i_], p1, 0, 0, 0); } } while (0)
    QK_LD(fa, 0);
#pragma unroll
    for (int g = 0; g < NB; g += 2) {
        if (g + 1 < NB) { QK_LD(fb, g + 1); __builtin_amdgcn_sched_barrier(0); }
        QK_MM(fa, g); __builtin_amdgcn_sched_barrier(0);
        if (g + 2 < NB) { QK_LD(fa, g + 2); __builtin_amdgcn_sched_barrier(0); }
        if (g + 1 < NB) { QK_MM(fb, g + 1); __builtin_amdgcn_sched_barrier(0); }
    }
#undef QK_LD
#undef QK_MM
}
template <int DV, bool BIAS, bool VDB = true>
__device__ __forceinline__ void sm_pv_tile(f32x16& p0, f32x16& p1, const LAS unsigned char* Vb, f32x16 (&o)[DV / 32], float& m, float& l, const float C,
                                           const LAS float* btab, const int bbase, LAS float* wsf, const int r32, const int hi, const int lane) {
    if (BIAS) {
#pragma unroll
        for (int r = 0; r < 16; ++r) { const int kj = crow(r, hi); p0[r] = fmaf(p0[r], C, btab[bbase - kj]); p1[r] = fmaf(p1[r], C, btab[bbase - kj - 32]); }
    }
    float pm, pq;
    pm = vmax3(p0[0], p0[1], p0[2]); pq = vmax3(p1[0], p1[1], p1[2]);
#pragma unroll
    for (int r = 3; r < 15; r += 2) { pm = vmax3(pm, p0[r], p0[r + 1]); pq = vmax3(pq, p1[r], p1[r + 1]); }
    pm = vmax3(pm, p0[15], pq); pm = fmaxf(pm, p1[15]);
    { auto rr = __builtin_amdgcn_permlane32_swap(__float_as_uint(pm), __float_as_uint(pm), false, false); pm = fmaxf(__uint_as_float(rr[0]), __uint_as_float(rr[1])); }
    if (!BIAS) pm *= C;
    if (__any(pm > m + THR)) {
        const float mn = fmaxf(m, pm), al = __builtin_amdgcn_exp2f(m - mn); m = mn; l *= al;
        if (hi == 0) wsf[r32] = al;
        asm volatile("s_waitcnt lgkmcnt(0)" ::: "memory");
#pragma unroll
        for (int r = 0; r < 16; ++r) { const float a = wsf[crow(r, hi)];
#pragma unroll
            for (int d = 0; d < DV / 32; ++d) o[d][r] *= a; }
    }
    const float nm = -m;
    { const f32x2 nm2 = (f32x2){nm, nm}, C2 = (f32x2){C, C}; f32x2 sa = (f32x2){0.f, 0.f}, sb = (f32x2){0.f, 0.f};
#pragma unroll
      for (int i = 0; i < 8; ++i) { f32x2 a = (f32x2){p0[2 * i], p0[2 * i + 1]}, b = (f32x2){p1[2 * i], p1[2 * i + 1]};
          if (BIAS) { a = a + nm2; b = b + nm2; } else { a = a * C2 + nm2; b = b * C2 + nm2; }
          a.x = __builtin_amdgcn_exp2f(a.x); a.y = __builtin_amdgcn_exp2f(a.y); b.x = __builtin_amdgcn_exp2f(b.x); b.y = __builtin_amdgcn_exp2f(b.y);
          p0[2 * i] = a.x; p0[2 * i + 1] = a.y; p1[2 * i] = b.x; p1[2 * i + 1] = b.y; sa += a; sb += b; }
      sa += sb; l += sa.x + sa.y; }
#define PV_PK(ks_) ({ u32x4 w_; if ((ks_) < 2) { const int b_ = 8 * (ks_); w_.x = cvtpk(p0[b_], p0[b_ + 1]); w_.y = cvtpk(p0[b_ + 2], p0[b_ + 3]); w_.z = cvtpk(p0[b_ + 4], p0[b_ + 5]); w_.w = cvtpk(p0[b_ + 6], p0[b_ + 7]); } \
        else { const int b_ = 8 * ((ks_) - 2); w_.x = cvtpk(p1[b_], p1[b_ + 1]); w_.y = cvtpk(p1[b_ + 2], p1[b_ + 3]); w_.z = cvtpk(p1[b_ + 4], p1[b_ + 5]); w_.w = cvtpk(p1[b_ + 6], p1[b_ + 7]); } __builtin_bit_cast(bf16x8, w_); })
    bf16x8 pa[4];
    if constexpr (VDB) {
#pragma unroll
        for (int ks = 0; ks < 4; ++ks) pa[ks] = PV_PK(ks); }
    const LAS unsigned char* vp = Vb + ((lane >> 4) & 1) * 32 + (lane & 3) * 8 + (4 * hi + ((lane & 15) >> 2)) * 64;
    bf16x8 va[4], vb[4];
#define PV_LD(f, d0_) do { _Pragma("unroll") for (int ks_ = 0; ks_ < 4; ++ks_) { const s16x4 lo_ = vtr(vp + ((d0_) * 4 + ks_) * 1024), hh_ = vtr(vp + ((d0_) * 4 + ks_) * 1024 + 512); \
        f[ks_] = (bf16x8){lo_[0], lo_[1], lo_[2], lo_[3], hh_[0], hh_[1], hh_[2], hh_[3]}; } } while (0)
#define PV_MM(f, d0_) do { _Pragma("unroll") for (int ks_ = 0; ks_ < 4; ++ks_) o[d0_] = __builtin_amdgcn_mfma_f32_32x32x16_bf16(pa[ks_], f[ks_], o[d0_], 0, 0, 0); } while (0)
    if constexpr (!VDB) {
#pragma unroll
        for (int ks = 0; ks < 4; ++ks) { const bf16x8 pk_ = PV_PK(ks);
#pragma unroll
            for (int d0 = 0; d0 < DV / 32; ++d0) { const s16x4 lo_ = vtr(vp + (d0 * 4 + ks) * 1024), hh_ = vtr(vp + (d0 * 4 + ks) * 1024 + 512);
                o[d0] = __builtin_amdgcn_mfma_f32_32x32x16_bf16(pk_, (bf16x8){lo_[0], lo_[1], lo_[2], lo_[3], hh_[0], hh_[1], hh_[2], hh_[3]}, o[d0], 0, 0, 0); } }
    } else {
    PV_LD(va, 0);
#pragma unroll
    for (int d0 = 0; d0 < DV / 32; d0 += 2) {
        PV_LD(vb, d0 + 1); __builtin_amdgcn_sched_barrier(0); PV_MM(va, d0); __builtin_amdgcn_sched_barrier(0);
        if (d0 + 2 < DV / 32) { PV_LD(va, d0 + 2); __builtin_amdgcn_sched_barrier(0); }
        PV_MM(vb, d0 + 1); __builtin_amdgcn_sched_barrier(0);
    }
    }
#undef PV_LD
#undef PV_MM
#undef PV_PK
}

template <int DQK, int DV, int NHU, bool BIAS, bool PIPE, int ORD>
__device__ __forceinline__ void attn_unit(LAS unsigned char* lds, const unsigned ldsb, const int tid, const int lane, const int wid, const bf16_t* Q, const int ldq, const bf16_t* K, const int ldk, const bf16_t* V, const int ldv, const int vhs,
                                          bf16_t* O, const int ldo, const float* bias, const float C, const int b, const int head0, const int cbase, const unsigned klane, const unsigned vlane, const int probe = 0, const bool fill_bias = true) {
    constexpr int KBLK = DQK / 8, VBLK = DV / 8, KSZ = NHU * KBLK * 1024, VSZ = NHU * VBLK * 1024, SLOT = KSZ + VSZ, CPU_ = 4 / NHU, DPW = NHU * (KBLK + VBLK) / 8;
    const int r32 = lane & 31, hi = lane >> 5;
    const int hh = NHU == 2 ? (wid >> 2) : 0, cj = NHU == 2 ? ((wid >> 1) & 1) : (wid >> 1), half = wid & 1;
    LAS float* wsf = (LAS float*)(lds + 3 * SLOT) + wid * 64;
    LAS float* btab = (LAS float*)(lds + 3 * SLOT + 2048);
    const int cq = cbase + cj, kc_hi = cbase + CPU_ - 1;
    const int kc_lo = BIAS ? (cbase - 8 > 0 ? cbase - 8 : 0) : 0, w_lo = BIAS ? (cq - 8 > 0 ? cq - 8 : 0) : 0;
    const size_t qrow0 = (size_t)b * SEQ + (size_t)cq * 64 + half * 32;
    bf16x8 qr[DQK / 16];
    { const bf16_t* qp = Q + (qrow0 + r32) * ldq + (head0 + hh) * DQK + hi * 8;
#pragma unroll
      for (int d0 = 0; d0 < DQK / 16; ++d0) qr[d0] = *(const bf16x8*)(qp + d0 * 16);
#pragma unroll
      for (int d0 = 0; d0 < DQK / 16; ++d0) asm volatile("s_waitcnt vmcnt(0)" : "+v"(qr[d0])); }
    if (BIAS && fill_bias) for (int idx = tid; idx < NHU * 640; idx += 512) { const int h2 = idx / 640, i = idx % 640; btab[idx] = bias[(head0 + h2) * NREL + (i < NREL - 1 ? i : NREL - 1)] * 1.4426950408889634f; }
    f32x16 o[DV / 32];
#pragma unroll
    for (int d = 0; d < DV / 32; ++d)
#pragma unroll
        for (int r = 0; r < 16; ++r) o[d][r] = 0.f;
    float m = -1.0e30f, l = 0.f;
#define ATT_DMA(kc_, slot_) do { const int so_ = (slot_) * SLOT; \
    _Pragma("unroll") for (int j_ = 0; j_ < NHU * KBLK / 8; ++j_) { const int id_ = wid + 8 * j_, hd_ = id_ / KBLK, bi_ = id_ % KBLK; \
        glds16_s(klane, (const char*)(K + ((size_t)((b * ldk + head0 + hd_) * NCHK + (kc_)) * KBLK + bi_) * 512), ldsb + (unsigned)(so_ + id_ * 1024)); } \
    _Pragma("unroll") for (int j_ = 0; j_ < NHU * VBLK / 8; ++j_) { const int id_ = wid + 8 * j_, hd_ = id_ / VBLK, vb_ = id_ % VBLK; \
        glds16_s(vlane, (const char*)(V + ((size_t)((b * ldk + head0 + hd_) * NCHK + (kc_)) * VBLK + vb_) * 512), ldsb + (unsigned)(so_ + KSZ + id_ * 1024)); } } while (0)
    constexpr int QBS = DQK > 64 ? 2 : 4;
    if constexpr (!PIPE) {
    f32x16 p0, p1;
#pragma unroll
    for (int r = 0; r < 16; ++r) { p0[r] = 0.f; p1[r] = 0.f; }
    int s_cur = 0, s_nn = 2;
    if (probe != 2) { ATT_DMA(kc_lo, 0); if (kc_lo + 1 <= kc_hi) ATT_DMA(kc_lo + 1, 1); }
    for (int kc = kc_lo; kc <= kc_hi; ++kc) {
        if (kc + 1 <= kc_hi) asm volatile("s_waitcnt vmcnt(%0) lgkmcnt(0)\n\ts_barrier" :: "n"(DPW) : "memory");
        else                 asm volatile("s_waitcnt vmcnt(0) lgkmcnt(0)\n\ts_barrier" ::: "memory");
        if (kc + 2 <= kc_hi && probe != 2) ATT_DMA(kc + 2, s_nn);
        if (kc >= w_lo && kc <= cq && probe != 1) {
            const LAS unsigned char* Kb = lds + s_cur * SLOT + hh * KBLK * 1024; const LAS unsigned char* Vb = lds + s_cur * SLOT + KSZ + hh * VBLK * 1024;
            if (probe == 5 || probe == 6) {
                if (probe == 5) {
#pragma unroll
                    for (int d0 = 0; d0 < DQK / 16; ++d0) { p0 = __builtin_amdgcn_mfma_f32_32x32x16_bf16(qr[d0], qr[d0], p0, 0, 0, 0); p1 = __builtin_amdgcn_mfma_f32_32x32x16_bf16(qr[d0], qr[d0], p1, 0, 0, 0); } }
                else { const LAS unsigned char* kp = Kb + hi * 1024 + r32 * 16; bf16x8 acc_ = qr[0];
#pragma unroll
                    for (int d0 = 0; d0 < DQK / 16; ++d0) { const bf16x8 b0 = *(const LAS bf16x8*)(kp + d0 * 2048), b1 = *(const LAS bf16x8*)(kp + d0 * 2048 + 512); acc_ ^= b0 ^ b1; }
                    asm volatile("" :: "v"(acc_)); }
            }
            else if (probe != 4) { qk_tile<DQK, QBS>(Kb, qr, p0, p1, r32, hi); __builtin_amdgcn_sched_barrier(0); }
            if (probe == 5 || probe == 6) { asm volatile("" : "+v"(p0), "+v"(p1)); }
            else if (probe != 3) sm_pv_tile<DV, BIAS>(p0, p1, Vb, o, m, l, C, btab + hh * 640, (cq - kc) * 64 + half * 32 + r32 + 63, wsf, r32, hi, lane);
            else { asm volatile("" : "+v"(p0), "+v"(p1)); }
        }
        s_cur = s_cur == 2 ? 0 : s_cur + 1; s_nn = s_nn == 2 ? 0 : s_nn + 1;
    }
    } else {
    f32x16 pA0, pA1, pB0, pB1;
#pragma unroll
    for (int r = 0; r < 16; ++r) { pA0[r] = 0.f; pA1[r] = 0.f; pB0[r] = 0.f; pB1[r] = 0.f; }
    int s_cur = 0, s_n1 = 1, s_nn = 2;
#define ATT_ADV() do { const int t_ = s_cur; s_cur = s_n1; s_n1 = s_nn; s_nn = t_; } while (0)
#define ATT_SYNC(kc_) do { asm volatile("s_waitcnt vmcnt(0) lgkmcnt(0)\n\ts_barrier" ::: "memory");     \
        if ((kc_) + 2 <= kc_hi) ATT_DMA((kc_) + 2, s_nn); } while (0)
#define ATT_A(N0, N1) qk_tile<DQK, QBS>(lds + s_n1 * SLOT + hh * KBLK * 1024, qr, N0, N1, r32, hi)
#define ATT_B(C0, C1, kc_) sm_pv_tile<DV, BIAS, (DQK <= 64)>(C0, C1, lds + s_cur * SLOT + KSZ + hh * VBLK * 1024, o, m, l, C, btab + hh * 640, (cq - (kc_)) * 64 + half * 32 + r32 + 63, wsf, r32, hi, lane)
#define ATT_AB(N0, N1, C0, C1, kc_) do { if (ORD == 0) { ATT_A(N0, N1); __builtin_amdgcn_sched_barrier(0); ATT_B(C0, C1, kc_); } else { ATT_B(C0, C1, kc_); __builtin_amdgcn_sched_barrier(0); ATT_A(N0, N1); } } while (0)
    ATT_DMA(kc_lo, 0); if (kc_lo + 1 <= kc_hi) ATT_DMA(kc_lo + 1, 1);
    if (kc_lo + 1 <= kc_hi) asm volatile("s_waitcnt vmcnt(%0) lgkmcnt(0)\n\ts_barrier" :: "n"(DPW) : "memory"); else asm volatile("s_waitcnt vmcnt(0) lgkmcnt(0)\n\ts_barrier" ::: "memory");
    int kc = kc_lo;
    if (w_lo == kc_lo) { qk_tile<DQK, QBS>(lds + hh * KBLK * 1024, qr, pA0, pA1, r32, hi); }
    else { for (; kc < w_lo - 1; ++kc) { ATT_SYNC(kc); ATT_ADV(); } ATT_SYNC(kc); ATT_A(pA0, pA1); ATT_ADV(); ++kc; }
    int n = cq - w_lo;
    if (n & 1) { ATT_SYNC(kc); ATT_AB(pB0, pB1, pA0, pA1, kc); ATT_ADV(); ++kc; --n; pA0 = pB0; pA1 = pB1; }
    for (; n > 0; n -= 2) {
        ATT_SYNC(kc); ATT_AB(pB0, pB1, pA0, pA1, kc); ATT_ADV(); ++kc;
        ATT_SYNC(kc); ATT_AB(pA0, pA1, pB0, pB1, kc); ATT_ADV(); ++kc; }
    ATT_SYNC(kc); ATT_B(pA0, pA1, kc); ATT_ADV(); ++kc;
    for (; kc <= kc_hi; ++kc) { ATT_SYNC(kc); ATT_ADV(); }
#undef ATT_ADV
#undef ATT_SYNC
#undef ATT_A
#undef ATT_B
#undef ATT_AB
    }
#undef ATT_DMA
    { auto rr = __builtin_amdgcn_permlane32_swap(__float_as_uint(l), __float_as_uint(l), false, false); l = __uint_as_float(rr[0]) + __uint_as_float(rr[1]); }
    if (hi == 0) wsf[32 + r32] = 1.0f / l;
    asm volatile("s_waitcnt lgkmcnt(0)" ::: "memory");
    int r32s = r32, his = hi; asm volatile("" : "+v"(r32s), "+v"(his));
    bf16_t* op = O + qrow0 * ldo + (head0 + hh) * DV + r32s;
    if (probe == 0) {
    if (vhs) {
    unsigned char* op8 = (unsigned char*)O + qrow0 * ldo + (head0 + hh) * DV + r32s;
#pragma unroll
    for (int r = 0; r < 16; ++r) { const int q = crow(r, his); const float rl = wsf[32 + q] * 16.0f;
#pragma unroll
        for (int d0 = 0; d0 < DV / 32; ++d0) { const float v_ = __builtin_amdgcn_fmed3f(o[d0][r] * rl, -448.0f, 448.0f); op8[(size_t)q * ldo + d0 * 32] = (unsigned char)(__builtin_amdgcn_cvt_pk_fp8_f32(v_, v_, 0u, false) & 0xffu); } }
    } else {
#pragma unroll
    for (int r = 0; r < 16; ++r) { const int q = crow(r, his); const float rl = wsf[32 + q];
#pragma unroll
        for (int d0 = 0; d0 < DV / 32; ++d0) op[(size_t)q * ldo + d0 * 32] = (bf16_t)f2bf(o[d0][r] * rl); } } }
}
template <int DQK, int DV, int NHU, bool BIAS, bool PIPE>
__device__ __forceinline__ void attn_mfma(const Frame& F, const bf16_t* Q, int ldq, const bf16_t* K, int ldk, const bf16_t* V, int ldv, int vhs, bf16_t* O, int ldo, int nheads, const float* bias, const float C, const int probe = 0) {
    constexpr int CPU_ = 4 / NHU;
    const int lane = F.lane, wid = F.wave;
    LAS unsigned char* lds = F.lds;
    const unsigned ldsb = (unsigned)__builtin_amdgcn_readfirstlane((int)(unsigned)(uintptr_t)lds);
    const int nunits = NBATCH * (nheads / NHU) * (NCHK / CPU_);
    const unsigned klane = (unsigned)lane * 16u, vlane = klane;
    int prev_h0 = -1;
    for (int L = F.vcu; L < nunits; L += F.G) {
        int b, head0, cbase;
        if (NHU == 1) { const int vv = L & 255, ii = L >> 8, c8 = vv & 7, grp = vv >> 3;
            const int bh = grp * 4 + ii, qb = (ii & 1) ? 7 - c8 : c8;
            b = bh / nheads; head0 = bh % nheads; cbase = qb * 4; }
        else { const int vv = L & 255, bhp = vv >> 1, g = 2 * (L >> 8) + (vv & 1); b = bhp >> 3; head0 = (bhp & 7) * 2; cbase = g * 2; }
        asm volatile("s_waitcnt lgkmcnt(0)\n\ts_barrier" ::: "memory");
        if constexpr (PIPE) { if (wid < 4) attn_unit<DQK, DV, NHU, BIAS, true, 0>(lds, ldsb, F.tid, lane, wid, Q, ldq, K, ldk, V, ldv, vhs, O, ldo, bias, C, b, head0, cbase, klane, vlane, probe, head0 != prev_h0);
                              else         attn_unit<DQK, DV, NHU, BIAS, true, 1>(lds, ldsb, F.tid, lane, wid, Q, ldq, K, ldk, V, ldv, vhs, O, ldo, bias, C, b, head0, cbase, klane, vlane, probe, head0 != prev_h0); }
        else attn_unit<DQK, DV, NHU, BIAS, false, 0>(lds, ldsb, F.tid, lane, wid, Q, ldq, K, ldk, V, ldv, vhs, O, ldo, bias, C, b, head0, cbase, klane, vlane, probe, head0 != prev_h0);
        prev_h0 = head0;
    }
    asm volatile("s_waitcnt vmcnt(0) lgkmcnt(0)\n\ts_barrier" ::: "memory");
}
}

struct Args { const void* in[50]; float* out; unsigned char* ws; int ph_lo, ph_hi; };
#define NAIVE(g) (((NAIVE_MASK) >> (g)) & 1)
constexpr int N_PHASES = 2 * (13 + NAIVE(5)) + 1;

__global__ void __launch_bounds__(512, 2) fwd(Args args) {
    extern __shared__ __attribute__((aligned(16))) unsigned char lds_raw[];
    Frame F;
    F.lds = (LAS unsigned char*)lds_raw;
    F.tid = threadIdx.x; F.lane = F.tid & 63; F.wave = __builtin_amdgcn_readfirstlane(F.tid >> 6);
    F.G = gridDim.x; { const int bx = blockIdx.x; F.vcu = (F.G % 8 == 0) ? (bx % 8) * (F.G / 8) + bx / 8 : bx; }
    F.gw = F.vcu * 8 + F.wave; F.NGW = F.G * 8;
    volatile LAS unsigned* MISC = (volatile LAS unsigned*)(F.lds + MISC_OFF);
    gu32* ctl = (gu32*)(args.ws + WS_CTL);
    for (int u = F.tid; u < (LDS_BYTES - LDSCTL_OFF) / 4; u += 512) ((LAS unsigned*)(F.lds + LDSCTL_OFF))[u] = 0u;
    __syncthreads();
    XcdBarrier bar; bar.bar = (unsigned*)(ctl + CW_BAR); bar.x = 0; bar.st = nullptr;
    if (!MK_PER_PHASE) bar = xcd_barrier_post((unsigned*)(ctl + CW_BAR), MISC + 8);
    const int lo = args.ph_lo, hi = args.ph_hi;
    int ph = 0;
#ifndef PH_MASK
#define PH_MASK 0xFFFFFFFFu
#endif
#ifndef DUP_MASK
#define DUP_MASK 0u
#endif
#ifndef EPI_PROBE
#define EPI_PROBE 0
#endif
#ifndef E0_PROBE
#define E0_PROBE 0
#endif
#ifndef BAR_PROBE
#define BAR_PROBE 0
#endif
#ifndef ATT_PROBE
#define ATT_PROBE 0
#endif
#define PHASE_BEGIN(k) if (ph >= lo && ph < hi) { if ((PH_MASK >> (k)) & 1u) for (int rep_ = 0; rep_ < 1 + (int)((DUP_MASK >> (k)) & 1u); ++rep_) { asm volatile("; PHASE_MARK %0" :: "n"(k)); { unsigned z_ = 0u; asm volatile("" : "+v"(z_)); F.lane = (int)__builtin_amdgcn_mbcnt_hi(~0u, __builtin_amdgcn_mbcnt_lo(~0u, z_)); } F.tid = F.wave * 64 + F.lane; asm volatile("" : "+s"(F.wave), "+s"(F.vcu), "+s"(F.gw));
#define PHASE_END   } if (!MK_PER_PHASE && ph + 1 < hi) { unsigned z_ = 0u; asm volatile("" : "+v"(z_)); xcd_barrier(bar, (int)(F.wave * 64 + __builtin_amdgcn_mbcnt_hi(~0u, __builtin_amdgcn_mbcnt_lo(~0u, z_)))); if (BAR_PROBE) xcd_barrier(bar, (int)(F.wave * 64 + __builtin_amdgcn_mbcnt_hi(~0u, __builtin_amdgcn_mbcnt_lo(~0u, z_)))); } } ++ph;

#define XB2 ((bf16_t*)args.out)
#define H8B ((unsigned char*)args.out + (size_t)64 * MiB)
#define H ((bf16_t*)(args.ws + WS_H))
#define W (args.ws + WS_W)
#define BIG (args.ws + WS_BIG)
#define route_e ((int*)(args.ws + WS_ROUTE_E))
#define route_p ((int*)(args.ws + WS_ROUTE_P))
#define route_w ((float*)(args.ws + WS_ROUTE_W))
#define perm_g ((int*)(args.ws + WS_PERM))
#define Ybuf ((bf16_t*)(BIG + B_Y))
#define positions ((const int*)args.in[1])

#pragma unroll 1
    for (int lp = 0; lp < 2; ++lp) {
#define FFN8 (((FFN8_MASK) >> lp) & 1)
#define QKV8 (((QKV8_MASK) >> lp) & 1)
#define AO8 (((AO8_MASK) >> lp) & 1)
#define IN8 (((IN8_MASK) >> lp) & 1)
#define MLAUP8 (((MLAUP8_MASK) >> lp) & 1)
#define BO8 (((BO8_MASK) >> lp) & 1)
#define EIN(k) ((const float*)args.in[2 + lp * 24 + (k)])
#define OIN(k) ((const float*)args.in[15 + lp * 24 + (k)])
#define e_attn_norm EIN(0)
#define e_w_in EIN(1)
#define e_qa EIN(2)
#define e_kva EIN(3)
#define e_w_uq EIN(4)
#define e_w_ukv EIN(5)
#define e_qn EIN(6)
#define e_kn EIN(7)
#define e_w_o EIN(8)
#define e_ffn_norm EIN(9)
#define e_wg EIN(10)
#define e_wu EIN(11)
#define e_wd EIN(12)
#define o_attn_norm OIN(0)
#define o_w_qkv OIN(1)
#define o_qn OIN(2)
#define o_kn OIN(3)
#define o_bias OIN(4)
#define o_w_o OIN(5)
#define o_ffn_norm OIN(6)
#define o_router OIN(7)
#define o_wg OIN(8)
#define o_wu OIN(9)
#define o_wd OIN(10)
#define cnt_prev (ctl + CW_CNT + (lp ? (lp - 1) : 0) * 512)
#define cnt_cur (ctl + CW_CNT + lp * 512)
#define A1 ((bf16_t*)(BIG + B_A1))
#define VM ((bf16_t*)(BIG + B_VM))
#define QN ((bf16_t*)(BIG + B_QN))
#define KN ((bf16_t*)(BIG + B_KN))
#define OM ((bf16_t*)(BIG + B_OM))
#define ACT ((bf16_t*)(BIG + B_ACT))
#define CQ ((bf16_t*)(BIG + B_CQ))
#define CK ((bf16_t*)(BIG + B_CK))
#define CV ((bf16_t*)(BIG + B_CV))
#define CO ((bf16_t*)(BIG + B_CO))
        PHASE_BEGIN(0)
          for (int r2_ = 0; r2_ < ((E0_PROBE && lp == 0) ? 2 : 1); ++r2_) {
            { EvenConv ec{e_w_in, e_w_uq, e_qa, e_w_ukv, e_kva, e_w_o, e_wg, e_wu, e_ffn_norm, e_wd, (unsigned char*)W, MLAUP8, AO8, FFN8, IN8, e_attn_norm}; conv_even(F, ec); }
            MoeCombine mc; mc.re = route_e; mc.rp = route_p; mc.rw = route_w; mc.Y = Ybuf;
            static_assert((IN8_MASK) == 0, "the input projection reads the raw bf16 residual rows (rstd in its epilogue, gain folded into w_in)");
            if (lp == 0) { res_rows<false, false, true, false, false>(F, args.in[0], XB2, nullptr, nullptr, nullptr, mc, false, (float*)(args.ws + WS_SSX)); }
            else { mc.mi.load(cnt_prev); res_rows<true, true, true, false, false>(F, H, XB2, nullptr, nullptr, nullptr, mc, false, (float*)(args.ws + WS_SSX)); }
          }
        PHASE_END
        PHASE_BEGIN(1)
            if (NAIVE(0)) { naive_gemm<false>(F, T_ / 64, AIN, DM, H, DM, [](int r) { return r; }, [&](int, const float*& b1, const float*& b2) { b1 = e_w_in; b2 = e_w_in; }, AIN,
                              [&](int r, int c, float v, float) { A1[(size_t)r * AINP + c] = (bf16_t)f2bf(v); }); }
            else { pg8::Gemm g{(const char*)XB2, (const char*)(W + WE_IN), DM, DM, DM, 2, 0u, 0u}; pg8::DenseOrder S; S.init(T_ / 256, AINP / 256, F.G, (int)blockIdx.x);
                static_assert((MLAUP8_MASK) == 0, "the fp8 input projection below stores bf16 latents");
                pg8::EpiA1<false> E{A1, AINP, (float*)(args.ws + WS_SSQ), (const float*)(args.ws + WS_SSX), (LAS float*)(F.lds + LDSCTL_OFF + 8192)};
                if (((IN8_MASK) != 0) && IN8) { g.A = (const char*)H8B; g.es = 1; E.iscale = 1.0f / 4096.0f; pg8::gemm_phase<pg8::EpiA1<false>, pg8::DenseOrder, false, true>(F.lds, F.wave, g, S, E); }
                else if ((IN8_MASK) != 3) pg8::gemm_phase<pg8::EpiA1<false>, pg8::DenseOrder, false>(F.lds, F.wave, g, S, E); }
        PHASE_END
        PHASE_BEGIN(3)
            { { LAS float* GL = (LAS float*)(F.lds + LDSCTL_OFF + 5120); if (F.tid < QKD) { GL[F.tid] = e_qn[F.tid]; GL[192 + F.tid] = e_kn[F.tid]; } __syncthreads(); }
              pg8::Gemm g{(const char*)A1, (const char*)(W + WE_QKVF), 256, AINP, 256, 2, 0u, 0u}; pg8::MlaOrder S; S.d.init(T_ / 256, 20, F.G, (int)blockIdx.x);
              pg8::EpiMlaQKV E{(LAS float*)(F.lds + LDSCTL_OFF + 1024), QN, (size_t)(B_KN - B_QN) / 2, VM, (const float*)(args.ws + WS_SSQ), e_qn, e_kn, positions, (LAS float*)(F.lds + LDSCTL_OFF + 8192)};
              if (((MLAUP8_MASK) != 0) && MLAUP8) { g.es = 1; E.iscale = 1.0f / 4096.0f; pg8::gemm_phase<pg8::EpiMlaQKV, pg8::MlaOrder, false, true>(F.lds, F.wave, g, S, E); }
              else if ((MLAUP8_MASK) != 3) { E.nostore = rep_ && EPI_PROBE == 2; pg8::gemm_phase<pg8::EpiMlaQKV, pg8::MlaOrder, false>(F.lds, F.wave, g, S, E); } }
        PHASE_END
        PHASE_BEGIN(5)
#if NAIVE_ATTN & 1
            attn_naive<QKD, VD, false>(F, QN, 1536, KN, 1536, VM, DM, OM, DM, MLA_H, nullptr, 0.07216878364870322f);
#else
            att::attn_mfma<QKD, VD, 1, false, MLA_PIPE>(F, QN, 1536, KN, MLA_H, VM, 0, AO8, OM, DM, MLA_H, nullptr, 0.07216878364870322f * 1.4426950408889634f, rep_ ? ATT_PROBE : 0);
#endif
        PHASE_END
        PHASE_BEGIN(6)
            if (NAIVE(2)) { naive_gemm<false>(F, T_ / 64, DM, DM, OM, DM, [](int r) { return r; }, [&](int, const float*& b1, const float*& b2) { b1 = e_w_o; b2 = e_w_o; }, DM,
                              [&](int r, int c, float v, float) { H[(size_t)r * DM + c] = (bf16_t)f2bf(bf2f(H[(size_t)r * DM + c]) + v); }); }
            else { pg8::Gemm g{(const char*)OM, (const char*)(W + WE_O), DM, DM, DM, 2, 0u, 0u}; pg8::DenseOrder S; S.init(T_ / 256, DM / 256, F.G, (int)blockIdx.x);
                const bf16_t* xin_ = rep_ ? H : XB2; const float sc_ = rep_ ? 0.0f : 1.0f; float* ssx_ = (float*)(args.ws + WS_SSX); LAS float* P_ = (LAS float*)(F.lds + LDSCTL_OFF + 8192);
                if (HAS_G3(1, 1) && AO8 && FFN8) { g.es = 1; pg8::EpiResid16<true, true> E{xin_, H, ssx_, P_, sc_ / 4096.0f, H8B}; pg8::gemm_phase<pg8::EpiResid16<true, true>, pg8::DenseOrder, false, true>(F.lds, F.wave, g, S, E); }
                else if (HAS_G3(1, 0) && AO8) { g.es = 1; pg8::EpiResid16<true> E{xin_, H, ssx_, P_, sc_ / 4096.0f}; pg8::gemm_phase<pg8::EpiResid16<true>, pg8::DenseOrder, false, true>(F.lds, F.wave, g, S, E); }
                else if (HAS_G3(0, 1) && FFN8) { pg8::EpiResid16<true, true> E{xin_, H, ssx_, P_, sc_, H8B}; pg8::gemm_phase<pg8::EpiResid16<true, true>, pg8::DenseOrder, false>(F.lds, F.wave, g, S, E); }
                else if (HAS_G3(0, 0)) { pg8::EpiResid16<true> E{xin_, H, ssx_, P_, sc_}; pg8::gemm_phase<pg8::EpiResid16<true>, pg8::DenseOrder, false>(F.lds, F.wave, g, S, E); } }
        PHASE_END
        PHASE_BEGIN(8)
            if (NAIVE(3)) { naive_gemm<true>(F, T_ / 64, FF, DM, H, DM, [](int r) { return r; }, [&](int, const float*& b1, const float*& b2) { b1 = e_wg; b2 = e_wu; }, FF,
                              [&](int r, int c, float v, float v2) { ACT[(size_t)r * FF + c] = (bf16_t)f2bf(silu_f(v) * v2); }); }
            else { pg8::Gemm g{(const char*)H, (const char*)(W + WE_GU), DM, DM, DM, 2, 0u, 0u}; pg8::DenseOrder S; S.init(T_ / 256, 2 * FF / 256, F.G, (int)blockIdx.x); g.probe = rep_ ? KL_PROBE : 0;
                if (FFN8) { g.A = (const char*)H8B; g.es = 1;
                    pg8::EpiSwiglu8R E{(unsigned char*)ACT, FF, 1.0f / 2048.0f, 4.0f, (const float*)(args.ws + WS_SSX), (LAS float*)(F.lds + LDSCTL_OFF + 8192)}; pg8::gemm_phase<pg8::EpiSwiglu8R, pg8::DenseOrder, false, true>(F.lds, F.wave, g, S, E); }
                else { pg8::EpiSwiglu E{ACT, FF, (const float*)(args.ws + WS_SSX), rep_ && EPI_PROBE, (LAS float*)(F.lds + LDSCTL_OFF + 8192)}; pg8::gemm_phase<pg8::EpiSwiglu, pg8::DenseOrder, false>(F.lds, F.wave, g, S, E); } }
        PHASE_END
        PHASE_BEGIN(9)
            if (NAIVE(4)) { naive_gemm<false>(F, T_ / 64, DM, FF, ACT, FF, [](int r) { return r; }, [&](int, const float*& b1, const float*& b2) { b1 = e_wd; b2 = e_wd; }, DM,
                              [&](int r, int c, float v, float) { H[(size_t)r * DM + c] = (bf16_t)f2bf(bf2f(H[(size_t)r * DM + c]) + v); }); }
            else { pg8::Gemm g{(const char*)ACT, (const char*)(W + WE_D), FF, FF, FF, 2, 0u, 0u}; pg8::DenseOrder S; S.init(T_ / 256, DM / 256, F.G, (int)blockIdx.x);
                const float sc_ = rep_ ? 0.0f : 1.0f; float* ssx_ = (float*)(args.ws + WS_SSX); LAS float* P_ = (LAS float*)(F.lds + LDSCTL_OFF + 8192);
                if (HAS_G5(1, 1) && FFN8 && QKV8) { g.es = 1; pg8::EpiResid16<true, true> E{H, H, ssx_, P_, sc_ / 1024.0f, H8B}; pg8::gemm_phase<pg8::EpiResid16<true, true>, pg8::DenseOrder, false, true>(F.lds, F.wave, g, S, E); }
                else if (HAS_G5(1, 0) && FFN8) { g.es = 1; pg8::EpiResid16<true> E{H, H, ssx_, P_, sc_ / 1024.0f}; pg8::gemm_phase<pg8::EpiResid16<true>, pg8::DenseOrder, false, true>(F.lds, F.wave, g, S, E); }
                else if (HAS_G5(0, 1) && QKV8) { pg8::EpiResid16<true, true> E{H, H, ssx_, P_, sc_, H8B}; pg8::gemm_phase<pg8::EpiResid16<true, true>, pg8::DenseOrder, false>(F.lds, F.wave, g, S, E); }
                else if (HAS_G5(0, 0)) { pg8::EpiResid16<true> E{H, H, ssx_, P_, sc_}; pg8::gemm_phase<pg8::EpiResid16<true>, pg8::DenseOrder, false>(F.lds, F.wave, g, S, E); } }
            if (rep_ == 0) {
            if (QKV8) conv_matrix<true>(F, MapQkvCA{o_w_qkv}, DM, DM, 3 * DM, (unsigned char*)(W + WO_QKV), o_attn_norm, 256.0f);
            else conv_matrix(F, MapQkvCA{o_w_qkv}, DM, DM, 3 * DM, (bf16_t*)(W + WO_QKV), o_attn_norm);
            if (BO8) conv_matrix<true>(F, MapPlain{o_w_o, DM}, DM, DM, DM, (unsigned char*)(W + WO_O), nullptr, 256.0f);
            else conv_matrix(F, MapPlain{o_w_o, DM}, DM, DM, DM, (bf16_t*)(W + WO_O));
#pragma unroll 1
            for (int e = 0; e < NE; ++e) {
#if MOE_FP8
                conv_matrix<true>(F, MapGateUp{o_wg + (size_t)e * DM * EFF, o_wu + (size_t)e * DM * EFF, EFF}, DM, DM, 2 * EFF, (unsigned char*)(W + WO_GU) + (size_t)e * 2 * EFF * DM, nullptr, 256.0f);
                conv_matrix<true>(F, MapPlain{o_wd + (size_t)e * EFF * DM, DM}, EFF, EFF, DM, (unsigned char*)(W + WO_D) + (size_t)e * DM * EFF, nullptr, 256.0f);
#else
                conv_matrix(F, MapGateUp{o_wg + (size_t)e * DM * EFF, o_wu + (size_t)e * DM * EFF, EFF}, DM, DM, 2 * EFF, (bf16_t*)(W + WO_GU) + (size_t)e * 2 * EFF * DM);
                conv_matrix(F, MapPlain{o_wd + (size_t)e * EFF * DM, DM}, EFF, EFF, DM, (bf16_t*)(W + WO_D) + (size_t)e * DM * EFF);
#endif
            }
            }
        PHASE_END

        PHASE_BEGIN(11)
            if (NAIVE(5)) {
                naive_gemm<false>(F, T_ / 64, 3 * DM, DM, H, DM, [](int r) { return r; }, [&](int, const float*& b1, const float*& b2) { b1 = o_w_qkv; b2 = o_w_qkv; }, 3 * DM,
                                  [&](int r, int c, float v, float) { bf16_t* dst = c < DM ? CQ : (c < 2 * DM ? CK : CV); dst[(size_t)r * DM + (c & (DM - 1))] = (bf16_t)f2bf(v); });
                __syncthreads(); VM_WAIT();
            } else { { LAS float* GL = (LAS float*)(F.lds + LDSCTL_OFF + 5120); if (F.tid < CA_D) { GL[F.tid] = o_qn[F.tid]; GL[192 + F.tid] = o_kn[F.tid]; } __syncthreads(); }
                pg8::Gemm g{(const char*)H, (const char*)(W + WO_QKV), DM, DM, DM, 2, 0u, 0u}; pg8::DenseOrder S; S.init(T_ / 256, 3 * DM / 256, F.G, (int)blockIdx.x);
                pg8::EpiQkvNorm E{(LAS float*)(F.lds + LDSCTL_OFF + 8192), (LAS float*)(F.lds + LDSCTL_OFF + 5120), CQ, (size_t)(B_CK - B_CQ) / 2, o_qn, o_kn, (const float*)(args.ws + WS_SSX)};
                if (QKV8) { g.A = (const char*)H8B; g.es = 1; E.iscale = 1.0f / 2048.0f; pg8::gemm_phase<pg8::EpiQkvNorm, pg8::DenseOrder, false, true>(F.lds, F.wave, g, S, E); }
                else pg8::gemm_phase<pg8::EpiQkvNorm, pg8::DenseOrder, false>(F.lds, F.wave, g, S, E); }
        PHASE_END
#if NAIVE(5)
        PHASE_BEGIN(12)
            ca_head_norm(F, CQ, o_qn); ca_head_norm(F, CK, o_kn);
        PHASE_END
#endif
        PHASE_BEGIN(13)
#if NAIVE_ATTN & 2
            attn_naive<CA_D, CA_D, true>(F, CQ, DM, CK, DM, CV, DM, CO, DM, CA_H, o_bias, 0.125f);
#else
            att::attn_mfma<CA_D, CA_D, 2, true, BAND_PIPE>(F, CQ, DM, CK, CA_H, CV, 0, BO8, CO, DM, CA_H, o_bias, 0.125f * 1.4426950408889634f, rep_ ? ATT_PROBE : 0);
#endif
        PHASE_END
        PHASE_BEGIN(14)
            if (NAIVE(2)) { naive_gemm<false>(F, T_ / 64, DM, DM, CO, DM, [](int r) { return r; }, [&](int, const float*& b1, const float*& b2) { b1 = o_w_o; b2 = o_w_o; }, DM,
                              [&](int r, int c, float v, float) { H[(size_t)r * DM + c] = (bf16_t)f2bf(bf2f(H[(size_t)r * DM + c]) + v); }); }
            else { pg8::Gemm g{(const char*)CO, (const char*)(W + WO_O), DM, DM, DM, 2, 0u, 0u}; pg8::DenseOrder S; S.init(T_ / 256, DM / 256, F.G, (int)blockIdx.x);
                pg8::EpiResid16<false> E{H, H, nullptr, nullptr, rep_ ? 0.0f : 1.0f};
                if (((BO8_MASK) != 0) && BO8) { g.es = 1; E.scale *= 1.0f / 4096.0f; pg8::gemm_phase<pg8::EpiResid16<false>, pg8::DenseOrder, false, true>(F.lds, F.wave, g, S, E); }
                else if ((BO8_MASK) != 3) pg8::gemm_phase<pg8::EpiResid16<false>, pg8::DenseOrder, false>(F.lds, F.wave, g, S, E); }
        PHASE_END
        PHASE_BEGIN(15)
            norm_router<MOE_FP8 != 0>(F, H, o_ffn_norm, o_router, H8B, route_e, route_p, route_w, perm_g, cnt_cur, rep_ != 0);
        PHASE_END
        PHASE_BEGIN(16)
            pg8::MoeInfo mi; mi.load(cnt_cur);
            if (NAIVE(6)) {
                naive_gemm<true>(F, mi.total * 4, EFF, DM, H, DM,
                    [&](int r) { const int pm = r >> 8, e = mi.expert_of(pm), p = (pm - mi.start_of(e)) * 256 + (r & 255); return p < mi.cnt_of(e) ? perm_g[(size_t)e * T_ + p] : -1; },
                    [&](int mt, const float*& b1, const float*& b2) { const int e = mi.expert_of(mt >> 2); b1 = o_wg + (size_t)e * DM * EFF; b2 = o_wu + (size_t)e * DM * EFF; }, EFF,
                    [&](int r, int c, float v, float v2) { ACT[(size_t)r * EFF + c] = (bf16_t)f2bf(silu_f(v) * v2); });
            } else {
                pg8::Gemm g{(const char*)H8B, (const char*)(W + WO_GU), DM, DM, DM, 2, 0u, 0u}; LAS int* tb = (LAS int*)(F.lds + LDSCTL_OFF + 1024); pg8::moe_tables(mi, tb, F.tid);
                pg8::MoeOrder S; S.d.init(mi.total, 2 * EFF / 256, F.G, (int)blockIdx.x); S.perm = perm_g; S.tb = tb; S.gather = true;
#if MOE_FP8
                g.es = 1;
                pg8::EpiSwiglu8 E{(unsigned char*)ACT, EFF, 1.0f / 4096.0f, 4.0f, rep_ && EPI_PROBE}; pg8::gemm_phase<pg8::EpiSwiglu8, pg8::MoeOrder, true, true>(F.lds, F.wave, g, S, E);
#else
                pg8::EpiSwiglu E{ACT, EFF, nullptr, false, nullptr}; pg8::gemm_phase<pg8::EpiSwiglu, pg8::MoeOrder, true>(F.lds, F.wave, g, S, E);
#endif
            }
        PHASE_END
        PHASE_BEGIN(17)
            pg8::MoeInfo mi; mi.load(cnt_cur);
            if (NAIVE(7)) {
                naive_gemm<false>(F, mi.total * 4, DM, EFF, ACT, EFF,
                    [&](int r) { const int pm = r >> 8, e = mi.expert_of(pm), p = (pm - mi.start_of(e)) * 256 + (r & 255); return p < mi.cnt_of(e) ? r : -1; },
                    [&](int mt, const float*& b1, const float*& b2) { const int e = mi.expert_of(mt >> 2); b1 = o_wd + (size_t)e * EFF * DM; b2 = b1; }, DM,
                    [&](int r, int c, float v, float) { Ybuf[(size_t)r * DM + c] = (bf16_t)f2bf(v); });
            } else {
                pg8::Gemm g{(const char*)ACT, (const char*)(W + WO_D), EFF, EFF, EFF, 2, 0u, 0u}; LAS int* tb = (LAS int*)(F.lds + LDSCTL_OFF + 1024); pg8::moe_tables(mi, tb, F.tid);
                pg8::MoeOrder S; S.d.init(mi.total, DM / 256, F.G, (int)blockIdx.x); S.perm = perm_g; S.tb = tb; S.gather = false;
#if MOE_FP8
                g.es = 1;
                pg8::EpiStoreBf16 E{Ybuf, DM, 1.0f / 1024.0f}; pg8::gemm_phase<pg8::EpiStoreBf16, pg8::MoeOrder, false, true>(F.lds, F.wave, g, S, E);
#else
                pg8::EpiStoreBf16 E{Ybuf, DM, 1.0f}; pg8::gemm_phase<pg8::EpiStoreBf16, pg8::MoeOrder, false>(F.lds, F.wave, g, S, E);
#endif
            }
        PHASE_END
    }
    PHASE_BEGIN(31)
        MoeCombine mc; mc.re = route_e; mc.rp = route_p; mc.rw = route_w; mc.Y = Ybuf; mc.mi.load(ctl + CW_CNT + 512);
        res_rows<true, true, false, false, true>(F, H, nullptr, nullptr, nullptr, args.out, mc);
    PHASE_END
}

#undef XB2
#undef H8B
#undef H
#undef W
#undef BIG
#undef route_e
#undef route_p
#undef route_w
#undef perm_g
#undef Ybuf
#undef positions
#undef EIN
#undef FFN8
#undef QKV8
#undef AO8
#undef IN8
#undef MLAUP8
#undef BO8
#undef OIN
#undef e_attn_norm
#undef e_w_in
#undef e_qa
#undef e_kva
#undef e_w_uq
#undef e_w_ukv
#undef e_qn
#undef e_kn
#undef e_w_o
#undef e_ffn_norm
#undef e_wg
#undef e_wu
#undef e_wd
#undef o_attn_norm
#undef o_w_qkv
#undef o_qn
#undef o_kn
#undef o_bias
#undef o_w_o
#undef o_ffn_norm
#undef o_router
#undef o_wg
#undef o_wu
#undef o_wd
#undef cnt_prev
#undef cnt_cur
#undef A1
#undef QRAW
#undef KVRAW
#undef QN
#undef KN
#undef OM
#undef ACT
#undef CQ
#undef CK
#undef CV
#undef CO
extern "C" void kernel_launch(void* const* d_in, const int* in_sizes, int n_in, void* d_out, int out_size, void* d_ws, size_t ws_size, hipStream_t stream) {
    static int grid = 0;
    if (grid == 0) {
        if (n_in != 50 || out_size != T_ * DM || ws_size < WS_END) { fprintf(stderr, "kernel_launch: shape mismatch n_in %d out %d ws %zu (need %zu)\n", n_in, out_size, ws_size, (size_t)WS_END); grid = -1; return; }
        int dev = 0, cus = 0, per_cu = 0;
        if (hipGetDevice(&dev) != hipSuccess || hipDeviceGetAttribute(&cus, hipDeviceAttributeMultiprocessorCount, dev) != hipSuccess) { grid = -1; return; }
        if (hipFuncSetAttribute((const void*)fwd, hipFuncAttributeMaxDynamicSharedMemorySize, LDS_BYTES) != hipSuccess) { fprintf(stderr, "kernel_launch: hipFuncSetAttribute failed\n"); grid = -1; return; }
        if (hipOccupancyMaxActiveBlocksPerMultiprocessor(&per_cu, (const void*)fwd, 512, LDS_BYTES) != hipSuccess || per_cu < 1) { fprintf(stderr, "kernel_launch: occupancy query says %d\n", per_cu); }
        (void)hipGetLastError();
        grid = cus;
    }
    if (grid < 0) return;
    (void)hipMemsetAsync((char*)d_ws + WS_CTL, 0, CTL_ZERO_BYTES, stream);
    Args a{};
    for (int i = 0; i < 50; ++i) a.in[i] = d_in[i];
    a.out = (float*)d_out; a.ws = (unsigned char*)d_ws;
#if MK_PER_PHASE
    for (int p = 0; p < N_PHASES; ++p) { a.ph_lo = p; a.ph_hi = p + 1; hipLaunchKernelGGL(fwd, dim3(grid), dim3(512), LDS_BYTES, stream, a); }
#else
    a.ph_lo = 0; a.ph_hi = N_PHASES; hipLaunchKernelGGL(fwd, dim3(grid), dim3(512), LDS_BYTES, stream, a);
#endif
    const hipError_t le = hipPeekAtLastError();
    if (le != hipSuccess) fprintf(stderr, "kernel_launch: launch failed: %s\n", hipGetErrorName(le));
}
```

```cpp
#include <hip/hip_runtime.h>
#include <cstdio>
#include <cstdint>

#ifndef MK_PER_PHASE
#define MK_PER_PHASE 0
#endif
#ifndef NAIVE_MASK
#define NAIVE_MASK 0x0
#endif
#ifndef MOE_FP8
#define MOE_FP8 1
#endif
#ifndef FFN8_MASK
#define FFN8_MASK 2
#endif
#ifndef QKV8_MASK
#define QKV8_MASK 3
#endif
#ifndef MLAUP8_MASK
#define MLAUP8_MASK 0
#endif
#ifndef IN8_MASK
#define IN8_MASK 0
#endif
#ifndef AO8_MASK
#define AO8_MASK 3
#endif
#ifndef BO8_MASK
#define BO8_MASK 3
#endif
#define HAS_G3(f, q) ((((AO8_MASK) & 1) == (f) && ((FFN8_MASK) & 1) == (q)) || ((((AO8_MASK) >> 1) & 1) == (f) && (((FFN8_MASK) >> 1) & 1) == (q)))
#define HAS_G5(f, q) ((((FFN8_MASK) & 1) == (f) && ((QKV8_MASK) & 1) == (q)) || ((((FFN8_MASK) >> 1) & 1) == (f) && (((QKV8_MASK) >> 1) & 1) == (q)))
#ifndef KL_PROBE
#define KL_PROBE 0
#endif
#ifndef MLA_PIPE
#define MLA_PIPE false
#endif
#ifndef BAND_PIPE
#define BAND_PIPE true
#endif
#ifndef NAIVE_ATTN
#define NAIVE_ATTN 0
#endif

#define GAS __attribute__((address_space(1)))
#define LAS __attribute__((address_space(3)))
typedef unsigned short bf16_t;
typedef short bf16x8 __attribute__((ext_vector_type(8)));
typedef short s16x4 __attribute__((ext_vector_type(4)));
typedef float f32x4 __attribute__((ext_vector_type(4)));
typedef float f32x2 __attribute__((ext_vector_type(2)));
typedef unsigned u32x4 __attribute__((ext_vector_type(4)));
typedef unsigned u32x2 __attribute__((ext_vector_type(2)));
typedef GAS unsigned gu32;

constexpr int T_ = 32768, DM = 1024, SEQ = 2048, NBATCH = 16, NCHK = 32;
constexpr float EPS = 1e-6f;
constexpr int MLA_H = 8, QKD = 192, NOPE = 128, ROPE = 64, VD = 128, QLORA = 256, KVLORA = 128, AIN = 448, AINP = 512;
constexpr int CA_H = 16, CA_D = 64, NREL = 320;
constexpr int FF = 2816, NE = 8, EFF = 3584;
constexpr int MAXROWS = 2 * T_ + NE * 256;

constexpr size_t MiB = 1u << 20;
constexpr size_t WS_CTL = 0, CTL_ZERO_BYTES = 1 * MiB;
constexpr size_t WS_ROUTE_E = 1 * MiB;
constexpr size_t WS_ROUTE_P = WS_ROUTE_E + (size_t)T_ * 8;
constexpr size_t WS_ROUTE_W = WS_ROUTE_P + (size_t)T_ * 8;
constexpr size_t WS_PERM = 2 * MiB;
constexpr size_t WS_W = 4 * MiB;
constexpr size_t WS_H = 184 * MiB;
constexpr size_t WS_BIG = 248 * MiB;
constexpr size_t WS_END = WS_BIG + 644 * MiB;
constexpr size_t WE_IN = 0, WE_O = 3 * MiB, WE_GU = 5 * MiB, WE_D = 16 * MiB, WE_QKVF = 22 * MiB;
constexpr size_t WS_CS = WS_W + 160 * MiB;
constexpr size_t WS_SSX = WS_W + 172 * MiB;
constexpr size_t WS_SSQ = WS_W + 170 * MiB;
constexpr size_t WO_QKV = 32 * MiB, WO_O = 38 * MiB, WO_GU = 40 * MiB, WO_D = 96 * MiB;
constexpr size_t B_A1 = 0, B_VM = 32 * MiB, B_QN = 256 * MiB, B_KN = 352 * MiB, B_OM = 448 * MiB;
constexpr size_t B_ACT = 0;
constexpr size_t B_CQ = 0, B_CK = 64 * MiB, B_CV = 128 * MiB, B_CO = 192 * MiB;
constexpr size_t B_Y = 512 * MiB;
static_assert(B_Y + (size_t)MAXROWS * 1024 * 2 <= 644 * MiB && (size_t)MAXROWS * EFF * 2 <= B_Y, "BIG map");
constexpr int CW_TMO = 0, CW_BAR = 4096, CW_CNT = 8192;

static_assert(MOE_FP8 == 1, "the odd-layer weight map (WO_*) is sized for fp8 expert weights");
constexpr int RING_BYTES = 131072, LDSCTL_OFF = RING_BYTES, MISC_OFF = LDSCTL_OFF + 320, LDS_BYTES = 147456;

#define RLX_AGENT __ATOMIC_RELAXED, __HIP_MEMORY_SCOPE_AGENT
#define LDS_WAIT() asm volatile("s_waitcnt lgkmcnt(0)" ::: "memory")
#define VM_WAIT() asm volatile("s_waitcnt vmcnt(0)" ::: "memory")
__device__ __forceinline__ float bf2f(unsigned b) { return __uint_as_float(b << 16); }
__device__ __forceinline__ unsigned f2bf(float f) { unsigned u = __float_as_uint(f); return (u + 0x7fffu + ((u >> 16) & 1u)) >> 16; }
__device__ __forceinline__ unsigned pk2(float lo, float hi) { return f2bf(lo) | (f2bf(hi) << 16); }
__device__ __forceinline__ unsigned cvt_pk_bf16(float lo, float hi) { unsigned r; asm volatile("v_cvt_pk_bf16_f32 %0, %1, %2" : "=v"(r) : "v"(lo), "v"(hi)); return r; }
template <int CTRL, int ROWMASK>
__device__ __forceinline__ float dpp_f(float v) { return __uint_as_float((unsigned)__builtin_amdgcn_update_dpp(0, (int)__float_as_uint(v), CTRL, ROWMASK, 0xF, false)); }
__device__ __forceinline__ float sum_x16_x32(float p) {
    const auto a = __builtin_amdgcn_permlane16_swap(__float_as_uint(p), __float_as_uint(p), false, false); p = __uint_as_float(a[0]) + __uint_as_float(a[1]);
    const auto b = __builtin_amdgcn_permlane32_swap(__float_as_uint(p), __float_as_uint(p), false, false); return __uint_as_float(b[0]) + __uint_as_float(b[1]);
}
__device__ __forceinline__ float wave_sum(float v) {
    v += dpp_f<0xB1, 0xF>(v); v += dpp_f<0x4E, 0xF>(v); v += dpp_f<0x141, 0xF>(v); v += dpp_f<0x140, 0xF>(v);
    v += dpp_f<0x142, 0xA>(v); v += dpp_f<0x143, 0xC>(v);
    return __uint_as_float((unsigned)__builtin_amdgcn_readlane((int)__float_as_uint(v), 63));
}
__device__ __forceinline__ float silu_f(float g) { return g * __builtin_amdgcn_rcpf(1.0f + __builtin_amdgcn_exp2f(g * -1.4426950408889634f)); }
__device__ __forceinline__ float swiglu_s(float g, float u, float c1  , float c2  ) { return (g * u) * (c2 * __builtin_amdgcn_rcpf(1.0f + __builtin_amdgcn_exp2f(g * c1))); }
__device__ __forceinline__ void swiglu8(const f32x4 g0, const f32x4 g1, const f32x4 u0, const f32x4 u1, const float c1, const float k, f32x4& o0, f32x4& o1) {
    const f32x4 t0 = g0 * c1, t1 = g1 * c1; f32x4 e0, e1, r0, r1;
#pragma unroll
    for (int j = 0; j < 4; ++j) { e0[j] = __builtin_amdgcn_exp2f(t0[j]); e1[j] = __builtin_amdgcn_exp2f(t1[j]); }
    const f32x4 d0 = e0 * k + k, d1 = e1 * k + k, p0 = g0 * u0, p1 = g1 * u1;
#pragma unroll
    for (int j = 0; j < 4; ++j) { r0[j] = __builtin_amdgcn_rcpf(d0[j]); r1[j] = __builtin_amdgcn_rcpf(d1[j]); }
    o0 = p0 * r0; o1 = p1 * r1;
}
__device__ __forceinline__ float clamp8(float x) { return __builtin_amdgcn_fmed3f(x, -448.0f, 448.0f); }
__device__ __forceinline__ unsigned pk4_fp8(float a, float b, float c, float d) {
    unsigned w = 0u; w = __builtin_amdgcn_cvt_pk_fp8_f32(clamp8(a), clamp8(b), w, false); w = __builtin_amdgcn_cvt_pk_fp8_f32(clamp8(c), clamp8(d), w, true); return w; }

#ifndef WT_STORES
#define WT_STORES 0
#endif
__device__ __forceinline__ void st16(void* p, u32x4 v) {
#if WT_STORES
    asm volatile("global_store_dwordx4 %0, %1, off sc1" :: "v"(p), "v"(v) : "memory");
#else
    *(u32x4*)p = v;
#endif
}
__device__ __forceinline__ void st8(void* p, u32x2 v) {
#if WT_STORES
    asm volatile("global_store_dwordx2 %0, %1, off sc1" :: "v"(p), "v"(v) : "memory");
#else
    *(u32x2*)p = v;
#endif
}
__device__ __forceinline__ void glds16_s(unsigned voff, const char* sbase, unsigned ldsaddr) { unsigned keep;
    asm volatile("s_mov_b32 %0, m0\n\ts_mov_b32 m0, %3\n\ts_nop 0\n\tglobal_load_lds_dwordx4 %1, %2\n\ts_mov_b32 m0, %0" : "=&s"(keep) : "v"(voff), "s"(sbase), "s"(ldsaddr) : "memory"); }

__device__ __forceinline__ void glds4_s(unsigned voff, const char* sbase, unsigned ldsaddr) { unsigned keep;
    asm volatile("s_mov_b32 %0, m0\n\ts_mov_b32 m0, %3\n\ts_nop 0\n\tglobal_load_lds_dword %1, %2\n\ts_mov_b32 m0, %0" : "=&s"(keep) : "v"(voff), "s"(sbase), "s"(ldsaddr) : "memory"); }

#define XB_TMO      128
#define XB_XCNT(j)  (256  + 64 * (j))
#define XB_XSUB(j)  (1280 + 64 * (j))
#define XB_XGEN(j)  (2304 + 64 * (j))
#define XB_TOP      3328
#define XB_TOPGEN   3392
#define XCD_BAR_WORDS 3456
#define XB_SPIN_CAP (1u << 18)
__device__ __forceinline__ unsigned xb_ld(unsigned* p)              { return __hip_atomic_load(p, __ATOMIC_RELAXED, __HIP_MEMORY_SCOPE_AGENT); }
__device__ __forceinline__ unsigned xb_add(unsigned* p, unsigned v) { return __hip_atomic_fetch_add(p, v, __ATOMIC_RELAXED, __HIP_MEMORY_SCOPE_AGENT); }
__device__ __forceinline__ unsigned xb_xcc_id() { return (unsigned)__builtin_amdgcn_s_getreg((3 << 11) | 20) & 0xFu; }
#define XB_SPIN(cond, bar) do { unsigned _sp = 0; while (cond) { __builtin_amdgcn_s_sleep(1); \
    if ((++_sp & 255u) == 0u) { if (xb_ld(&(bar)[XB_TMO])) break; if (_sp > XB_SPIN_CAP) { atomicAdd(&(bar)[XB_TMO], 1u); break; } } } } while (0)
struct XcdBarrier { unsigned* bar; unsigned x; volatile LAS unsigned* st; };
__device__ __forceinline__ XcdBarrier xcd_barrier_post(unsigned* bar, volatile LAS unsigned* st) {
    XcdBarrier b; b.bar = bar; b.x = xb_xcc_id(); b.st = st;
    if (threadIdx.x == 0) (void)xb_add(&bar[XB_XCNT(b.x)], 1u);
    return b;
}
__device__ __forceinline__ void xcd_barrier_complete(unsigned* bar, unsigned x, unsigned& nloc, unsigned& nx) {
    const unsigned G = gridDim.x * gridDim.y * gridDim.z;
    unsigned sum, cnt, mine, sp = 0u;
    for (;;) {
        sum = 0u; cnt = 0u; mine = 0u;
#pragma unroll
        for (unsigned j = 0; j < 16; ++j) { const unsigned c = xb_ld(&bar[XB_XCNT(j)]); sum += c; cnt += (c > 0u) ? 1u : 0u; mine = (j == x) ? c : mine; }
        if (sum == G) break;
        __builtin_amdgcn_s_sleep(1);
        if ((++sp & 255u) == 0u) { if (xb_ld(&bar[XB_TMO])) break; if (sp > XB_SPIN_CAP) { atomicAdd(&bar[XB_TMO], 1u); break; } }
    }
    nloc = mine > 0u ? mine : 1u; nx = cnt > 0u ? cnt : 1u;
}
__device__ __forceinline__ void xcd_barrier(const XcdBarrier& b, const int tid) {
    asm volatile("s_waitcnt vmcnt(0)" ::: "memory");
    __syncthreads();
    if (tid == 0) {
        unsigned* bar = b.bar;
        __builtin_amdgcn_s_waitcnt(0);
        unsigned nloc = b.st[0], nx = b.st[1];
        if (nloc == 0u) { xcd_barrier_complete(bar, b.x, nloc, nx); b.st[0] = nloc; b.st[1] = nx; }
        const unsigned old = xb_add(&bar[XB_XSUB(b.x)], 1u);
        const unsigned gen = old / nloc;
        if (old + 1u == (gen + 1u) * nloc) {
            __builtin_amdgcn_fence(__ATOMIC_RELEASE, "agent");
            asm volatile("s_waitcnt vmcnt(0)" ::: "memory");
            const unsigned og = xb_add(&bar[XB_TOP], 1u);
            const unsigned tg = og / nx;
            if (og + 1u == (tg + 1u) * nx) xb_add(&bar[XB_TOPGEN], 1u);
            else XB_SPIN(xb_ld(&bar[XB_TOPGEN]) == tg, bar);
            __builtin_amdgcn_fence(__ATOMIC_ACQUIRE, "agent");
            xb_add(&bar[XB_XGEN(b.x)], 1u);
            asm volatile("s_waitcnt vmcnt(0)" ::: "memory");
        } else {
            XB_SPIN(xb_ld(&bar[XB_XGEN(b.x)]) == gen, bar);
            __builtin_amdgcn_fence(__ATOMIC_ACQUIRE, "agent");
            asm volatile("s_waitcnt vmcnt(0)" ::: "memory");
        }
    }
    __syncthreads();
}

namespace pg8 {
constexpr int BM = 256, BK = 64, HALF = 128, HTB = HALF * BK * 2, STAGE_BYTES = 8 * HTB, NXCD = 8, WGM = 8;
__host__ __device__ __forceinline__ int lds_byte(int r, int c) { const int st = (r >> 4) * 2 + (c >> 5), rr = r & 15, cc = c & 31, ob = rr * 64 + cc * 2; return st * 1024 + (ob ^ (((ob >> 9) & 1) << 5)); }
__host__ __device__ __forceinline__ void stage_rc(int b, int& R, int& C) { const int st = b / 1024, sb = b % 1024, swz = sb ^ (((sb >> 9) & 1) << 5); R = (st >> 1) * 16 + swz / 64; C = (st & 1) * 32 + (swz % 64) / 2; }
__host__ __device__ __forceinline__ int perm32(int rho) { const int n = rho >> 4, i = rho & 15; return 8 * (i >> 2) + 4 * n + (i & 3); }

struct Unit { int pm, pn; };
typedef int v4i_t __attribute__((ext_vector_type(4)));
struct Gemm { const char* A; const char* Bt; int K, lda, ldb, es; unsigned sw, sa; int probe = 0; };

struct DenseOrder {
    int nM, nN, nwg, G, c;
    __device__ __forceinline__ void init(int nM_, int nN_, int G_, int c_) { nM = nM_; nN = nN_; nwg = nM * nN; G = G_; c = c_; }
    __device__ __forceinline__ bool next(int i, Unit& u) const {
        const long L = (long)i * G + c; if (L >= nwg) return false;
        int wgid = (int)L; { const int q = nwg / NXCD, r = nwg % NXCD, xcd = wgid % NXCD, off = wgid / NXCD; wgid = (xcd < r ? xcd * (q + 1) : r * (q + 1) + (xcd - r) * q) + off; }
        const int nig = WGM * nN, gid = wgid / nig, fm = gid * WGM, gsz = (nM - fm) < WGM ? (nM - fm) : WGM;
        u.pm = fm + ((wgid % nig) % gsz); u.pn = (wgid % nig) / gsz; return true;
    }
    __device__ __forceinline__ const char* a_base(const Gemm& g, const Unit& u) const { return g.A + (size_t)u.pm * 256 * g.lda * g.es; }
    __device__ __forceinline__ const char* b_base(const Gemm& g, const Unit& u) const { return g.Bt + (size_t)u.pn * 256 * g.ldb * g.es; }
    __device__ __forceinline__ const int* toklist(const Unit&) const { return nullptr; }
    __device__ __forceinline__ LAS unsigned* ofs() const { return nullptr; }
};
struct MoeInfo {
    int c0, c1, c2, c3, c4, c5, c6, c7;
    int s1, s2, s3, s4, s5, s6, s7, total;
    __device__ __forceinline__ void load(const gu32* cnt) {
        c0 = (int)__hip_atomic_load(cnt + 0 * 64, RLX_AGENT); c1 = (int)__hip_atomic_load(cnt + 1 * 64, RLX_AGENT); c2 = (int)__hip_atomic_load(cnt + 2 * 64, RLX_AGENT); c3 = (int)__hip_atomic_load(cnt + 3 * 64, RLX_AGENT);
        c4 = (int)__hip_atomic_load(cnt + 4 * 64, RLX_AGENT); c5 = (int)__hip_atomic_load(cnt + 5 * 64, RLX_AGENT); c6 = (int)__hip_atomic_load(cnt + 6 * 64, RLX_AGENT); c7 = (int)__hip_atomic_load(cnt + 7 * 64, RLX_AGENT);
        c0 = __builtin_amdgcn_readfirstlane(c0); c1 = __builtin_amdgcn_readfirstlane(c1); c2 = __builtin_amdgcn_readfirstlane(c2); c3 = __builtin_amdgcn_readfirstlane(c3);
        c4 = __builtin_amdgcn_readfirstlane(c4); c5 = __builtin_amdgcn_readfirstlane(c5); c6 = __builtin_amdgcn_readfirstlane(c6); c7 = __builtin_amdgcn_readfirstlane(c7);
        s1 = (c0 + 255) >> 8; s2 = s1 + ((c1 + 255) >> 8); s3 = s2 + ((c2 + 255) >> 8); s4 = s3 + ((c3 + 255) >> 8);
        s5 = s4 + ((c4 + 255) >> 8); s6 = s5 + ((c5 + 255) >> 8); s7 = s6 + ((c6 + 255) >> 8); total = s7 + ((c7 + 255) >> 8);
    }
    __device__ __forceinline__ int expert_of(int pm) const { return (pm >= s1) + (pm >= s2) + (pm >= s3) + (pm >= s4) + (pm >= s5) + (pm >= s6) + (pm >= s7); }
    __device__ __forceinline__ int start_of(int e) const { return e == 0 ? 0 : e == 1 ? s1 : e == 2 ? s2 : e == 3 ? s3 : e == 4 ? s4 : e == 5 ? s5 : e == 6 ? s6 : s7; }
    __device__ __forceinline__ int cnt_of(int e) const { return e == 0 ? c0 : e == 1 ? c1 : e == 2 ? c2 : e == 3 ? c3 : e == 4 ? c4 : e == 5 ? c5 : e == 6 ? c6 : c7; }
};
struct MoeOrder {
    static constexpr int TBN = 272;
    DenseOrder d; const int* perm; const LAS int* tb; bool gather;
    __device__ __forceinline__ bool next(int i, Unit& u) const { return d.next(i, u); }
    __device__ __forceinline__ const char* a_base(const Gemm& g, const Unit& u) const { return gather ? g.A : g.A + (size_t)u.pm * 256 * g.lda * g.es; }
    __device__ __forceinline__ const char* b_base(const Gemm& g, const Unit& u) const { const int e = __builtin_amdgcn_readfirstlane(tb[u.pm]); return g.Bt + ((size_t)e * d.nN + u.pn) * 256 * g.ldb * g.es; }
    __device__ __forceinline__ const int* toklist(const Unit& u) const { return perm + __builtin_amdgcn_readfirstlane(tb[2 * TBN + u.pm]); }
    __device__ __forceinline__ LAS unsigned* ofs() const { return (LAS unsigned*)(tb + 3 * TBN); }
};
__device__ __forceinline__ void moe_tables(const MoeInfo& mi, LAS int* tb, int tid) {
    if (tid < MoeOrder::TBN) { int e = 0, rem = 0, base = 0;
        if (tid < mi.total) { e = mi.expert_of(tid); const int lt = tid - mi.start_of(e); rem = mi.cnt_of(e) - lt * 256; base = e * T_ + lt * 256; }
        tb[tid] = e; tb[MoeOrder::TBN + tid] = rem; tb[2 * MoeOrder::TBN + tid] = base; }
    __syncthreads();
}

struct EpiStoreBf16 {
    static constexpr bool PERM = true, PREFETCH = false;
    bf16_t* O; int ldc; float scale;
    __device__ __forceinline__ void operator()(const f32x4 (&acc)[2][2][4][2], const Unit& u, int wr, int wc, int fr, int fq) const {
        const int row0 = u.pm * BM + wr * 64 + fr, col0 = u.pn * BM + wc * 32 + 8 * fq;
#pragma unroll
        for (int ai = 0; ai < 2; ++ai)
#pragma unroll
            for (int m = 0; m < 4; ++m) { bf16_t* rowp = O + (size_t)(row0 + ai * HALF + m * 16) * ldc + col0;
#pragma unroll
                for (int bj = 0; bj < 2; ++bj) { const f32x4 v0 = acc[ai][bj][m][0] * scale, v1 = acc[ai][bj][m][1] * scale;
                    u32x4 w; w.x = cvt_pk_bf16(v0[0], v0[1]); w.y = cvt_pk_bf16(v0[2], v0[3]); w.z = cvt_pk_bf16(v1[0], v1[1]); w.w = cvt_pk_bf16(v1[2], v1[3]);
                    st16(rowp + bj * HALF, w); } }
    }
};
struct EpiResid {
    static constexpr bool PERM = true, PREFETCH = false;
    float* X; int ldc; float scale;
    __device__ __forceinline__ void operator()(const f32x4 (&acc)[2][2][4][2], const Unit& u, int wr, int wc, int fr, int fq) const {
        const int row0 = u.pm * BM + wr * 64 + fr, col0 = u.pn * BM + wc * 32 + 8 * fq;
#pragma unroll
        for (int ai = 0; ai < 2; ++ai)
#pragma unroll
            for (int m = 0; m < 4; ++m) { float* rowp = X + (size_t)(row0 + ai * HALF + m * 16) * ldc + col0;
#pragma unroll
                for (int bj = 0; bj < 2; ++bj) { f32x4* p = (f32x4*)(rowp + bj * HALF); f32x4 a = p[0], b = p[1]; a += acc[ai][bj][m][0] * scale; b += acc[ai][bj][m][1] * scale; p[0] = a; p[1] = b; } }
    }
};
template <bool STATS, bool W8 = false>
struct EpiResid16 {
    static constexpr bool PERM = true, PREFETCH = false;
    const bf16_t* XBin; bf16_t* XB; float* ss; LAS float* P; float scale; unsigned char* X8 = nullptr;
    __device__ __forceinline__ void operator()(const f32x4 (&acc)[2][2][4][2], const Unit& u, int wr, int wc, int fr, int fq) const {
        const int col0 = u.pn * BM + wc * 32 + 8 * fq;
#pragma unroll
        for (int ai = 0; ai < 2; ++ai) { u32x4 xin[4][2];
#pragma unroll
            for (int m = 0; m < 4; ++m)
#pragma unroll
                for (int bj = 0; bj < 2; ++bj) xin[m][bj] = *(const u32x4*)(XBin + (size_t)(u.pm * BM + ai * HALF + wr * 64 + m * 16 + fr) * DM + col0 + bj * HALF);
#pragma unroll
            for (int m = 0; m < 4; ++m) { const int rl = ai * HALF + wr * 64 + m * 16 + fr; bf16_t* rowb = XB + (size_t)(u.pm * BM + rl) * DM + col0; float p = 0.f;
#pragma unroll
                for (int bj = 0; bj < 2; ++bj) { const u32x4 xi = xin[m][bj];
                    f32x4 a = (f32x4){bf2f(xi.x & 0xffffu), bf2f(xi.x >> 16), bf2f(xi.y & 0xffffu), bf2f(xi.y >> 16)}, b = (f32x4){bf2f(xi.z & 0xffffu), bf2f(xi.z >> 16), bf2f(xi.w & 0xffffu), bf2f(xi.w >> 16)};
                    a += acc[ai][bj][m][0] * scale; b += acc[ai][bj][m][1] * scale;
                    if constexpr (STATS) p += ((a[0] * a[0] + a[1] * a[1]) + (a[2] * a[2] + a[3] * a[3])) + ((b[0] * b[0] + b[1] * b[1]) + (b[2] * b[2] + b[3] * b[3]));
                    u32x4 w; w.x = cvt_pk_bf16(a[0], a[1]); w.y = cvt_pk_bf16(a[2], a[3]); w.z = cvt_pk_bf16(b[0], b[1]); w.w = cvt_pk_bf16(b[2], b[3]); st16(rowb + bj * HALF, w);
                    if constexpr (W8) { u32x2 w8; w8.x = pk4_fp8(a[0] * 8.0f, a[1] * 8.0f, a[2] * 8.0f, a[3] * 8.0f); w8.y = pk4_fp8(b[0] * 8.0f, b[1] * 8.0f, b[2] * 8.0f, b[3] * 8.0f); st8(X8 + (size_t)(u.pm * BM + rl) * DM + col0 + bj * HALF, w8); } }
                if constexpr (STATS) { p = sum_x16_x32(p); if (fq == 0) P[rl * 4 + wc] = p; } }
            asm volatile("" ::: "memory"); }
        if constexpr (STATS) {
            asm volatile("s_waitcnt lgkmcnt(0)" ::: "memory"); __builtin_amdgcn_s_barrier(); asm volatile("" ::: "memory");
            if (wc == 0 && fq == 0) {
#pragma unroll
                for (int ai = 0; ai < 2; ++ai)
#pragma unroll
                    for (int m = 0; m < 4; ++m) { const int rl = ai * HALF + wr * 64 + m * 16 + fr; const f32x4 p4 = *(const LAS f32x4*)(P + rl * 4);
                        ss[(size_t)(u.pm * BM + rl) * 4 + u.pn] = (p4[0] + p4[1]) + (p4[2] + p4[3]); } } }
    }
};
struct EpiSwiglu {
    static constexpr bool PERM = true, PREFETCH = true;
    bf16_t* O; int ldc; const float* ss; bool skip; LAS float* P;
    __device__ __forceinline__ void prefetch(const Unit& u, int wid, int lane) const {
        if (ss && wid < 4) glds16_s((unsigned)lane * 16u, (const char*)(ss + (size_t)(u.pm * BM + wid * 64) * 4), (unsigned)__builtin_amdgcn_readfirstlane((int)(unsigned)(uintptr_t)P) + (unsigned)wid * 1024u); }
    __device__ __forceinline__ void operator()(const f32x4 (&acc)[2][2][4][2], const Unit& u, int wr, int wc, int fr, int fq) const {
        if (skip) return;
        const int row0 = u.pm * BM + wr * 64 + fr, col0 = u.pn * HALF + wc * 32 + 8 * fq;
        float rs8[8], kv8[8];
        if (ss) {
#pragma unroll
            for (int r8 = 0; r8 < 8; ++r8) { const f32x4 s4 = *(const LAS f32x4*)(P + ((r8 >> 2) * HALF + wr * 64 + (r8 & 3) * 16 + fr) * 4); kv8[r8] = ((s4[0] + s4[1]) + (s4[2] + s4[3])) * (1.0f / DM) + EPS; rs8[r8] = rsqrtf(kv8[r8]); } }
        else {
#pragma unroll
            for (int r8 = 0; r8 < 8; ++r8) { rs8[r8] = 1.0f; kv8[r8] = 1.0f; } }
#pragma unroll
        for (int ai = 0; ai < 2; ++ai)
#pragma unroll
            for (int m = 0; m < 4; ++m) { bf16_t* rowp = O + (size_t)(row0 + ai * HALF + m * 16) * ldc + col0;
                const float rs = rs8[ai * 4 + m], kv = kv8[ai * 4 + m];
                f32x4 o0, o1; swiglu8(acc[ai][0][m][0], acc[ai][0][m][1], acc[ai][1][m][0], acc[ai][1][m][1], rs * -1.4426950408889634f, kv, o0, o1);
                u32x4 w; w.x = cvt_pk_bf16(o0[0], o0[1]); w.y = cvt_pk_bf16(o0[2], o0[3]); w.z = cvt_pk_bf16(o1[0], o1[1]); w.w = cvt_pk_bf16(o1[2], o1[3]);
                st16(rowp, w); }
    }
};
struct EpiSwiglu8 {
    static constexpr bool PERM = true, PREFETCH = false;
    unsigned char* O; int ldc; float iscale, oscale; bool skip;
    __device__ __forceinline__ void operator()(const f32x4 (&acc)[2][2][4][2], const Unit& u, int wr, int wc, int fr, int fq) const {
        if (skip) return;
        const int row0 = u.pm * BM + wr * 64 + fr, col0 = u.pn * HALF + wc * 32 + 8 * fq;
#pragma unroll
        for (int ai = 0; ai < 2; ++ai)
#pragma unroll
            for (int m = 0; m < 4; ++m) { unsigned char* rowp = O + (size_t)(row0 + ai * HALF + m * 16) * ldc + col0;
                const float c1 = iscale * -1.4426950408889634f, kk = 1.0f / (iscale * iscale * oscale);
                f32x4 o0, o1; swiglu8(acc[ai][0][m][0], acc[ai][0][m][1], acc[ai][1][m][0], acc[ai][1][m][1], c1, kk, o0, o1);
                u32x2 w; w.x = pk4_fp8(o0[0], o0[1], o0[2], o0[3]); w.y = pk4_fp8(o1[0], o1[1], o1[2], o1[3]);
                st8(rowp, w); }
    }
};
struct EpiSwiglu8R {
    static constexpr bool PERM = true, PREFETCH = true;
    unsigned char* O; int ldc; float iscale, oscale; const float* ss; LAS float* P;
    __device__ __forceinline__ void prefetch(const Unit& u, int wid, int lane) const {
        if (wid < 4) glds16_s((unsigned)lane * 16u, (const char*)(ss + (size_t)(u.pm * BM + wid * 64) * 4), (unsigned)__builtin_amdgcn_readfirstlane((int)(unsigned)(uintptr_t)P) + (unsigned)wid * 1024u); }
    __device__ __forceinline__ void operator()(const f32x4 (&acc)[2][2][4][2], const Unit& u, int wr, int wc, int fr, int fq) const {
        const int row0 = u.pm * BM + wr * 64 + fr, col0 = u.pn * HALF + wc * 32 + 8 * fq;
        float rs8[8], kv8[8]; const float ik = 1.0f / (iscale * iscale * oscale);
#pragma unroll
        for (int r8 = 0; r8 < 8; ++r8) { const f32x4 s4 = *(const LAS f32x4*)(P + ((r8 >> 2) * HALF + wr * 64 + (r8 & 3) * 16 + fr) * 4); const float var = ((s4[0] + s4[1]) + (s4[2] + s4[3])) * (1.0f / DM) + EPS; rs8[r8] = rsqrtf(var) * iscale; kv8[r8] = var * ik; }
#pragma unroll
        for (int ai = 0; ai < 2; ++ai)
#pragma unroll
            for (int m = 0; m < 4; ++m) { unsigned char* rowp = O + (size_t)(row0 + ai * HALF + m * 16) * ldc + col0;
                f32x4 o0, o1; swiglu8(acc[ai][0][m][0], acc[ai][0][m][1], acc[ai][1][m][0], acc[ai][1][m][1], rs8[ai * 4 + m] * -1.4426950408889634f, kv8[ai * 4 + m], o0, o1);
                u32x2 w; w.x = pk4_fp8(o0[0], o0[1], o0[2], o0[3]); w.y = pk4_fp8(o1[0], o1[1], o1[2], o1[3]);
                st8(rowp, w); }
    }
};
template <bool OUT8 = false>
struct EpiA1 {
    static constexpr bool PERM = true, PREFETCH = true;
    bf16_t* O; int ldc; float* ss; const float* ssin; LAS float* P; float iscale = 1.0f;
    __device__ __forceinline__ void prefetch(const Unit& u, int wid, int lane) const {
        if (wid < 4) glds16_s((unsigned)lane * 16u, (const char*)(ssin + (size_t)(u.pm * BM + wid * 64) * 4), (unsigned)__builtin_amdgcn_readfirstlane((int)(unsigned)(uintptr_t)P) + (unsigned)wid * 1024u); }
    __device__ __forceinline__ void operator()(const f32x4 (&acc)[2][2][4][2], const Unit& u, int wr, int wc, int fr, int fq) const {
        const int row0 = u.pm * BM + wr * 64 + fr, col0 = u.pn * BM + wc * 32 + 8 * fq;
        float rs8[8];
#pragma unroll
        for (int r8 = 0; r8 < 8; ++r8) { const f32x4 s4 = *(const LAS f32x4*)(P + ((r8 >> 2) * HALF + wr * 64 + (r8 & 3) * 16 + fr) * 4); rs8[r8] = rsqrtf(((s4[0] + s4[1]) + (s4[2] + s4[3])) * (1.0f / DM) + EPS) * iscale; }
        float* sp = ss + (size_t)u.pn * T_ * 4 + wc;
#pragma unroll
        for (int ai = 0; ai < 2; ++ai)
#pragma unroll
            for (int m = 0; m < 4; ++m) { const int row = row0 + ai * HALF + m * 16; bf16_t* rowp = O + (size_t)row * ldc + col0; float p = 0.f;
#pragma unroll
                for (int bj = 0; bj < 2; ++bj) { const float rs = rs8[ai * 4 + m]; const f32x4 v0 = acc[ai][bj][m][0] * rs, v1 = acc[ai][bj][m][1] * rs;
                    if (bj == 0 || u.pn == 0) p += ((v0[0] * v0[0] + v0[1] * v0[1]) + (v0[2] * v0[2] + v0[3] * v0[3])) + ((v1[0] * v1[0] + v1[1] * v1[1]) + (v1[2] * v1[2] + v1[3] * v1[3]));
                    if constexpr (OUT8) { u32x2 w8; w8.x = pk4_fp8(v0[0] * 16.0f, v0[1] * 16.0f, v0[2] * 16.0f, v0[3] * 16.0f); w8.y = pk4_fp8(v1[0] * 16.0f, v1[1] * 16.0f, v1[2] * 16.0f, v1[3] * 16.0f);
                        *(u32x2*)((unsigned char*)O + (size_t)row * ldc + col0 + bj * HALF) = w8; }
                    else { u32x4 w; w.x = cvt_pk_bf16(v0[0], v0[1]); w.y = cvt_pk_bf16(v0[2], v0[3]); w.z = cvt_pk_bf16(v1[0], v1[1]); w.w = cvt_pk_bf16(v1[2], v1[3]);
                    *(u32x4*)(rowp + bj * HALF) = w; } }
                p = sum_x16_x32(p);
                if (fq == 0) sp[(size_t)row * 4] = p; }
    }
};
struct EpiMlaQKV {
    static constexpr bool PERM = true, PREFETCH = true;
    LAS float* SS4;
    __device__ __forceinline__ void prefetch(const Unit& u, int wid, int lane) const {
        if (wid < 4) { const float* ssp = ss + (u.pn < 8 ? (size_t)0 : (size_t)T_ * 4);
            glds16_s((unsigned)lane * 16u, (const char*)(ssp + (size_t)(u.pm * BM + wid * 64) * 4), (unsigned)__builtin_amdgcn_readfirstlane((int)(unsigned)(uintptr_t)SS4) + (unsigned)wid * 1024u);
            glds4_s((unsigned)lane * 4u, (const char*)(positions + u.pm * BM + wid * 64), (unsigned)__builtin_amdgcn_readfirstlane((int)(unsigned)(uintptr_t)(P + 1280)) + (unsigned)wid * 256u); } }
    bf16_t* QN; size_t kn_off; bf16_t* VM; const float* ss; const float* gq; const float* gk; const int* positions; LAS float* P; float iscale = 1.0f; bool nostore = false;
    __device__ __forceinline__ void operator()(const f32x4 (&acc)[2][2][4][2], const Unit& u, int wr, int wc, int fr, int fq) const {
        asm volatile("" : "+v"(fr), "+v"(fq));
        const int pn = u.pn, row0 = u.pm * BM + wr * 64 + fr;
        if (pn >= 16) {
#pragma unroll
            for (int ai = 0; ai < 2; ++ai) { f32x4 s4[4];
#pragma unroll
                for (int m = 0; m < 4; ++m) s4[m] = *(const LAS f32x4*)(SS4 + (ai * HALF + wr * 64 + m * 16 + fr) * 4);
#pragma unroll
                for (int m = 0; m < 4; ++m) { const int row = row0 + ai * HALF + m * 16;
                    const float rs = rsqrtf(((s4[m][0] + s4[m][1]) + (s4[m][2] + s4[m][3])) * (1.0f / KVLORA) + EPS) * iscale;
                    const int sq_ = row & (SEQ - 1), bb_ = row >> 11;
                    bf16_t* rowp = VM + ((size_t)((bb_ * MLA_H + 4 * (pn - 16) + (wc >> 1)) * NCHK + (sq_ >> 6)) * 16 + (2 + (wc & 1)) * 4 + ((sq_ >> 4) & 3)) * 512 + (sq_ & 15) * 32 + 8 * fq;
#pragma unroll
                    for (int bj = 0; bj < 2; ++bj) { const f32x4 v0 = acc[ai][bj][m][0] * rs, v1 = acc[ai][bj][m][1] * rs;
                        u32x4 w; w.x = cvt_pk_bf16(v0[0], v0[1]); w.y = cvt_pk_bf16(v0[2], v0[3]); w.z = cvt_pk_bf16(v1[0], v1[1]); w.w = cvt_pk_bf16(v1[2], v1[3]);
                        if (!nostore) *(u32x4*)(rowp + (size_t)bj * (2 * NCHK * 16 * 512)) = w; } }
                asm volatile("" ::: "memory"); }
            asm volatile("s_waitcnt lgkmcnt(0)" ::: "memory"); __builtin_amdgcn_s_barrier(); asm volatile("" ::: "memory");
            return;
        }
        const bool isq = pn < 8; const int h = isq ? pn : pn - 8;
        const float invn = isq ? 1.0f / QLORA : 1.0f / KVLORA;
        LAS float* RS = P + 1024; LAS int* POS = (LAS int*)(P + 1280);
#pragma unroll
        for (int ai = 0; ai < 2; ++ai) { f32x4 s4[4];
#pragma unroll
            for (int m = 0; m < 4; ++m) s4[m] = *(const LAS f32x4*)(SS4 + (ai * HALF + wr * 64 + m * 16 + fr) * 4);
#pragma unroll
            for (int m = 0; m < 4; ++m) { const float rs = rsqrtf(((s4[m][0] + s4[m][1]) + (s4[m][2] + s4[m][3])) * invn + EPS) * iscale, rr = isq ? rs : iscale;
                const f32x4 a0 = acc[ai][0][m][0], a1 = acc[ai][0][m][1], b0 = acc[ai][1][m][0], b1 = acc[ai][1][m][1];
                float p = (((a0[0] * a0[0] + a0[1] * a0[1]) + (a0[2] * a0[2] + a0[3] * a0[3])) + ((a1[0] * a1[0] + a1[1] * a1[1]) + (a1[2] * a1[2] + a1[3] * a1[3]))) * (rs * rs)
                        + (((b0[0] * b0[0] + b0[1] * b0[1]) + (b0[2] * b0[2] + b0[3] * b0[3])) + ((b1[0] * b1[0] + b1[1] * b1[1]) + (b1[2] * b1[2] + b1[3] * b1[3]))) * ((isq || wc < 2) ? rr * rr : 0.0f);
                p = sum_x16_x32(p);
                const int rl = ai * HALF + wr * 64 + m * 16 + fr;
                if (fq == 0) { P[rl * 4 + wc] = p; if (wc == 0) RS[rl] = rs; } }
            asm volatile("" ::: "memory"); }
        asm volatile("s_waitcnt lgkmcnt(0)" ::: "memory"); __builtin_amdgcn_s_barrier(); asm volatile("" ::: "memory");
        f32x4 gn[2], g1, g2;
        const LAS float* GL = SS4 + 1024 + (isq ? 0 : 192);
#pragma unroll
        for (int n = 0; n < 2; ++n) gn[n] = *(const LAS f32x4*)(GL + wc * 32 + 8 * fq + 4 * n);
        const int ib = (wc & 1) * 16 + 4 * fq;
        g1 = *(const LAS f32x4*)(GL + NOPE + ib); g2 = *(const LAS f32x4*)(GL + NOPE + 32 + ib);
        f32x2 gp[4];
#pragma unroll
        for (int j = 0; j < 4; ++j) { gp[j] = (f32x2){g1[j], g2[j]}; asm volatile("" : "+v"(gp[j])); }
        float irev[4];
#pragma unroll
        for (int j = 0; j < 4; ++j) irev[j] = __builtin_amdgcn_exp2f(-(float)(ib + j) * (13.287712379549449f / 32.0f)) * 0.15915494309189535f;
        bf16_t* Ob = QN + (isq ? (size_t)0 : kn_off) + h * QKD;
#pragma unroll
        for (int ai = 0; ai < 2; ++ai)
#pragma unroll
            for (int m = 0; m < 4; ++m) { const int rl = ai * HALF + wr * 64 + m * 16 + fr, row = u.pm * BM + rl; const f32x4 p4 = *(const LAS f32x4*)(P + rl * 4);
                const float rs = RS[rl];
                const float rinv = rsqrtf(((p4[0] + p4[1]) + (p4[2] + p4[3])) * (1.0f / QKD) + EPS), fn = rs * rinv, fr_ = (isq ? rs : iscale) * rinv;
                const int sq_ = row & (SEQ - 1); bf16_t* kt_ = QN + kn_off + ((size_t)((row >> 11) * MLA_H + h) * NCHK + (sq_ >> 6)) * (24 * 512) + (sq_ & 63) * 8;
                bf16_t* rowp = Ob + (size_t)row * (MLA_H * QKD);
                { const f32x4 v0 = acc[ai][0][m][0] * fn * gn[0], v1 = acc[ai][0][m][1] * fn * gn[1];
                  u32x4 w; w.x = cvt_pk_bf16(v0[0], v0[1]); w.y = cvt_pk_bf16(v0[2], v0[3]); w.z = cvt_pk_bf16(v1[0], v1[1]); w.w = cvt_pk_bf16(v1[2], v1[3]);
                  if (!nostore) { if (isq) *(u32x4*)(rowp + wc * 32 + 8 * fq) = w; else *(u32x4*)(kt_ + (4 * wc + fq) * 512) = w; } }
                if (!isq && wc >= 2) {
                    const f32x4 v0 = acc[ai][1][m][0] * rs, v1 = acc[ai][1][m][1] * rs;
                    u32x4 w; w.x = cvt_pk_bf16(v0[0], v0[1]); w.y = cvt_pk_bf16(v0[2], v0[3]); w.z = cvt_pk_bf16(v1[0], v1[1]); w.w = cvt_pk_bf16(v1[2], v1[3]);
                    if (!nostore) *(u32x4*)(VM + ((size_t)(((row >> 11) * MLA_H + h) * NCHK + (sq_ >> 6)) * 16 + (wc - 2) * 4 + ((sq_ >> 4) & 3)) * 512 + (sq_ & 15) * 32 + 8 * fq) = w; }
                if (wc < 2) { const float pos = (float)POS[rl]; float cs_[4], sn_[4];
#pragma unroll
                    for (int j = 0; j < 4; ++j) { const float rev = __builtin_amdgcn_fractf(pos * irev[j]); cs_[j] = __builtin_amdgcn_cosf(rev); sn_[j] = __builtin_amdgcn_sinf(rev); }
                    const f32x4 b0 = acc[ai][1][m][0], b1 = acc[ai][1][m][1];
                    f32x2 ro[4];
#pragma unroll
                    for (int j = 0; j < 4; ++j) { const f32x2 xy = (j == 0 ? (f32x2){b0[0], b0[1]} : j == 1 ? (f32x2){b0[2], b0[3]} : j == 2 ? (f32x2){b1[0], b1[1]} : (f32x2){b1[2], b1[3]}) * gp[j];
                        const float cf = cs_[j] * fr_, sf = sn_[j] * fr_;
                        ro[j] = xy * (f32x2){cf, cf} + (f32x2){xy.y, xy.x} * (f32x2){-sf, sf}; }
                    u32x2 o1, o2;
                    o1.x = cvt_pk_bf16(ro[0].x, ro[1].x); o1.y = cvt_pk_bf16(ro[2].x, ro[3].x);
                    o2.x = cvt_pk_bf16(ro[0].y, ro[1].y); o2.y = cvt_pk_bf16(ro[2].y, ro[3].y);
                    if (nostore) {} else if (isq) { *(u32x2*)(rowp + NOPE + ib) = o1; *(u32x2*)(rowp + NOPE + 32 + ib) = o2; }
                    else { bf16_t* kr_ = kt_ + (16 + 2 * wc + (fq >> 1)) * 512 + 4 * (fq & 1); *(u32x2*)kr_ = o1; *(u32x2*)(kr_ + 4 * 512) = o2; } }
            }
    }
};
struct MlaOrder {
    DenseOrder d;
    __device__ __forceinline__ bool next(int i, Unit& u) const { return d.next(i, u); }
    __device__ __forceinline__ const char* a_base(const Gemm& g, const Unit& u) const { return g.A + (size_t)u.pm * 256 * g.lda * g.es + (u.pn >= 8 ? 256 * g.es : 0); }
    __device__ __forceinline__ const char* b_base(const Gemm& g, const Unit& u) const { return g.Bt + (size_t)u.pn * 256 * g.ldb * g.es; }
    __device__ __forceinline__ const int* toklist(const Unit&) const { return nullptr; }
    __device__ __forceinline__ LAS unsigned* ofs() const { return nullptr; }
};
struct EpiQkvNorm {
    static constexpr bool PERM = true, PREFETCH = true;
    LAS float* P; LAS float* GL;
    __device__ __forceinline__ void prefetch(const Unit& u, int wid, int lane) const {
        if (wid < 4) glds16_s((unsigned)lane * 16u, (const char*)(ss + (size_t)(u.pm * BM + wid * 64) * 4), (unsigned)__builtin_amdgcn_readfirstlane((int)(unsigned)(uintptr_t)P) + (unsigned)wid * 1024u); }
    bf16_t* Q; size_t sect_stride; const float *gq, *gk; const float* ss; float iscale = 1.0f;
    __device__ __forceinline__ void operator()(const f32x4 (&acc)[2][2][4][2], const Unit& u, int wr, int wc, int fr, int fq) const {
        const int sect = u.pn >> 2, head = 4 * (u.pn & 3) + wc;
        bf16_t* O = Q + (size_t)sect * sect_stride + head * 64 + 8 * fq;
        f32x4 g[2][2], ga[2][2], gb[2][2];
#pragma unroll
        for (int bj = 0; bj < 2; ++bj)
#pragma unroll
            for (int n = 0; n < 2; ++n) { ga[bj][n] = *(const LAS f32x4*)(GL + 8 * fq + 32 * bj + 4 * n); gb[bj][n] = *(const LAS f32x4*)(GL + 192 + 8 * fq + 32 * bj + 4 * n); }
        const int row0 = u.pm * BM + wr * 64 + fr;
        float rs8[8];
#pragma unroll
        for (int r8 = 0; r8 < 8; ++r8) { const f32x4 s4 = *(const LAS f32x4*)(P + ((r8 >> 2) * HALF + wr * 64 + (r8 & 3) * 16 + fr) * 4); rs8[r8] = rsqrtf(((s4[0] + s4[1]) + (s4[2] + s4[3])) * (1.0f / DM) + EPS) * iscale; }
#pragma unroll
        for (int bj = 0; bj < 2; ++bj)
#pragma unroll
            for (int n = 0; n < 2; ++n) g[bj][n] = sect == 0 ? ga[bj][n] : (sect == 1 ? gb[bj][n] : (f32x4){1.f, 1.f, 1.f, 1.f});
#pragma unroll
        for (int ai = 0; ai < 2; ++ai)
#pragma unroll
            for (int m = 0; m < 4; ++m) {
                float hs = 0.f;
#pragma unroll
                for (int bj = 0; bj < 2; ++bj)
#pragma unroll
                    for (int n = 0; n < 2; ++n) { const f32x4 x = acc[ai][bj][m][n]; hs += (x[0] * x[0] + x[1] * x[1]) + (x[2] * x[2] + x[3] * x[3]); }
                hs = sum_x16_x32(hs);
                const float rs = rs8[ai * 4 + m];
                const float rinv = sect < 2 ? rs * rsqrtf(hs * rs * rs * (1.0f / 64.0f) + EPS) : rs;
                const int row = row0 + ai * HALF + m * 16, sq_ = row & (SEQ - 1);
                bf16_t* rowp = O + (size_t)row * DM;
                bf16_t* tb_ = Q + (size_t)sect * sect_stride + ((size_t)((row >> 11) * CA_H + head) * NCHK + (sq_ >> 6)) * (8 * 512);
#pragma unroll
                for (int bj = 0; bj < 2; ++bj) { const f32x4 v0 = acc[ai][bj][m][0] * rinv * g[bj][0], v1 = acc[ai][bj][m][1] * rinv * g[bj][1];
                    u32x4 w; w.x = cvt_pk_bf16(v0[0], v0[1]); w.y = cvt_pk_bf16(v0[2], v0[3]); w.z = cvt_pk_bf16(v1[0], v1[1]); w.w = cvt_pk_bf16(v1[2], v1[3]);
                    if (sect == 0) st16(rowp + 32 * bj, w);
                    else if (sect == 1) st16(tb_ + (4 * bj + fq) * 512 + (sq_ & 63) * 8, w);
                    else st16(tb_ + (4 * bj + ((sq_ >> 4) & 3)) * 512 + (sq_ & 15) * 32 + 8 * fq, w); }
            }
    }
};

template <class Epi, class Sched, bool GATHER, bool FP8 = false>
__device__ __forceinline__ void gemm_phase(LAS unsigned char* lds, const int wid, const Gemm g, const Sched& S, const Epi& E) {
    const int wr = wid >> 2, wc = wid & 3;
    constexpr unsigned ES = FP8 ? 1u : 2u;
    const int K = g.K, nt = FP8 ? K / (2 * BK) : K / BK;
    int tid, fr, fq, aoff, boff; unsigned voffB[2], cvA0[2], cvA1[2];
#define PG8_LANE(SETA) do { unsigned z_ = 0u; asm volatile("" : "+v"(z_)); const int lane_ = (int)__builtin_amdgcn_mbcnt_hi(~0u, __builtin_amdgcn_mbcnt_lo(~0u, z_)); \
        tid = wid * 64 + lane_; fr = lane_ & 15; fq = lane_ >> 4; aoff = lds_byte(wr * 64 + fr, fq * 8); boff = lds_byte(wc * 32 + fr, fq * 8); \
        _Pragma("unroll") for (int i = 0; i < 2; ++i) { int R, C; stage_rc(tid * 16 + i * 8192, R, C); const int Rb = Epi::PERM ? ((R & ~31) + perm32(R & 31)) : R; \
            voffB[i] = (unsigned)(Rb * g.ldb) * ES + (unsigned)C * 2u; if (SETA) { cvA0[i] = (unsigned)(R * g.lda) * ES + (unsigned)C * 2u; cvA1[i] = cvA0[i]; } } } while (0)
    PG8_LANE(true);
    const size_t kstep = (size_t)(BK * 2);
    const size_t hstepB = (size_t)HALF * g.ldb * ES;
    const size_t hstepA = GATHER ? (size_t)0 : (size_t)HALF * g.lda * ES;
    const unsigned ldsw = (unsigned)wid * 1024u;
    const unsigned ldsbase = (unsigned)__builtin_amdgcn_readfirstlane((int)(unsigned)(uintptr_t)lds) + ldsw;
#define PG8_SA(b, h) (((b) * 2 + (h)) * HTB)
#define PG8_SB(b, h) ((4 + (b) * 2 + (h)) * HTB)
#define PG8_STAGE(bufoff, gbase, voff) do { if (KL_PROBE && g.probe == 2) break; _Pragma("unroll") for (int _i = 0; _i < 2; ++_i) { unsigned keep_; \
        asm volatile("s_mov_b32 %0, m0\n\ts_mov_b32 m0, %3\n\ts_nop 0\n\tglobal_load_lds_dwordx4 %1, %2\n\ts_mov_b32 m0, %0" \
                     : "=&s"(keep_) : "v"((voff)[_i]), "s"((const char*)(gbase)), "s"(ldsbase + (unsigned)((bufoff) + _i * 8192)) : "memory"); } } while (0)
#define PG8_LDA(dst, b, h) do { _Pragma("unroll") for (int m = 0; m < 4; ++m) _Pragma("unroll") for (int k = 0; k < 2; ++k) dst[m][k] = *(const LAS bf16x8*)(lds + PG8_SA(b, h) + aoff + m * 2048 + k * 1024); } while (0)
#define PG8_LDB(dst, b, h) do { _Pragma("unroll") for (int n = 0; n < 2; ++n) _Pragma("unroll") for (int k = 0; k < 2; ++k) dst[n][k] = *(const LAS bf16x8*)(lds + PG8_SB(b, h) + boff + n * 2048 + k * 1024); } while (0)
#define PG8_CAT(x0, x1) __builtin_shufflevector(__builtin_bit_cast(v4i_t, x0), __builtin_bit_cast(v4i_t, x1), 0, 1, 2, 3, 4, 5, 6, 7)
#define PG8_MMA(ai, bj, At, Bt) do { if (KL_PROBE && g.probe == 1) break; __builtin_amdgcn_s_setprio(1); if constexpr (FP8) { _Pragma("unroll") for (int m = 0; m < 4; ++m) _Pragma("unroll") for (int n = 0; n < 2; ++n) \
        asm("v_mfma_f32_16x16x128_f8f6f4 %0, %1, %2, %0" : "+v"(acc[ai][bj][m][n]) : "v"(PG8_CAT(Bt[n][0], Bt[n][1])), "v"(PG8_CAT(At[m][0], At[m][1]))); } else { \
        _Pragma("unroll") for (int m = 0; m < 4; ++m) _Pragma("unroll") for (int n = 0; n < 2; ++n) _Pragma("unroll") for (int k = 0; k < 2; ++k) \
        acc[ai][bj][m][n] = __builtin_amdgcn_mfma_f32_16x16x32_bf16(Bt[n][k], At[m][k], acc[ai][bj][m][n], 0, 0, 0); } __builtin_amdgcn_s_setprio(0); } while (0)
#define PG8_WAIT_V(n) asm volatile("s_waitcnt vmcnt(" #n ")" ::: "memory")
#define PG8_WAIT_L(n) asm volatile("s_waitcnt lgkmcnt(" #n ")" ::: "memory")
#define PG8_BAR __builtin_amdgcn_s_barrier()
#define PG8_SCHED __builtin_amdgcn_sched_barrier(0)
#define PG8_TOKC(x) ((unsigned)(x) < (unsigned)T_ ? (unsigned)(x) : 0u)
#define PG8_GOFF_G(u, o0, o1) do { const int* tl_ = S.toklist(u); _Pragma("unroll") for (int _i = 0; _i < 2; ++_i) { int R_, C_; stage_rc(tid * 16 + _i * 8192, R_, C_); \
        o0[_i] = PG8_TOKC(tl_[R_]) * (unsigned)g.lda * ES + (unsigned)C_ * 2u; o1[_i] = PG8_TOKC(tl_[HALF + R_]) * (unsigned)g.lda * ES + (unsigned)C_ * 2u; } } while (0)
#define PG8_GOFF_L(par, o0, o1) do { const LAS unsigned* tl_ = S.ofs() + (par) * 256; _Pragma("unroll") for (int _i = 0; _i < 2; ++_i) { int R_, C_; stage_rc(tid * 16 + _i * 8192, R_, C_); \
        o0[_i] = PG8_TOKC(tl_[R_]) * (unsigned)g.lda * ES + (unsigned)C_ * 2u; o1[_i] = PG8_TOKC(tl_[HALF + R_]) * (unsigned)g.lda * ES + (unsigned)C_ * 2u; } } while (0)
    Unit cur, nxt; int ui = 0;
    if (!S.next(0, cur)) return;
    f32x4 acc[2][2][4][2];
#pragma unroll
    for (int a = 0; a < 2; ++a)
#pragma unroll
        for (int b = 0; b < 2; ++b)
#pragma unroll
            for (int m = 0; m < 4; ++m)
#pragma unroll
                for (int n = 0; n < 2; ++n) acc[a][b][m][n] = (f32x4){0.f, 0.f, 0.f, 0.f};
    bf16x8 At[4][2], B0[2][2], B1[2][2];
    const char* cA = S.a_base(g, cur); const char* cB = S.b_base(g, cur);
    if constexpr (GATHER) { PG8_GOFF_G(cur, cvA0, cvA1); }
    PG8_STAGE(PG8_SB(0, 0), cB, voffB); PG8_STAGE(PG8_SB(0, 1), cB + hstepB, voffB); PG8_STAGE(PG8_SA(0, 0), cA, cvA0); PG8_STAGE(PG8_SA(0, 1), cA + hstepA, cvA1);
    if (wr == 1) PG8_BAR;
    PG8_WAIT_V(2); PG8_BAR;
    PG8_STAGE(PG8_SB(1, 0), cB + kstep, voffB); PG8_STAGE(PG8_SA(1, 0), cA + kstep, cvA0); PG8_STAGE(PG8_SB(1, 1), cB + hstepB + kstep, voffB);
    PG8_WAIT_V(6); PG8_BAR;
    for (;;) {
        const bool has_next = S.next(ui + 1, nxt);
        const char* nA = has_next ? S.a_base(g, nxt) : cA; const char* nB = has_next ? S.b_base(g, nxt) : cB;
        if constexpr (GATHER) { if (has_next && wid < 4) {
            unsigned keep_; const unsigned dst_ = (unsigned)__builtin_amdgcn_readfirstlane((int)(unsigned)(uintptr_t)S.ofs()) + (unsigned)(((ui + 1) & 1) * 1024 + wid * 256);
            asm volatile("s_mov_b32 %0, m0\n\ts_mov_b32 m0, %3\n\ts_nop 0\n\tglobal_load_lds_dword %1, %2\n\ts_mov_b32 m0, %0"
                         : "=&s"(keep_) : "v"((unsigned)tid * 4u), "s"((const char*)S.toklist(nxt)), "s"(dst_) : "memory"); } }
        for (int t = 0; t < nt; t += 2) {
            const bool last = (t == nt - 2);
            const char* a1 = cA + (size_t)(t + 1) * kstep;
            const char* a2 = last ? nA : cA + (size_t)(t + 2) * kstep; const char* b2 = last ? nB : cB + (size_t)(t + 2) * kstep;
            const char* a3 = a2 + kstep; const char* b3 = b2 + kstep;
            if constexpr (Epi::PREFETCH) { if (last) E.prefetch(cur, wid, tid & 63); }
            PG8_LDB(B0, 0, 0); PG8_LDB(B1, 0, 1); PG8_SCHED; PG8_LDA(At, 0, 0); PG8_STAGE(PG8_SA(1, 1), a1 + hstepA, cvA1);
            if constexpr (GATHER) { if (last && has_next) { PG8_GOFF_L((ui + 1) & 1, cvA0, cvA1); } }
            PG8_WAIT_V(8); PG8_WAIT_L(0); PG8_BAR; PG8_MMA(0, 0, At, B0); PG8_MMA(0, 1, At, B1); PG8_BAR; PG8_SCHED;
            PG8_LDA(At, 0, 1); PG8_STAGE(PG8_SB(0, 0), b2, voffB); PG8_STAGE(PG8_SB(0, 1), b2 + hstepB, voffB); PG8_STAGE(PG8_SA(0, 0), a2, cvA0);
            PG8_WAIT_V(8); PG8_WAIT_L(0); PG8_BAR; PG8_MMA(1, 0, At, B0); PG8_MMA(1, 1, At, B1); PG8_BAR; PG8_SCHED;
            PG8_LDB(B0, 1, 0); PG8_LDB(B1, 1, 1); PG8_SCHED; PG8_LDA(At, 1, 0); PG8_STAGE(PG8_SA(0, 1), a2 + hstepA, cvA1);
            PG8_WAIT_V(8); PG8_WAIT_L(0); PG8_BAR; PG8_MMA(0, 0, At, B0); PG8_MMA(0, 1, At, B1); PG8_BAR; PG8_SCHED;
            PG8_LDA(At, 1, 1); PG8_STAGE(PG8_SB(1, 0), b3, voffB); PG8_STAGE(PG8_SB(1, 1), b3 + hstepB, voffB); PG8_STAGE(PG8_SA(1, 0), a3, cvA0);
            PG8_WAIT_V(8); PG8_WAIT_L(0); PG8_BAR; PG8_MMA(1, 0, At, B0); PG8_MMA(1, 1, At, B1); PG8_BAR; PG8_SCHED;
        }
        if (wr == 0) PG8_BAR;
        if constexpr (FP8) asm volatile("s_nop 15\n\ts_nop 7" ::: "memory");
        E(acc, cur, wr, wc, fr, fq);
        if (!has_next) break;
        PG8_LANE(!GATHER);
#pragma unroll
        for (int a = 0; a < 2; ++a)
#pragma unroll
            for (int b = 0; b < 2; ++b)
#pragma unroll
                for (int m = 0; m < 4; ++m)
#pragma unroll
                    for (int n = 0; n < 2; ++n) acc[a][b][m][n] = (f32x4){0.f, 0.f, 0.f, 0.f};
        cur = nxt; cA = nA; cB = nB; ++ui;
        if (wr == 1) PG8_BAR;
    }
    PG8_WAIT_V(0);
    PG8_BAR;
#undef PG8_SA
#undef PG8_SB
#undef PG8_STAGE
#undef PG8_LDA
#undef PG8_LDB
#undef PG8_MMA
#undef PG8_CAT
#undef PG8_WAIT_V
#undef PG8_WAIT_L
#undef PG8_BAR
#undef PG8_SCHED
#undef PG8_LANE
#undef PG8_GOFF_G
#undef PG8_GOFF_L
#undef PG8_TOKC
}
}

struct Frame { LAS unsigned char* lds; int tid, lane, wave, vcu, G, gw, NGW; };

typedef float f32x4n __attribute__((ext_vector_type(4)));
template <bool DUAL, class RowFn, class WFn, class EpiFn>
__device__ __forceinline__ void naive_gemm(const Frame& F, int nRowTiles, int N, int K, const bf16_t* A, int lda, RowFn rowfn, WFn wfn, int ldb, EpiFn epi) {
    LAS bf16_t* sA = (LAS bf16_t*)F.lds; LAS bf16_t* sB1 = sA + 64 * 40; LAS bf16_t* sB2 = sB1 + 64 * 40;
    const int ntn = N / 64, tiles = nRowTiles * ntn, wm = F.wave & 1, wn = F.wave >> 1, l15 = F.lane & 15, quad = F.lane >> 4;
    for (int tile = F.vcu; tile < tiles; tile += F.G) {
        const int mt = tile / ntn, n0 = (tile % ntn) * 64;
        const float* B1; const float* B2; wfn(mt, B1, B2);
        const int ar = F.tid >> 3, ak = (F.tid & 7) * 4; const int srow = rowfn(mt * 64 + ar); const bf16_t* arow = A + (size_t)(srow < 0 ? 0 : srow) * lda + ak;
        f32x4n acc1[2] = {}, acc2[2] = {};
        for (int k0 = 0; k0 < K; k0 += 32) {
            *(LAS u32x2*)(sA + ar * 40 + ak) = *(const u32x2*)(arow + k0);
#pragma unroll
            for (int i = 0; i < 4; ++i) { const int idx = F.tid + 512 * i, k = idx >> 6, n = idx & 63;
                sB1[n * 40 + k] = (bf16_t)f2bf(B1[(size_t)(k0 + k) * ldb + n0 + n]);
                if (DUAL) sB2[n * 40 + k] = (bf16_t)f2bf(B2[(size_t)(k0 + k) * ldb + n0 + n]); }
            __syncthreads();
            const bf16x8 b1 = *(const LAS bf16x8*)(sB1 + (wn * 16 + l15) * 40 + quad * 8);
            bf16x8 b2 = b1; if (DUAL) b2 = *(const LAS bf16x8*)(sB2 + (wn * 16 + l15) * 40 + quad * 8);
#pragma unroll
            for (int mi = 0; mi < 2; ++mi) { const bf16x8 a = *(const LAS bf16x8*)(sA + (wm * 32 + mi * 16 + l15) * 40 + quad * 8);
                acc1[mi] = __builtin_amdgcn_mfma_f32_16x16x32_bf16(a, b1, acc1[mi], 0, 0, 0);
                if (DUAL) acc2[mi] = __builtin_amdgcn_mfma_f32_16x16x32_bf16(a, b2, acc2[mi], 0, 0, 0); }
            __syncthreads();
        }
#pragma unroll
        for (int mi = 0; mi < 2; ++mi)
#pragma unroll
            for (int j = 0; j < 4; ++j) { const int r = mt * 64 + wm * 32 + mi * 16 + quad * 4 + j, c = n0 + wn * 16 + l15;
                if (rowfn(r) >= 0) epi(r, c, acc1[mi][j], DUAL ? acc2[mi][j] : 0.f); }
    }
}

struct SrcBlk { const float* W; int ld; int col0; int mode; };
template <bool OUT8 = false, class Map>
__device__ __forceinline__ void conv_matrix(const Frame& F, const Map& map, int Ksrc, int Kd, int Nd, void* WTv, const float* kgain = nullptr, const float oscale = 1.0f) {
    bf16_t* WT = (bf16_t*)WTv; unsigned char* WT8 = (unsigned char*)WTv;
    LAS float* scr = (LAS float*)(F.lds + F.wave * 8704);
    const int nblk = Nd / 32, nitems = (Kd / 64) * nblk, lane = F.lane, lr = lane >> 3, lc = (lane & 7) * 4;
    f32x4 cur[8], nxt[8];
#define CONV_LOAD(item_, v_) do { const int kb_ = (item_) / nblk, nb_ = (item_) % nblk, k0_ = 64 * kb_; const SrcBlk sb_ = map(nb_); \
        _Pragma("unroll") for (int i_ = 0; i_ < 8; ++i_) { const int k_ = k0_ + lr + 8 * i_; \
            if (sb_.mode == 2) { const int c2_ = sb_.col0 + (lc >> 1); v_[i_] = (f32x4){k_ == c2_ ? 1.f : 0.f, k_ == c2_ + 32 ? 1.f : 0.f, k_ == c2_ + 1 ? 1.f : 0.f, k_ == c2_ + 33 ? 1.f : 0.f}; } \
            else { if (sb_.mode == 1) { f32x2 a_ = (f32x2){0.f, 0.f}, b_ = (f32x2){0.f, 0.f}; if (k_ < Ksrc) { const float* p_ = sb_.W + (size_t)k_ * sb_.ld + sb_.col0 + (lc >> 1); a_ = *(const f32x2*)p_; b_ = *(const f32x2*)(p_ + 32); } \
                    v_[i_] = (f32x4){a_.x, b_.x, a_.y, b_.y}; } \
                else v_[i_] = (sb_.W && k_ < Ksrc) ? *(const f32x4*)(sb_.W + (size_t)k_ * sb_.ld + sb_.col0 + lc) : (f32x4){0.f, 0.f, 0.f, 0.f}; \
                if (kgain) { const float g_ = k_ < Ksrc ? kgain[k_] : 0.f; v_[i_] *= g_; } } } } while (0)
    int item = F.gw;
    if (item < nitems) CONV_LOAD(item, cur);
    for (; item < nitems; item += F.NGW) {
        const int ni = item + F.NGW;
        if (ni < nitems) CONV_LOAD(ni, nxt);
        const int kb = item / nblk, nb = item % nblk, k0 = 64 * kb;
#pragma unroll
        for (int i = 0; i < 8; ++i)
#pragma unroll
            for (int j = 0; j < 4; ++j) scr[(lr + 8 * i) * 33 + lc + j] = cur[i][j];
        LDS_WAIT(); asm volatile("" ::: "memory");
        const int c = lane & 7;
#pragma unroll
        for (int j = 0; j < 4; ++j) { const int n = (lane >> 3) + 8 * j; const LAS float* sp = scr + (8 * c) * 33 + n;
            if constexpr (OUT8) { u32x2 o; o.x = pk4_fp8(sp[0 * 33] * oscale, sp[1 * 33] * oscale, sp[2 * 33] * oscale, sp[3 * 33] * oscale); o.y = pk4_fp8(sp[4 * 33] * oscale, sp[5 * 33] * oscale, sp[6 * 33] * oscale, sp[7 * 33] * oscale);
                *(u32x2*)(WT8 + (size_t)(nb * 32 + n) * Kd + k0 + 8 * c) = o; }
            else { u32x4 o; o.x = pk2(sp[0 * 33], sp[1 * 33]); o.y = pk2(sp[2 * 33], sp[3 * 33]); o.z = pk2(sp[4 * 33], sp[5 * 33]); o.w = pk2(sp[6 * 33], sp[7 * 33]);
                *(u32x4*)(WT + (size_t)(nb * 32 + n) * Kd + k0 + 8 * c) = o; } }
        LDS_WAIT(); asm volatile("" ::: "memory");
#pragma unroll
        for (int i = 0; i < 8; ++i) cur[i] = nxt[i];
    }
#undef CONV_LOAD
}
struct MapPlain { const float* W; int N;
    __device__ __forceinline__ SrcBlk operator()(int nb) const { SrcBlk s; s.W = (nb * 32 < N) ? W : nullptr; s.ld = N; s.col0 = nb * 32; s.mode = 0; return s; } };
struct MapGateUp { const float* Wg; const float* Wu; int N;
    __device__ __forceinline__ SrcBlk operator()(int nb) const { const int pn = nb >> 3, w = nb & 7; SrcBlk s; const uintptr_t m = (w < 4) ? (uintptr_t)0 : ~(uintptr_t)0; s.W = (const float*)(((uintptr_t)Wg & ~m) | ((uintptr_t)Wu & m)); s.ld = N; s.col0 = pn * 128 + (w & 3) * 32; s.mode = 0; return s; } };
struct MapQkvCA { const float* W;
    __device__ __forceinline__ SrcBlk operator()(int nb) const { const int pn = nb >> 3, blk = nb & 7, bj = blk >> 2, wc = blk & 3, sect = pn >> 2, t = pn & 3;
        SrcBlk s; s.W = W; s.ld = 3 * DM; s.col0 = sect * DM + (4 * t + wc) * 64 + 32 * bj; s.mode = 0; return s; } };

struct MapMlaQ { const float* W;
    __device__ __forceinline__ SrcBlk operator()(int nb) const { const int h = nb >> 3, blk = nb & 7; SrcBlk s; s.ld = MLA_H * QKD; s.W = blk < 6 ? W : nullptr;
        s.mode = (blk == 4 || blk == 5) ? 1 : 0; s.col0 = blk < 4 ? h * QKD + blk * 32 : h * QKD + NOPE + 16 * (blk & 1); return s; } };
struct MapMlaKV { const float* W;
    __device__ __forceinline__ SrcBlk operator()(int nb) const { const int tl = nb >> 3, blk = nb & 7; SrcBlk s; s.ld = MLA_H * 256; s.W = W; s.mode = 0;
        if (tl < 8) { if (blk < 4) s.col0 = tl * 256 + blk * 32; else if (blk < 6) { s.mode = 2; s.col0 = KVLORA + 16 * (blk - 4); } else s.col0 = tl * 256 + NOPE + (blk - 6) * 32; }
        else { const int hv = 4 * (tl - 8) + 2 * (blk >> 2) + ((blk & 3) >> 1); s.col0 = hv * 256 + NOPE + 64 + (blk & 1) * 32; }
        return s; } };

struct ConvSel { SrcBlk sb; int Ksrc, Kd, k0, nb, out8; const float* kgain; unsigned char* WT; float oscale; };
template <class Map>
__device__ __forceinline__ bool conv_pick1(ConvSel& c, int& item, const Map& map, int Ksrc, int Kd, int Nd, void* WT, const float* kgain, int out8, float oscale) {
    const int nblk = Nd / 32, nitems = (Kd / 64) * nblk;
    if (item < nitems) { const int kb = item / nblk; c.nb = item - kb * nblk; c.k0 = 64 * kb; c.sb = map(c.nb); c.Ksrc = Ksrc; c.Kd = Kd; c.out8 = out8; c.kgain = kgain; c.WT = (unsigned char*)WT; c.oscale = oscale; return true; }
    item -= nitems; return false;
}
__device__ __forceinline__ void conv_load(const ConvSel& c, f32x4 (&v)[8], int lr, int lc) {
#pragma unroll
    for (int i = 0; i < 8; ++i) { const int k = c.k0 + lr + 8 * i;
        if (c.sb.mode == 2) { const int c2 = c.sb.col0 + (lc >> 1); v[i] = (f32x4){k == c2 ? 1.f : 0.f, k == c2 + 32 ? 1.f : 0.f, k == c2 + 1 ? 1.f : 0.f, k == c2 + 33 ? 1.f : 0.f}; }
        else { if (c.sb.mode == 1) { f32x2 a = (f32x2){0.f, 0.f}, b = (f32x2){0.f, 0.f}; if (k < c.Ksrc) { const float* q = c.sb.W + (size_t)k * c.sb.ld + c.sb.col0 + (lc >> 1); a = *(const f32x2*)q; b = *(const f32x2*)(q + 32); }
                v[i] = (f32x4){a.x, b.x, a.y, b.y}; }
            else v[i] = (c.sb.W && k < c.Ksrc) ? *(const f32x4*)(c.sb.W + (size_t)k * c.sb.ld + c.sb.col0 + lc) : (f32x4){0.f, 0.f, 0.f, 0.f};
            if (c.kgain) { const float g = k < c.Ksrc ? c.kgain[k] : 0.f; v[i] *= g; } } }
}
__device__ __forceinline__ void conv_store(const ConvSel& c, const f32x4 (&cur)[8], LAS float* scr, int lane, int lr, int lc) {
#pragma unroll
    for (int i = 0; i < 8; ++i)
#pragma unroll
        for (int j = 0; j < 4; ++j) scr[(lr + 8 * i) * 33 + lc + j] = cur[i][j];
    LDS_WAIT(); asm volatile("" ::: "memory");
    const int cc = lane & 7; const float os = c.oscale;
#pragma unroll
    for (int j = 0; j < 4; ++j) { const int n = (lane >> 3) + 8 * j; const LAS float* sp = scr + (8 * cc) * 33 + n;
        if (c.out8) { u32x2 o; o.x = pk4_fp8(sp[0 * 33] * os, sp[1 * 33] * os, sp[2 * 33] * os, sp[3 * 33] * os); o.y = pk4_fp8(sp[4 * 33] * os, sp[5 * 33] * os, sp[6 * 33] * os, sp[7 * 33] * os);
            *(u32x2*)(c.WT + (size_t)(c.nb * 32 + n) * c.Kd + c.k0 + 8 * cc) = o; }
        else { u32x4 o; o.x = pk2(sp[0 * 33], sp[1 * 33]); o.y = pk2(sp[2 * 33], sp[3 * 33]); o.z = pk2(sp[4 * 33], sp[5 * 33]); o.w = pk2(sp[6 * 33], sp[7 * 33]);
            *(u32x4*)((bf16_t*)c.WT + (size_t)(c.nb * 32 + n) * c.Kd + c.k0 + 8 * cc) = o; } }
    LDS_WAIT(); asm volatile("" ::: "memory");
}
struct EvenConv { const float *w_in, *w_uq, *qa, *w_ukv, *kva, *w_o, *wg, *wu, *ffn_norm, *wd; unsigned char* Wb; int up8, ao8, ffn8, in8; const float* attn_norm; };
__device__ __forceinline__ bool even_pick(const EvenConv& e, ConvSel& c, int item) {
    return conv_pick1(c, item, MapGateUp{e.wg, e.wu, FF}, DM, DM, 2 * FF, e.Wb + WE_GU, e.ffn_norm, e.ffn8, e.ffn8 ? 256.0f : 1.0f)
        || conv_pick1(c, item, MapPlain{e.wd, DM}, FF, FF, DM, e.Wb + WE_D, nullptr, e.ffn8, e.ffn8 ? 256.0f : 1.0f)
        || conv_pick1(c, item, MapPlain{e.w_o, DM}, DM, DM, DM, e.Wb + WE_O, nullptr, e.ao8, e.ao8 ? 256.0f : 1.0f)
        || conv_pick1(c, item, MapPlain{e.w_in, AIN}, DM, DM, AINP, e.Wb + WE_IN, e.attn_norm, e.in8, e.in8 ? 256.0f : 1.0f)
        || conv_pick1(c, item, MapMlaQ{e.w_uq}, QLORA, QLORA, MLA_H * 256, e.Wb + WE_QKVF, e.qa, e.up8, e.up8 ? 256.0f : 1.0f)
        || conv_pick1(c, item, MapMlaKV{e.w_ukv}, KVLORA, 256, 10 * 256, e.Wb + WE_QKVF + (size_t)MLA_H * 256 * 256 * (e.up8 ? 1 : 2), e.kva, e.up8, e.up8 ? 256.0f : 1.0f);
}
__device__ __forceinline__ void conv_even(const Frame& F, const EvenConv& e) {
    constexpr int TOTAL = (DM / 64) * (2 * FF / 32) + (FF / 64) * (DM / 32) + (DM / 64) * (DM / 32) + (DM / 64) * (AINP / 32) + (QLORA / 64) * (MLA_H * 256 / 32) + (256 / 64) * (10 * 256 / 32);
    LAS float* scr = (LAS float*)(F.lds + F.wave * 8704);
    const int lane = F.lane, lr = lane >> 3, lc = (lane & 7) * 4;
    f32x4 cur[8], nxt[8]; ConvSel cc, cn;
    int item = F.gw;
    if (item >= TOTAL) return;
    even_pick(e, cc, item); conv_load(cc, cur, lr, lc);
    for (; item < TOTAL; item += F.NGW) {
        const int ni = item + F.NGW < TOTAL ? item + F.NGW : TOTAL - 1;
        even_pick(e, cn, ni); conv_load(cn, nxt, lr, lc);
        conv_store(cc, cur, scr, lane, lr, lc);
#pragma unroll
        for (int i = 0; i < 8; ++i) cur[i] = nxt[i];
        cc = cn;
    }
}

__device__ __forceinline__ void rope_table(const Frame& F, const int* positions, f32x2* CS) {
    for (int idx = F.gw * 64 + F.lane; idx < T_ * 32; idx += F.NGW * 64) { const int t = idx >> 5, i = idx & 31;
        const float inv = exp2f(-(float)i * (13.287712379549449f / 32.0f)); float sn, cs; sincosf((float)positions[t] * inv, &sn, &cs); CS[idx] = (f32x2){cs, sn}; }
}
struct MoeCombine { const int* re; const int* rp; const float* rw; const bf16_t* Y; pg8::MoeInfo mi; };
struct NormRowData { f32x4 x[4]; u32x2 y0[4], y1[4]; float w0, w1; };
template <bool COMBINE>
__device__ __forceinline__ void norm_row_load(NormRowData& d, const float* src, int t, int lane, const MoeCombine& mc, int e0, int e1, int p0, int p1, float w0, float w1) {
    const f32x4* xr = (const f32x4*)(src + (size_t)t * DM) + lane;
#pragma unroll
    for (int j = 0; j < 4; ++j) d.x[j] = xr[64 * j];
    if constexpr (COMBINE) {
        const size_t r0 = (size_t)mc.mi.start_of(e0) * 256 + p0, r1 = (size_t)mc.mi.start_of(e1) * 256 + p1;
        const u32x2* y0 = (const u32x2*)(mc.Y + r0 * DM) + lane; const u32x2* y1 = (const u32x2*)(mc.Y + r1 * DM) + lane;
#pragma unroll
        for (int j = 0; j < 4; ++j) { d.y0[j] = y0[64 * j]; d.y1[j] = y1[64 * j]; }
        d.w0 = w0; d.w1 = w1;
    }
}
template <bool COMBINE, bool WRITE_X, bool WRITE_H, bool OUT8 = false>
__device__ __forceinline__ void norm_rows(const Frame& F, const float* src, float* X, const float* gain, bf16_t* H, const MoeCombine& mc) {
    const int lane = F.lane;
    f32x4 gl[4];
    if constexpr (WRITE_H) {
#pragma unroll
        for (int j = 0; j < 4; ++j) gl[j] = ((const f32x4*)gain)[lane + 64 * j]; }
    NormRowData d, dn;
    int e0n = 0, e1n = 0, p0n = 0, p1n = 0; float w0n = 0.f, w1n = 0.f;
    int t = F.gw;
    if (t < T_) { int e0 = 0, e1 = 0, p0 = 0, p1 = 0; float w0 = 0.f, w1 = 0.f;
        if constexpr (COMBINE) { e0 = mc.re[2 * t]; e1 = mc.re[2 * t + 1]; p0 = mc.rp[2 * t]; p1 = mc.rp[2 * t + 1]; w0 = mc.rw[2 * t]; w1 = mc.rw[2 * t + 1]; }
        norm_row_load<COMBINE>(d, src, t, lane, mc, e0, e1, p0, p1, w0, w1);
        const int t1 = t + F.NGW < T_ ? t + F.NGW : T_ - 1;
        if constexpr (COMBINE) { e0n = mc.re[2 * t1]; e1n = mc.re[2 * t1 + 1]; p0n = mc.rp[2 * t1]; p1n = mc.rp[2 * t1 + 1]; w0n = mc.rw[2 * t1]; w1n = mc.rw[2 * t1 + 1]; } }
    for (; t < T_; t += F.NGW) {
        const int t1 = t + F.NGW, t2 = t1 + F.NGW;
        if (t1 < T_) norm_row_load<COMBINE>(dn, src, t1, lane, mc, e0n, e1n, p0n, p1n, w0n, w1n);
        if constexpr (COMBINE) if (t2 < T_) { e0n = mc.re[2 * t2]; e1n = mc.re[2 * t2 + 1]; p0n = mc.rp[2 * t2]; p1n = mc.rp[2 * t2 + 1]; w0n = mc.rw[2 * t2]; w1n = mc.rw[2 * t2 + 1]; }
        f32x4 v[4];
#pragma unroll
        for (int j = 0; j < 4; ++j) v[j] = d.x[j];
        if constexpr (COMBINE) { const float w0 = d.w0, w1 = d.w1;
#pragma unroll
            for (int j = 0; j < 4; ++j) { const u32x2 a = d.y0[j], b = d.y1[j];
                v[j][0] += w0 * bf2f(a.x & 0xffffu) + w1 * bf2f(b.x & 0xffffu); v[j][1] += w0 * bf2f(a.x >> 16) + w1 * bf2f(b.x >> 16);
                v[j][2] += w0 * bf2f(a.y & 0xffffu) + w1 * bf2f(b.y & 0xffffu); v[j][3] += w0 * bf2f(a.y >> 16) + w1 * bf2f(b.y >> 16); } }
        if constexpr (WRITE_X) { f32x4* xo = (f32x4*)(X + (size_t)t * DM) + lane;
#pragma unroll
            for (int j = 0; j < 4; ++j) xo[64 * j] = v[j]; }
        if constexpr (WRITE_H) {
            float s = 0.f;
#pragma unroll
            for (int j = 0; j < 4; ++j) s += (v[j][0] * v[j][0] + v[j][1] * v[j][1]) + (v[j][2] * v[j][2] + v[j][3] * v[j][3]);
            const float rstd = rsqrtf(wave_sum(s) * (1.0f / DM) + EPS);
            u32x2* ho = (u32x2*)(H + (size_t)t * DM) + lane;
#pragma unroll
            for (int j = 0; j < 4; ++j) { const f32x4 g = gl[j];
                if constexpr (OUT8) { const float r16 = rstd * 16.0f; ((unsigned*)((unsigned char*)H + (size_t)t * DM) + lane)[64 * j] = pk4_fp8(v[j][0] * r16 * g[0], v[j][1] * r16 * g[1], v[j][2] * r16 * g[2], v[j][3] * r16 * g[3]); }
                else { u32x2 o; o.x = cvt_pk_bf16(v[j][0] * rstd * g[0], v[j][1] * rstd * g[1]); o.y = cvt_pk_bf16(v[j][2] * rstd * g[2], v[j][3] * rstd * g[3]); ho[64 * j] = o; } }
        }
        d = dn;
    }
}
struct ResRowData { f32x4 x[4]; u32x2 y0[4], y1[4]; float w0, w1; };
template <bool SRC16, bool COMBINE>
__device__ __forceinline__ void res_row_load(ResRowData& d, const void* src, int t, int lane, const MoeCombine& mc, int e0, int e1, int p0, int p1, float w0, float w1) {
    if constexpr (SRC16) { const u32x2* xr = (const u32x2*)((const bf16_t*)src + (size_t)t * DM) + lane;
#pragma unroll
        for (int j = 0; j < 4; ++j) { const u32x2 a = xr[64 * j]; d.x[j] = (f32x4){bf2f(a.x & 0xffffu), bf2f(a.x >> 16), bf2f(a.y & 0xffffu), bf2f(a.y >> 16)}; } }
    else { const f32x4* xr = (const f32x4*)((const float*)src + (size_t)t * DM) + lane;
#pragma unroll
        for (int j = 0; j < 4; ++j) d.x[j] = xr[64 * j]; }
    if constexpr (COMBINE) {
        const size_t r0 = (size_t)mc.mi.start_of(e0) * 256 + p0, r1 = (size_t)mc.mi.start_of(e1) * 256 + p1;
        const u32x2* y0 = (const u32x2*)(mc.Y + r0 * DM) + lane; const u32x2* y1 = (const u32x2*)(mc.Y + r1 * DM) + lane;
#pragma unroll
        for (int j = 0; j < 4; ++j) { d.y0[j] = y0[64 * j]; d.y1[j] = y1[64 * j]; }
        d.w0 = w0; d.w1 = w1;
    }
}
template <bool SRC16, bool COMBINE, bool WRITE_XB, bool WRITE_H, bool WRITE_F32>
__device__ __forceinline__ void res_rows(const Frame& F, const void* src, bf16_t* XB, const float* gain, bf16_t* H, float* OUT, const MoeCombine& mc, const bool h8 = false, float* ssout = nullptr) {
    const int lane = F.lane; float keep_s = 0.f; int irow = 0;
    f32x4 gl[4];
    if constexpr (WRITE_H) {
#pragma unroll
        for (int j = 0; j < 4; ++j) gl[j] = ((const f32x4*)gain)[lane + 64 * j]; }
    ResRowData d, dn;
    int e0n = 0, e1n = 0, p0n = 0, p1n = 0; float w0n = 0.f, w1n = 0.f;
    int t = F.gw;
    if (t < T_) { int e0 = 0, e1 = 0, p0 = 0, p1 = 0; float w0 = 0.f, w1 = 0.f;
        if constexpr (COMBINE) { e0 = mc.re[2 * t]; e1 = mc.re[2 * t + 1]; p0 = mc.rp[2 * t]; p1 = mc.rp[2 * t + 1]; w0 = mc.rw[2 * t]; w1 = mc.rw[2 * t + 1]; }
        res_row_load<SRC16, COMBINE>(d, src, t, lane, mc, e0, e1, p0, p1, w0, w1);
        const int t1 = t + F.NGW < T_ ? t + F.NGW : T_ - 1;
        if constexpr (COMBINE) { e0n = mc.re[2 * t1]; e1n = mc.re[2 * t1 + 1]; p0n = mc.rp[2 * t1]; p1n = mc.rp[2 * t1 + 1]; w0n = mc.rw[2 * t1]; w1n = mc.rw[2 * t1 + 1]; } }
    for (; t < T_; t += F.NGW) {
        const int t1 = t + F.NGW < T_ ? t + F.NGW : T_ - 1, t2 = t + 2 * F.NGW < T_ ? t + 2 * F.NGW : T_ - 1;
        res_row_load<SRC16, COMBINE>(dn, src, t1, lane, mc, e0n, e1n, p0n, p1n, w0n, w1n);
        if constexpr (COMBINE) { e0n = mc.re[2 * t2]; e1n = mc.re[2 * t2 + 1]; p0n = mc.rp[2 * t2]; p1n = mc.rp[2 * t2 + 1]; w0n = mc.rw[2 * t2]; w1n = mc.rw[2 * t2 + 1]; }
        f32x4 v[4];
#pragma unroll
        for (int j = 0; j < 4; ++j) v[j] = d.x[j];
        if constexpr (COMBINE) { const float w0 = d.w0, w1 = d.w1;
#pragma unroll
            for (int j = 0; j < 4; ++j) { const u32x2 a = d.y0[j], b = d.y1[j];
                v[j][0] += w0 * bf2f(a.x & 0xffffu) + w1 * bf2f(b.x & 0xffffu); v[j][1] += w0 * bf2f(a.x >> 16) + w1 * bf2f(b.x >> 16);
                v[j][2] += w0 * bf2f(a.y & 0xffffu) + w1 * bf2f(b.y & 0xffffu); v[j][3] += w0 * bf2f(a.y >> 16) + w1 * bf2f(b.y >> 16); } }
        if constexpr (WRITE_F32) { f32x4* xo = (f32x4*)(OUT + (size_t)t * DM) + lane;
#pragma unroll
            for (int j = 0; j < 4; ++j) xo[64 * j] = v[j]; }
        if constexpr (WRITE_XB) { u32x2* xo = (u32x2*)(XB + (size_t)t * DM) + lane;
#pragma unroll
            for (int j = 0; j < 4; ++j) { u32x2 o; o.x = cvt_pk_bf16(v[j][0], v[j][1]); o.y = cvt_pk_bf16(v[j][2], v[j][3]); xo[64 * j] = o; } }
        if constexpr (WRITE_XB && !WRITE_H) { if (ssout) {
            float s = 0.f;
#pragma unroll
            for (int j = 0; j < 4; ++j) s += (v[j][0] * v[j][0] + v[j][1] * v[j][1]) + (v[j][2] * v[j][2] + v[j][3] * v[j][3]);
            s = wave_sum(s); keep_s = lane == irow ? s : keep_s; } }
        ++irow;
        if constexpr (WRITE_H) {
            float s = 0.f;
#pragma unroll
            for (int j = 0; j < 4; ++j) s += (v[j][0] * v[j][0] + v[j][1] * v[j][1]) + (v[j][2] * v[j][2] + v[j][3] * v[j][3]);
            const float rstd = rsqrtf(wave_sum(s) * (1.0f / DM) + EPS);
            if (h8) { const float r16 = rstd * 16.0f; unsigned* ho8 = (unsigned*)((unsigned char*)H + (size_t)t * DM) + lane;
#pragma unroll
                for (int j = 0; j < 4; ++j) { const f32x4 g = gl[j]; ho8[64 * j] = pk4_fp8(v[j][0] * r16 * g[0], v[j][1] * r16 * g[1], v[j][2] * r16 * g[2], v[j][3] * r16 * g[3]); } }
            else { u32x2* ho = (u32x2*)(H + (size_t)t * DM) + lane;
#pragma unroll
            for (int j = 0; j < 4; ++j) { const f32x4 g = gl[j]; u32x2 o; o.x = cvt_pk_bf16(v[j][0] * rstd * g[0], v[j][1] * rstd * g[1]); o.y = cvt_pk_bf16(v[j][2] * rstd * g[2], v[j][3] * rstd * g[3]); ho[64 * j] = o; } }
        }
        d = dn;
    }
    if constexpr (WRITE_XB && !WRITE_H) { if (ssout && lane < irow) *(f32x4*)(ssout + (size_t)(F.gw + lane * F.NGW) * 4) = (f32x4){keep_s, 0.f, 0.f, 0.f}; }
}
struct MlaTok { u32x2 aq, akv, qraw[MLA_H], kraw[MLA_H], vraw[MLA_H]; float pos; };
__device__ __forceinline__ void mla_tok_load(MlaTok& d, int t, int lane, const bf16_t* Qraw, const bf16_t* KVraw, const bf16_t* A1, const int* positions) {
    const u32x2* ap = (const u32x2*)(A1 + (size_t)t * AINP) + lane;
    d.aq = ap[0]; d.akv = (u32x2){0u, 0u}; if (lane < 48) d.akv = ap[64];
    d.pos = (float)positions[t];
#pragma unroll
    for (int h = 0; h < MLA_H; ++h) { d.qraw[h] = (u32x2){0u, 0u}; d.kraw[h] = (u32x2){0u, 0u}; d.vraw[h] = (u32x2){0u, 0u};
        if (lane < 48) d.qraw[h] = *((const u32x2*)(Qraw + (size_t)t * 1536 + h * QKD) + lane);
        if (lane < 32) { d.kraw[h] = *((const u32x2*)(KVraw + (size_t)t * 2048 + h * 256) + lane); d.vraw[h] = *((const u32x2*)(KVraw + (size_t)t * 2048 + h * 256 + 128) + lane); } }
}
__device__ __forceinline__ void mla_qk_norm_rope(const Frame& F, const bf16_t* Qraw, bf16_t* KVraw, const bf16_t* A1, const int* positions, const float* gq, const float* gk, bf16_t* QN, bf16_t* KN) {
    const int lane = F.lane; const bool act = lane < 48, isrope = lane >= 32 && lane < 48, second = lane >= 40;
    const f32x4 gql = act ? ((const f32x4*)gq)[lane] : (f32x4){0.f, 0.f, 0.f, 0.f};
    const f32x4 gkl = act ? ((const f32x4*)gk)[lane] : (f32x4){0.f, 0.f, 0.f, 0.f};
    float invf[4];
#pragma unroll
    for (int j = 0; j < 4; ++j) invf[j] = exp2f(-(float)(4 * (lane & 7) + j) * (13.287712379549449f / 32.0f));
    MlaTok d, dn;
    int t = F.gw;
    if (t < T_) mla_tok_load(d, t, lane, Qraw, KVraw, A1, positions);
    for (; t < T_; t += F.NGW) {
        const int tn = t + F.NGW;
        if (tn < T_) mla_tok_load(dn, tn, lane, Qraw, KVraw, A1, positions);
        float cs[4], sn[4];
#pragma unroll
        for (int j = 0; j < 4; ++j) sincosf(d.pos * invf[j], &sn[j], &cs[j]);
        const u32x2 kr = d.akv;
        float rq, rkv;
        { const float q0 = bf2f(d.aq.x & 0xffffu), q1 = bf2f(d.aq.x >> 16), q2 = bf2f(d.aq.y & 0xffffu), q3 = bf2f(d.aq.y >> 16);
          const float k0 = bf2f(d.akv.x & 0xffffu), k1 = bf2f(d.akv.x >> 16), k2 = bf2f(d.akv.y & 0xffffu), k3 = bf2f(d.akv.y >> 16);
          rq = rsqrtf(wave_sum((q0 * q0 + q1 * q1) + (q2 * q2 + q3 * q3)) * (1.0f / QLORA) + EPS);
          rkv = rsqrtf(wave_sum(lane < 32 ? (k0 * k0 + k1 * k1) + (k2 * k2 + k3 * k3) : 0.f) * (1.0f / KVLORA) + EPS); }
#pragma unroll
        for (int h = 0; h < MLA_H; ++h) {
#pragma unroll
            for (int qk = 0; qk < 2; ++qk) {
                const u32x2 raw = qk == 0 ? d.qraw[h] : (lane < 32 ? d.kraw[h] : kr);
                const float sc = qk == 0 ? rq : (lane < 32 ? rkv : 1.0f);
                float v[4] = {bf2f(raw.x & 0xffffu) * sc, bf2f(raw.x >> 16) * sc, bf2f(raw.y & 0xffffu) * sc, bf2f(raw.y >> 16) * sc};
                const float ss = wave_sum(act ? (v[0] * v[0] + v[1] * v[1]) + (v[2] * v[2] + v[3] * v[3]) : 0.f);
                const float rinv = rsqrtf(ss * (1.0f / QKD) + EPS); const f32x4 g = qk == 0 ? gql : gkl;
                float y[4], o[4];
#pragma unroll
                for (int j = 0; j < 4; ++j) y[j] = v[j] * rinv * g[j];
#pragma unroll
                for (int j = 0; j < 4; ++j) { const float pr = __shfl_xor(y[j], 8);
                    o[j] = isrope ? (second ? (pr * sn[j] + y[j] * cs[j]) : (y[j] * cs[j] - pr * sn[j])) : y[j]; }
                if (act) { u32x2 w; w.x = pk2(o[0], o[1]); w.y = pk2(o[2], o[3]); *((u32x2*)((qk == 0 ? QN : KN) + (size_t)t * 1536 + h * QKD) + lane) = w; }
            }
            if (lane < 32) { const u32x2 r = d.vraw[h]; u32x2 w; w.x = pk2(bf2f(r.x & 0xffffu) * rkv, bf2f(r.x >> 16) * rkv); w.y = pk2(bf2f(r.y & 0xffffu) * rkv, bf2f(r.y >> 16) * rkv);
                *((u32x2*)(KVraw + (size_t)t * 2048 + h * 256 + 128) + lane) = w; }
        }
        d = dn;
    }
}
__device__ __forceinline__ void ca_head_norm(const Frame& F, bf16_t* Q, const float* g) {
    for (int t = F.gw; t < T_; t += F.NGW) {
#pragma unroll 1
        for (int hh = 0; hh < 4; ++hh) {
            u32x2* p = (u32x2*)(Q + (size_t)t * DM + hh * 256) + F.lane; const u32x2 a = *p;
            float v[4] = {bf2f(a.x & 0xffffu), bf2f(a.x >> 16), bf2f(a.y & 0xffffu), bf2f(a.y >> 16)};
            float ss = (v[0] * v[0] + v[1] * v[1]) + (v[2] * v[2] + v[3] * v[3]);
            ss += __shfl_xor(ss, 1); ss += __shfl_xor(ss, 2); ss += __shfl_xor(ss, 4); ss += __shfl_xor(ss, 8);
            const float rinv = rsqrtf(ss * (1.0f / 64.0f) + EPS); const f32x4 gg = ((const f32x4*)g)[F.lane & 15];
            u32x2 o; o.x = pk2(v[0] * rinv * gg[0], v[1] * rinv * gg[1]); o.y = pk2(v[2] * rinv * gg[2], v[3] * rinv * gg[3]); *p = o;
        }
    }
}
template <bool OUT8>
__device__ __forceinline__ void norm_router(const Frame& F, const bf16_t* X, const float* gain, const float* router, void* Hv, int* re, int* rp, float* rw, int* perm, gu32* cnt, const bool probe = false) {
    bf16_t* H = (bf16_t*)Hv; unsigned char* H8 = (unsigned char*)Hv;
    LAS unsigned* bc = (LAS unsigned*)(F.lds);
    LAS float* RT = (LAS float*)(F.lds + 256);
    if (F.tid < 16) bc[F.tid] = 0u;
    { const f32x4* rq = (const f32x4*)router + F.tid * 4; const f32x4 q0 = rq[0], q1 = rq[1], q2 = rq[2], q3 = rq[3]; const int k = F.tid * 2;
#pragma unroll
      for (int e = 0; e < 4; ++e) { RT[e * DM + k] = q0[e]; RT[(e + 4) * DM + k] = q1[e]; RT[e * DM + k + 1] = q2[e]; RT[(e + 4) * DM + k + 1] = q3[e]; } }
    __syncthreads();
    const int lane = F.lane; const bool b0 = lane & 1, b1 = lane & 2, b2 = lane & 4;
    f32x4 gl[4];
#pragma unroll
    for (int j = 0; j < 4; ++j) gl[j] = ((const f32x4*)gain)[lane + 64 * j];
    int ke0 = 0, ke1 = 0, kl0 = 0, kl1 = 0; float kw0 = 0.f, kw1 = 0.f; int i = 0;
    constexpr int R = 2;
    u32x2 v[R][4], vn[R][4];
#ifndef E5_PROBE
#define E5_PROBE 0
#endif
    const int nrows = (E5_PROBE && probe) ? 0 : (F.gw < T_ ? (T_ - F.gw + F.NGW - 1) / F.NGW : 0);
    int t = F.gw;
#pragma unroll
    for (int r = 0; r < R; ++r) { const int tr = t + r * F.NGW, tc = tr < T_ ? tr : T_ - 1; const u32x2* xr = (const u32x2*)(X + (size_t)tc * DM) + lane;
#pragma unroll
        for (int j = 0; j < 4; ++j) v[r][j] = xr[64 * j]; }
    for (; i + R <= nrows; t += R * F.NGW, i += R) {
#pragma unroll
        for (int r = 0; r < R; ++r) { const int tn = t + (R + r) * F.NGW, tc = tn < T_ ? tn : T_ - 1; const u32x2* xr = (const u32x2*)(X + (size_t)tc * DM) + lane;
#pragma unroll
            for (int j = 0; j < 4; ++j) vn[r][j] = xr[64 * j]; }
        float s[R], rstd[R];
#pragma unroll
        for (int r = 0; r < R; ++r) { s[r] = 0.f;
#pragma unroll
            for (int j = 0; j < 4; ++j) { const u32x2 a = v[r][j]; const float x0 = bf2f(a.x & 0xffffu), x1 = bf2f(a.x >> 16), x2 = bf2f(a.y & 0xffffu), x3 = bf2f(a.y >> 16); s[r] += (x0 * x0 + x1 * x1) + (x2 * x2 + x3 * x3); } }
#pragma unroll
        for (int r = 0; r < R; ++r) rstd[r] = rsqrtf(wave_sum(s[r]) * (1.0f / DM) + EPS);
        float lg[R][8];
#pragma unroll
        for (int r = 0; r < R; ++r)
#pragma unroll
            for (int e = 0; e < 8; ++e) lg[r][e] = 0.f;
#pragma unroll
        for (int j = 0; j < 4; ++j) { f32x4 h[R];
#pragma unroll
            for (int r = 0; r < R; ++r) { const int tr = t + r * F.NGW; const u32x2 a = v[r][j]; h[r] = (f32x4){bf2f(a.x & 0xffffu), bf2f(a.x >> 16), bf2f(a.y & 0xffffu), bf2f(a.y >> 16)} * rstd[r] * gl[j];
                if constexpr (OUT8) { ((unsigned*)(H8 + (size_t)tr * DM) + lane)[64 * j] = pk4_fp8(h[r][0] * 16.0f, h[r][1] * 16.0f, h[r][2] * 16.0f, h[r][3] * 16.0f); }
                else { u32x2 o; o.x = cvt_pk_bf16(h[r][0], h[r][1]); o.y = cvt_pk_bf16(h[r][2], h[r][3]); ((u32x2*)(H + (size_t)tr * DM) + lane)[64 * j] = o; } }
#pragma unroll
            for (int e = 0; e < 8; ++e) { const f32x4 rt = *(const LAS f32x4*)(RT + e * DM + 256 * j + 4 * lane);
#pragma unroll
                for (int r = 0; r < R; ++r) lg[r][e] += (h[r][0] * rt[0] + h[r][1] * rt[1]) + (h[r][2] * rt[2] + h[r][3] * rt[3]); } }
        int e0[R], e1[R]; float w0[R], w1[R];
#pragma unroll
        for (int r = 0; r < R; ++r) { float L[8];
#pragma unroll
            for (int e = 0; e < 8; ++e) L[e] = wave_sum(lg[r][e]);
            e0[r] = 0; float l0 = L[0];
#pragma unroll
            for (int e = 1; e < 8; ++e) if (L[e] > l0) { l0 = L[e]; e0[r] = e; }
            e1[r] = -1; float l1 = -3.0e38f;
#pragma unroll
            for (int e = 0; e < 8; ++e) if (e != e0[r] && L[e] > l1) { l1 = L[e]; e1[r] = e; }
            const float ex = __expf(l1 - l0); w0[r] = 1.0f / (1.0f + ex); w1[r] = ex * w0[r]; }
        int lp0[R], lp1[R];
#pragma unroll
        for (int r = 0; r < R; ++r) { lp0[r] = 0; lp1[r] = 0; }
        if (lane == 0) {
#pragma unroll
            for (int r = 0; r < R; ++r) { lp0[r] = (int)__hip_atomic_fetch_add(bc + e0[r], 1u, __ATOMIC_RELAXED, __HIP_MEMORY_SCOPE_WORKGROUP); lp1[r] = (int)__hip_atomic_fetch_add(bc + e1[r], 1u, __ATOMIC_RELAXED, __HIP_MEMORY_SCOPE_WORKGROUP); } }
#pragma unroll
        for (int r = 0; r < R; ++r) { const int q0 = __builtin_amdgcn_readfirstlane(lp0[r]), q1 = __builtin_amdgcn_readfirstlane(lp1[r]);
            if (lane == i + r) { ke0 = e0[r]; ke1 = e1[r]; kl0 = q0; kl1 = q1; kw0 = w0[r]; kw1 = w1[r]; } }
#pragma unroll
        for (int r = 0; r < R; ++r)
#pragma unroll
            for (int j = 0; j < 4; ++j) v[r][j] = vn[r][j];
    }
    for (; i < nrows; t += F.NGW, ++i) {
        const u32x2* xr = (const u32x2*)(X + (size_t)t * DM) + lane; f32x4 x[4]; float s = 0.f;
#pragma unroll
        for (int j = 0; j < 4; ++j) { const u32x2 a = xr[64 * j]; x[j] = (f32x4){bf2f(a.x & 0xffffu), bf2f(a.x >> 16), bf2f(a.y & 0xffffu), bf2f(a.y >> 16)}; s += (x[j][0] * x[j][0] + x[j][1] * x[j][1]) + (x[j][2] * x[j][2] + x[j][3] * x[j][3]); }
        const float rstd = rsqrtf(wave_sum(s) * (1.0f / DM) + EPS);
        float L[8];
#pragma unroll
        for (int e = 0; e < 8; ++e) L[e] = 0.f;
#pragma unroll
        for (int j = 0; j < 4; ++j) { const f32x4 h = x[j] * rstd * gl[j];
            if constexpr (OUT8) { ((unsigned*)(H8 + (size_t)t * DM) + lane)[64 * j] = pk4_fp8(h[0] * 16.0f, h[1] * 16.0f, h[2] * 16.0f, h[3] * 16.0f); } else { u32x2 o; o.x = cvt_pk_bf16(h[0], h[1]); o.y = cvt_pk_bf16(h[2], h[3]); ((u32x2*)(H + (size_t)t * DM) + lane)[64 * j] = o; }
#pragma unroll
            for (int e = 0; e < 8; ++e) { const f32x4 rt = *(const LAS f32x4*)(RT + e * DM + 256 * j + 4 * lane); L[e] += (h[0] * rt[0] + h[1] * rt[1]) + (h[2] * rt[2] + h[3] * rt[3]); } }
#pragma unroll
        for (int e = 0; e < 8; ++e) L[e] = wave_sum(L[e]);
        int e0 = 0; float l0 = L[0];
#pragma unroll
        for (int e = 1; e < 8; ++e) if (L[e] > l0) { l0 = L[e]; e0 = e; }
        int e1 = -1; float l1 = -3.0e38f;
#pragma unroll
        for (int e = 0; e < 8; ++e) if (e != e0 && L[e] > l1) { l1 = L[e]; e1 = e; }
        const float ex = __expf(l1 - l0), w0 = 1.0f / (1.0f + ex), w1 = ex * w0;
        int lp0 = 0, lp1 = 0;
        if (lane == 0) { lp0 = (int)__hip_atomic_fetch_add(bc + e0, 1u, __ATOMIC_RELAXED, __HIP_MEMORY_SCOPE_WORKGROUP); lp1 = (int)__hip_atomic_fetch_add(bc + e1, 1u, __ATOMIC_RELAXED, __HIP_MEMORY_SCOPE_WORKGROUP); }
        lp0 = __builtin_amdgcn_readfirstlane(lp0); lp1 = __builtin_amdgcn_readfirstlane(lp1);
        if (lane == i) { ke0 = e0; ke1 = e1; kl0 = lp0; kl1 = lp1; kw0 = w0; kw1 = w1; }
    }
    __syncthreads();
    if (F.tid < 8 && !probe) bc[8 + F.tid] = __hip_atomic_fetch_add(cnt + 64 * F.tid, bc[F.tid], RLX_AGENT);
    __syncthreads();
    if (lane < i && !probe) { const int tt = F.gw + lane * F.NGW; const int p0 = (int)bc[8 + ke0] + kl0, p1 = (int)bc[8 + ke1] + kl1;
        re[2 * tt] = ke0; re[2 * tt + 1] = ke1; rp[2 * tt] = p0; rp[2 * tt + 1] = p1; rw[2 * tt] = kw0; rw[2 * tt + 1] = kw1; perm[(size_t)ke0 * T_ + p0] = tt; perm[(size_t)ke1 * T_ + p1] = tt; }
    __syncthreads();
}

template <int DQK, int DV, bool BAND>
__device__ __forceinline__ void attn_naive(const Frame& F, const bf16_t* Q, int ldq, const bf16_t* K, int ldk, const bf16_t* V, int ldv, bf16_t* O, int ldo, int nheads, const float* bias, float scale) {
    constexpr int QS = DQK + 4, KS = DQK + 8, VS = DV + 8, DG = DV / 8;
    LAS float* Qs = (LAS float*)F.lds; LAS bf16_t* Ks = (LAS bf16_t*)(Qs + 64 * QS); LAS bf16_t* Vs = Ks + 64 * KS; LAS float* Ss = (LAS float*)(Vs + 64 * VS);
    LAS float* mS = Ss + 64 * 65; LAS float* lS = mS + 64; LAS float* aS = lS + 64; LAS float* bS = aS + 64;
    const int tid = F.tid, qi = tid & 63, kw = tid >> 6, nunits = NBATCH * nheads * NCHK;
    for (int un = F.vcu; un < nunits; un += F.G) {
        const int c = (NCHK - 1) - un / (NBATCH * nheads), bh = un % (NBATCH * nheads), b = bh / nheads, h = bh % nheads;
        const size_t row0 = (size_t)b * SEQ + (size_t)c * 64;
        __syncthreads();
        for (int idx = tid; idx < 64 * DQK / 4; idx += 512) { const int r = idx / (DQK / 4), c4 = idx % (DQK / 4);
            const u32x2 a = *(const u32x2*)(Q + (row0 + r) * ldq + h * DQK + c4 * 4);
            *(LAS f32x4*)(Qs + r * QS + c4 * 4) = (f32x4){bf2f(a.x & 0xffffu), bf2f(a.x >> 16), bf2f(a.y & 0xffffu), bf2f(a.y >> 16)}; }
        if (tid < 64) { mS[tid] = -3.0e38f; lS[tid] = 0.f; }
        if (BAND) for (int idx = tid; idx < NREL; idx += 512) bS[idx] = bias[h * NREL + idx];
        float o[DG];
#pragma unroll
        for (int d = 0; d < DG; ++d) o[d] = 0.f;
        const int kc0 = BAND ? (c - 8 > 0 ? c - 8 : 0) : 0;
        for (int kc = kc0; kc <= c; ++kc) {
            const size_t krow0 = (size_t)b * SEQ + (size_t)kc * 64;
            __syncthreads();
            for (int idx = tid; idx < 64 * DQK / 8; idx += 512) { const int r = idx / (DQK / 8), c8 = idx % (DQK / 8);
                *(LAS u32x4*)(Ks + r * KS + c8 * 8) = *(const u32x4*)(K + (krow0 + r) * ldk + h * DQK + c8 * 8); }
            for (int idx = tid; idx < 64 * DV / 8; idx += 512) { const int r = idx / (DV / 8), c8 = idx % (DV / 8);
                *(LAS u32x4*)(Vs + r * VS + c8 * 8) = *(const u32x4*)(V + (krow0 + r) * ldv + h * DV + c8 * 8); }
            __syncthreads();
            float s[8] = {0.f, 0.f, 0.f, 0.f, 0.f, 0.f, 0.f, 0.f};
            for (int d = 0; d < DQK; d += 8) {
                const f32x4 qa = *(const LAS f32x4*)(Qs + qi * QS + d), qb = *(const LAS f32x4*)(Qs + qi * QS + d + 4);
#pragma unroll
                for (int j = 0; j < 8; ++j) { const u32x4 kk = *(const LAS u32x4*)(Ks + (kw + 8 * j) * KS + d);
                    s[j] += qa[0] * bf2f(kk.x & 0xffffu) + qa[1] * bf2f(kk.x >> 16) + qa[2] * bf2f(kk.y & 0xffffu) + qa[3] * bf2f(kk.y >> 16)
                          + qb[0] * bf2f(kk.z & 0xffffu) + qb[1] * bf2f(kk.z >> 16) + qb[2] * bf2f(kk.w & 0xffffu) + qb[3] * bf2f(kk.w >> 16); }
            }
#pragma unroll
            for (int j = 0; j < 8; ++j) { const int kj = kw + 8 * j; float sv = s[j] * scale;
                if (BAND) { int rel = (c * 64 + qi) - (kc * 64 + kj); rel = rel < -63 ? -63 : (rel > 256 ? 256 : rel); sv += bS[rel + 63]; }
                Ss[qi * 65 + kj] = sv; }
            __syncthreads();
            if (tid < 64) { float mo = mS[tid], mx = mo;
                for (int j = 0; j < 64; ++j) mx = fmaxf(mx, Ss[tid * 65 + j]);
                const float al = __expf(mo - mx); float sum = 0.f;
                for (int j = 0; j < 64; ++j) { const float p = __expf(Ss[tid * 65 + j] - mx); Ss[tid * 65 + j] = p; sum += p; }
                lS[tid] = lS[tid] * al + sum; mS[tid] = mx; aS[tid] = al; }
            __syncthreads();
            { const float al = aS[qi];
#pragma unroll
              for (int d = 0; d < DG; ++d) o[d] *= al;
              for (int kj = 0; kj < 64; ++kj) { const float p = Ss[qi * 65 + kj];
#pragma unroll
                  for (int d8 = 0; d8 < DG / 8; ++d8) { const u32x4 vv = *(const LAS u32x4*)(Vs + kj * VS + kw * DG + d8 * 8);
                      o[d8 * 8 + 0] += p * bf2f(vv.x & 0xffffu); o[d8 * 8 + 1] += p * bf2f(vv.x >> 16); o[d8 * 8 + 2] += p * bf2f(vv.y & 0xffffu); o[d8 * 8 + 3] += p * bf2f(vv.y >> 16);
                      o[d8 * 8 + 4] += p * bf2f(vv.z & 0xffffu); o[d8 * 8 + 5] += p * bf2f(vv.z >> 16); o[d8 * 8 + 6] += p * bf2f(vv.w & 0xffffu); o[d8 * 8 + 7] += p * bf2f(vv.w >> 16); } } }
        }
        { const float li = 1.0f / lS[qi]; bf16_t* op = O + (row0 + qi) * ldo + h * DV + kw * DG;
#pragma unroll
          for (int d8 = 0; d8 < DG / 8; ++d8) { u32x4 w; w.x = pk2(o[d8 * 8 + 0] * li, o[d8 * 8 + 1] * li); w.y = pk2(o[d8 * 8 + 2] * li, o[d8 * 8 + 3] * li);
              w.z = pk2(o[d8 * 8 + 4] * li, o[d8 * 8 + 5] * li); w.w = pk2(o[d8 * 8 + 6] * li, o[d8 * 8 + 7] * li); *(u32x4*)(op + d8 * 8) = w; } }
    }
    __syncthreads();
}


namespace att {
typedef float f32x16 __attribute__((ext_vector_type(16)));
typedef short v4i16_t __attribute__((ext_vector_type(4)));
constexpr float THR = 8.0f;
__device__ __forceinline__ float vmax3(float a, float b, float c) { float r; asm("v_max3_f32 %0, %1, %2, %3" : "=v"(r) : "v"(a), "v"(b), "v"(c)); return r; }
__device__ __forceinline__ int crow(int r, int hi) { return (r & 3) + 8 * (r >> 2) + 4 * hi; }
__device__ __forceinline__ s16x4 vtr(const LAS unsigned char* p) { return __builtin_bit_cast(s16x4, __builtin_amdgcn_ds_read_tr16_b64_v4i16((LAS v4i16_t*)p)); }
__device__ __forceinline__ unsigned cvtpk(float lo, float hi) { typedef __bf16 bf16x2_t __attribute__((ext_vector_type(2))); f32x2 v = {lo, hi}; bf16x2_t b = __builtin_convertvector(v, bf16x2_t); return __builtin_bit_cast(unsigned, b); }

template <int DQK, int BS>
__device__ __forceinline__ void qk_tile(const LAS unsigned char* Kb, const bf16x8 (&qr)[DQK / 16], f32x16& p0, f32x16& p1, const int r32, const int hi) {
#pragma unroll
    for (int r = 0; r < 16; ++r) { p0[r] = 0.f; p1[r] = 0.f; }
    const LAS unsigned char* kp = Kb + hi * 1024 + r32 * 16;
    if constexpr (BS == 0) {
#pragma unroll
        for (int d0 = 0; d0 < DQK / 16; ++d0) { const bf16x8 b0 = *(const LAS bf16x8*)(kp + d0 * 2048), b1 = *(const LAS bf16x8*)(kp + d0 * 2048 + 512);
            p0 = __builtin_amdgcn_mfma_f32_32x32x16_bf16(b0, qr[d0], p0, 0, 0, 0); p1 = __builtin_amdgcn_mfma_f32_32x32x16_bf16(b1, qr[d0], p1, 0, 0, 0); }
        return; }
    constexpr int NB = DQK / 16 / (BS ? BS : 1);
    bf16x8 fa[2 * (BS ? BS : 1)], fb[2 * (BS ? BS : 1)];
#define QK_LD(f, g) do { _Pragma("unroll") for (int i_ = 0; i_ < BS; ++i_) { f[2 * i_] = *(const LAS bf16x8*)(kp + ((g) * BS + i_) * 2048); f[2 * i_ + 1] = *(const LAS bf16x8*)(kp + ((g) * BS + i_) * 2048 + 512); } } while (0)
#define QK_MM(f, g) do { _Pragma("unroll") for (int i_ = 0; i_ < BS; ++i_) { p0 = __builtin_amdgcn_mfma_f32_32x32x16_bf16(f[2 * i_], qr[(g) * BS + i_], p0, 0, 0, 0); p1 = __builtin_amdgcn_mfma_f32_32x32x16_bf16(f[2 * i_ + 1], qr[(g) * BS + i_], p1, 0, 0, 0); } } while (0)
    QK_LD(fa, 0);
#pragma unroll
    for (int g = 0; g < NB; g += 2) {
        if (g + 1 < NB) { QK_LD(fb, g + 1); __builtin_amdgcn_sched_barrier(0); }
        QK_MM(fa, g); __builtin_amdgcn_sched_barrier(0);
        if (g + 2 < NB) { QK_LD(fa, g + 2); __builtin_amdgcn_sched_barrier(0); }
        if (g + 1 < NB) { QK_MM(fb, g + 1); __builtin_amdgcn_sched_barrier(0); }
    }
#undef QK_LD
#undef QK_MM
}
template <int DV, bool BIAS, bool VDB = true>
__device__ __forceinline__ void sm_pv_tile(f32x16& p0, f32x16& p1, const LAS unsigned char* Vb, f32x16 (&o)[DV / 32], float& m, float& l, const float C,
                                           const LAS float* btab, const int bbase, LAS float* wsf, const int r32, const int hi, const int lane) {
    if (BIAS) {
#pragma unroll
        for (int r = 0; r < 16; ++r) { const int kj = crow(r, hi); p0[r] = fmaf(p0[r], C, btab[bbase - kj]); p1[r] = fmaf(p1[r], C, btab[bbase - kj - 32]); }
    }
    float pm, pq;
    pm = vmax3(p0[0], p0[1], p0[2]); pq = vmax3(p1[0], p1[1], p1[2]);
#pragma unroll
    for (int r = 3; r < 15; r += 2) { pm = vmax3(pm, p0[r], p0[r + 1]); pq = vmax3(pq, p1[r], p1[r + 1]); }
    pm = vmax3(pm, p0[15], pq); pm = fmaxf(pm, p1[15]);
    { auto rr = __builtin_amdgcn_permlane32_swap(__float_as_uint(pm), __float_as_uint(pm), false, false); pm = fmaxf(__uint_as_float(rr[0]), __uint_as_float(rr[1])); }
    if (!BIAS) pm *= C;
    if (__any(pm > m + THR)) {
        const float mn = fmaxf(m, pm), al = __builtin_amdgcn_exp2f(m - mn); m = mn; l *= al;
        if (hi == 0) wsf[r32] = al;
        asm volatile("s_waitcnt lgkmcnt(0)" ::: "memory");
#pragma unroll
        for (int r = 0; r < 16; ++r) { const float a = wsf[crow(r, hi)];
#pragma unroll
            for (int d = 0; d < DV / 32; ++d) o[d][r] *= a; }
    }
    const float nm = -m;
    { const f32x2 nm2 = (f32x2){nm, nm}, C2 = (f32x2){C, C}; f32x2 sa = (f32x2){0.f, 0.f}, sb = (f32x2){0.f, 0.f};
#pragma unroll
      for (int i = 0; i < 8; ++i) { f32x2 a = (f32x2){p0[2 * i], p0[2 * i + 1]}, b = (f32x2){p1[2 * i], p1[2 * i + 1]};
          if (BIAS) { a = a + nm2; b = b + nm2; } else { a = a * C2 + nm2; b = b * C2 + nm2; }
          a.x = __builtin_amdgcn_exp2f(a.x); a.y = __builtin_amdgcn_exp2f(a.y); b.x = __builtin_amdgcn_exp2f(b.x); b.y = __builtin_amdgcn_exp2f(b.y);
          p0[2 * i] = a.x; p0[2 * i + 1] = a.y; p1[2 * i] = b.x; p1[2 * i + 1] = b.y; sa += a; sb += b; }
      sa += sb; l += sa.x + sa.y; }
#define PV_PK(ks_) ({ u32x4 w_; if ((ks_) < 2) { const int b_ = 8 * (ks_); w_.x = cvtpk(p0[b_], p0[b_ + 1]); w_.y = cvtpk(p0[b_ + 2], p0[b_ + 3]); w_.z = cvtpk(p0[b_ + 4], p0[b_ + 5]); w_.w = cvtpk(p0[b_ + 6], p0[b_ + 7]); } \
        else { const int b_ = 8 * ((ks_) - 2); w_.x = cvtpk(p1[b_], p1[b_ + 1]); w_.y = cvtpk(p1[b_ + 2], p1[b_ + 3]); w_.z = cvtpk(p1[b_ + 4], p1[b_ + 5]); w_.w = cvtpk(p1[b_ + 6], p1[b_ + 7]); } __builtin_bit_cast(bf16x8, w_); })
    bf16x8 pa[4];
    if constexpr (VDB) {
#pragma unroll
        for (int ks = 0; ks < 4; ++ks) pa[ks] = PV_PK(ks); }
    const LAS unsigned char* vp = Vb + ((lane >> 4) & 1) * 32 + (lane & 3) * 8 + (4 * hi + ((lane & 15) >> 2)) * 64;
    bf16x8 va[4], vb[4];
#define PV_LD(f, d0_) do { _Pragma("unroll") for (int ks_ = 0; ks_ < 4; ++ks_) { const s16x4 lo_ = vtr(vp + ((d0_) * 4 + ks_) * 1024), hh_ = vtr(vp + ((d0_) * 4 + ks_) * 1024 + 512); \
        f[ks_] = (bf16x8){lo_[0], lo_[1], lo_[2], lo_[3], hh_[0], hh_[1], hh_[2], hh_[3]}; } } while (0)
#define PV_MM(f, d0_) do { _Pragma("unroll") for (int ks_ = 0; ks_ < 4; ++ks_) o[d0_] = __builtin_amdgcn_mfma_f32_32x32x16_bf16(pa[ks_], f[ks_], o[d0_], 0, 0, 0); } while (0)
    if constexpr (!VDB) {
#pragma unroll
        for (int ks = 0; ks < 4; ++ks) { const bf16x8 pk_ = PV_PK(ks);
#pragma unroll
            for (int d0 = 0; d0 < DV / 32; ++d0) { const s16x4 lo_ = vtr(vp + (d0 * 4 + ks) * 1024), hh_ = vtr(vp + (d0 * 4 + ks) * 1024 + 512);
                o[d0] = __builtin_amdgcn_mfma_f32_32x32x16_bf16(pk_, (bf16x8){lo_[0], lo_[1], lo_[2], lo_[3], hh_[0], hh_[1], hh_[2], hh_[3]}, o[d0], 0, 0, 0); } }
    } else {
    PV_LD(va, 0);
#pragma unroll
    for (int d0 = 0; d0 < DV / 32; d0 += 2) {
        PV_LD(vb, d0 + 1); __builtin_amdgcn_sched_barrier(0); PV_MM(va, d0); __builtin_amdgcn_sched_barrier(0);
        if (d0 + 2 < DV / 32) { PV_LD(va, d0 + 2); __builtin_amdgcn_sched_barrier(0); }
        PV_MM(vb, d0 + 1); __builtin_amdgcn_sched_barrier(0);
    }
    }
#undef PV_LD
#undef PV_MM
#undef PV_PK
}

template <int DQK, int DV, int NHU, bool BIAS, bool PIPE, int ORD>
__device__ __forceinline__ void attn_unit(LAS unsigned char* lds, const unsigned ldsb, const int tid, const int lane, const int wid, const bf16_t* Q, const int ldq, const bf16_t* K, const int ldk, const bf16_t* V, const int ldv, const int vhs,
                                          bf16_t* O, const int ldo, const float* bias, const float C, const int b, const int head0, const int cbase, const unsigned klane, const unsigned vlane, const int probe = 0, const bool fill_bias = true) {
    constexpr int KBLK = DQK / 8, VBLK = DV / 8, KSZ = NHU * KBLK * 1024, VSZ = NHU * VBLK * 1024, SLOT = KSZ + VSZ, CPU_ = 4 / NHU, DPW = NHU * (KBLK + VBLK) / 8;
    const int r32 = lane & 31, hi = lane >> 5;
    const int hh = NHU == 2 ? (wid >> 2) : 0, cj = NHU == 2 ? ((wid >> 1) & 1) : (wid >> 1), half = wid & 1;
    LAS float* wsf = (LAS float*)(lds + 3 * SLOT) + wid * 64;
    LAS float* btab = (LAS float*)(lds + 3 * SLOT + 2048);
    const int cq = cbase + cj, kc_hi = cbase + CPU_ - 1;
    const int kc_lo = BIAS ? (cbase - 8 > 0 ? cbase - 8 : 0) : 0, w_lo = BIAS ? (cq - 8 > 0 ? cq - 8 : 0) : 0;
    const size_t qrow0 = (size_t)b * SEQ + (size_t)cq * 64 + half * 32;
    bf16x8 qr[DQK / 16];
    { const bf16_t* qp = Q + (qrow0 + r32) * ldq + (head0 + hh) * DQK + hi * 8;
#pragma unroll
      for (int d0 = 0; d0 < DQK / 16; ++d0) qr[d0] = *(const bf16x8*)(qp + d0 * 16);
#pragma unroll
      for (int d0 = 0; d0 < DQK / 16; ++d0) asm volatile("s_waitcnt vmcnt(0)" : "+v"(qr[d0])); }
    if (BIAS && fill_bias) for (int idx = tid; idx < NHU * 640; idx += 512) { const int h2 = idx / 640, i = idx % 640; btab[idx] = bias[(head0 + h2) * NREL + (i < NREL - 1 ? i : NREL - 1)] * 1.4426950408889634f; }
    f32x16 o[DV / 32];
#pragma unroll
    for (int d = 0; d < DV / 32; ++d)
#pragma unroll
        for (int r = 0; r < 16; ++r) o[d][r] = 0.f;
    float m = -1.0e30f, l = 0.f;
#define ATT_DMA(kc_, slot_) do { const int so_ = (slot_) * SLOT; \
    _Pragma("unroll") for (int j_ = 0; j_ < NHU * KBLK / 8; ++j_) { const int id_ = wid + 8 * j_, hd_ = id_ / KBLK, bi_ = id_ % KBLK; \
        glds16_s(klane, (const char*)(K + ((size_t)((b * ldk + head0 + hd_) * NCHK + (kc_)) * KBLK + bi_) * 512), ldsb + (unsigned)(so_ + id_ * 1024)); } \
    _Pragma("unroll") for (int j_ = 0; j_ < NHU * VBLK / 8; ++j_) { const int id_ = wid + 8 * j_, hd_ = id_ / VBLK, vb_ = id_ % VBLK; \
        glds16_s(vlane, (const char*)(V + ((size_t)((b * ldk + head0 + hd_) * NCHK + (kc_)) * VBLK + vb_) * 512), ldsb + (unsigned)(so_ + KSZ + id_ * 1024)); } } while (0)
    constexpr int QBS = DQK > 64 ? 2 : 4;
    if constexpr (!PIPE) {
    f32x16 p0, p1;
#pragma unroll
    for (int r = 0; r < 16; ++r) { p0[r] = 0.f; p1[r] = 0.f; }
    int s_cur = 0, s_nn = 2;
    if (probe != 2) { ATT_DMA(kc_lo, 0); if (kc_lo + 1 <= kc_hi) ATT_DMA(kc_lo + 1, 1); }
    for (int kc = kc_lo; kc <= kc_hi; ++kc) {
        if (kc + 1 <= kc_hi) asm volatile("s_waitcnt vmcnt(%0) lgkmcnt(0)\n\ts_barrier" :: "n"(DPW) : "memory");
        else                 asm volatile("s_waitcnt vmcnt(0) lgkmcnt(0)\n\ts_barrier" ::: "memory");
        if (kc + 2 <= kc_hi && probe != 2) ATT_DMA(kc + 2, s_nn);
        if (kc >= w_lo && kc <= cq && probe != 1) {
            const LAS unsigned char* Kb = lds + s_cur * SLOT + hh * KBLK * 1024; const LAS unsigned char* Vb = lds + s_cur * SLOT + KSZ + hh * VBLK * 1024;
            if (probe == 5 || probe == 6) {
                if (probe == 5) {
#pragma unroll
                    for (int d0 = 0; d0 < DQK / 16; ++d0) { p0 = __builtin_amdgcn_mfma_f32_32x32x16_bf16(qr[d0], qr[d0], p0, 0, 0, 0); p1 = __builtin_amdgcn_mfma_f32_32x32x16_bf16(qr[d0], qr[d0], p1, 0, 0, 0); } }
                else { const LAS unsigned char* kp = Kb + hi * 1024 + r32 * 16; bf16x8 acc_ = qr[0];
#pragma unroll
                    for (int d0 = 0; d0 < DQK / 16; ++d0) { const bf16x8 b0 = *(const LAS bf16x8*)(kp + d0 * 2048), b1 = *(const LAS bf16x8*)(kp + d0 * 2048 + 512); acc_ ^= b0 ^ b1; }
                    asm volatile("" :: "v"(acc_)); }
            }
            else if (probe != 4) { qk_tile<DQK, QBS>(Kb, qr, p0, p1, r32, hi); __builtin_amdgcn_sched_barrier(0); }
            if (probe == 5 || probe == 6) { asm volatile("" : "+v"(p0), "+v"(p1)); }
            else if (probe != 3) sm_pv_tile<DV, BIAS>(p0, p1, Vb, o, m, l, C, btab + hh * 640, (cq - kc) * 64 + half * 32 + r32 + 63, wsf, r32, hi, lane);
            else { asm volatile("" : "+v"(p0), "+v"(p1)); }
        }
        s_cur = s_cur == 2 ? 0 : s_cur + 1; s_nn = s_nn == 2 ? 0 : s_nn + 1;
    }
    } else {
    f32x16 pA0, pA1, pB0, pB1;
#pragma unroll
    for (int r = 0; r < 16; ++r) { pA0[r] = 0.f; pA1[r] = 0.f; pB0[r] = 0.f; pB1[r] = 0.f; }
    int s_cur = 0, s_n1 = 1, s_nn = 2;
#define ATT_ADV() do { const int t_ = s_cur; s_cur = s_n1; s_n1 = s_nn; s_nn = t_; } while (0)
#define ATT_SYNC(kc_) do { asm volatile("s_waitcnt vmcnt(0) lgkmcnt(0)\n\ts_barrier" ::: "memory");     \
        if ((kc_) + 2 <= kc_hi) ATT_DMA((kc_) + 2, s_nn); } while (0)
#define ATT_A(N0, N1) qk_tile<DQK, QBS>(lds + s_n1 * SLOT + hh * KBLK * 1024, qr, N0, N1, r32, hi)
#define ATT_B(C0, C1, kc_) sm_pv_tile<DV, BIAS, (DQK <= 64)>(C0, C1, lds + s_cur * SLOT + KSZ + hh * VBLK * 1024, o, m, l, C, btab + hh * 640, (cq - (kc_)) * 64 + half * 32 + r32 + 63, wsf, r32, hi, lane)
#define ATT_AB(N0, N1, C0, C1, kc_) do { if (ORD == 0) { ATT_A(N0, N1); __builtin_amdgcn_sched_barrier(0); ATT_B(C0, C1, kc_); } else { ATT_B(C0, C1, kc_); __builtin_amdgcn_sched_barrier(0); ATT_A(N0, N1); } } while (0)
    ATT_DMA(kc_lo, 0); if (kc_lo + 1 <= kc_hi) ATT_DMA(kc_lo + 1, 1);
    if (kc_lo + 1 <= kc_hi) asm volatile("s_waitcnt vmcnt(%0) lgkmcnt(0)\n\ts_barrier" :: "n"(DPW) : "memory"); else asm volatile("s_waitcnt vmcnt(0) lgkmcnt(0)\n\ts_barrier" ::: "memory");
    int kc = kc_lo;
    if (w_lo == kc_lo) { qk_tile<DQK, QBS>(lds + hh * KBLK * 1024, qr, pA0, pA1, r32, hi); }
    else { for (; kc < w_lo - 1; ++kc) { ATT_SYNC(kc); ATT_ADV(); } ATT_SYNC(kc); ATT_A(pA0, pA1); ATT_ADV(); ++kc; }
    int n = cq - w_lo;
    if (n & 1) { ATT_SYNC(kc); ATT_AB(pB0, pB1, pA0, pA1, kc); ATT_ADV(); ++kc; --n; pA0 = pB0; pA1 = pB1; }
    for (; n > 0; n -= 2) {
        ATT_SYNC(kc); ATT_AB(pB0, pB1, pA0, pA1, kc); ATT_ADV(); ++kc;
        ATT_SYNC(kc); ATT_AB(pA0, pA1, pB0, pB1, kc); ATT_ADV(); ++kc; }
    ATT_SYNC(kc); ATT_B(pA0, pA1, kc); ATT_ADV(); ++kc;
    for (; kc <= kc_hi; ++kc) { ATT_SYNC(kc); ATT_ADV(); }
#undef ATT_ADV
#undef ATT_SYNC
#undef ATT_A
#undef ATT_B
#undef ATT_AB
    }
#undef ATT_DMA
    { auto rr = __builtin_amdgcn_permlane32_swap(__float_as_uint(l), __float_as_uint(l), false, false); l = __uint_as_float(rr[0]) + __uint_as_float(rr[1]); }
    if (hi == 0) wsf[32 + r32] = 1.0f / l;
    asm volatile("s_waitcnt lgkmcnt(0)" ::: "memory");
    int r32s = r32, his = hi; asm volatile("" : "+v"(r32s), "+v"(his));
    bf16_t* op = O + qrow0 * ldo + (head0 + hh) * DV + r32s;
    if (probe == 0) {
    if (vhs) {
    unsigned char* op8 = (unsigned char*)O + qrow0 * ldo + (head0 + hh) * DV + r32s;
#pragma unroll
    for (int r = 0; r < 16; ++r) { const int q = crow(r, his); const float rl = wsf[32 + q] * 16.0f;
#pragma unroll
        for (int d0 = 0; d0 < DV / 32; ++d0) { const float v_ = __builtin_amdgcn_fmed3f(o[d0][r] * rl, -448.0f, 448.0f); op8[(size_t)q * ldo + d0 * 32] = (unsigned char)(__builtin_amdgcn_cvt_pk_fp8_f32(v_, v_, 0u, false) & 0xffu); } }
    } else {
#pragma unroll
    for (int r = 0; r < 16; ++r) { const int q = crow(r, his); const float rl = wsf[32 + q];
#pragma unroll
        for (int d0 = 0; d0 < DV / 32; ++d0) op[(size_t)q * ldo + d0 * 32] = (bf16_t)f2bf(o[d0][r] * rl); } } }
}
template <int DQK, int DV, int NHU, bool BIAS, bool PIPE>
__device__ __forceinline__ void attn_mfma(const Frame& F, const bf16_t* Q, int ldq, const bf16_t* K, int ldk, const bf16_t* V, int ldv, int vhs, bf16_t* O, int ldo, int nheads, const float* bias, const float C, const int probe = 0) {
    constexpr int CPU_ = 4 / NHU;
    const int lane = F.lane, wid = F.wave;
    LAS unsigned char* lds = F.lds;
    const unsigned ldsb = (unsigned)__builtin_amdgcn_readfirstlane((int)(unsigned)(uintptr_t)lds);
    const int nunits = NBATCH * (nheads / NHU) * (NCHK / CPU_);
    const unsigned klane = (unsigned)lane * 16u, vlane = klane;
    int prev_h0 = -1;
    for (int L = F.vcu; L < nunits; L += F.G) {
        int b, head0, cbase;
        if (NHU == 1) { const int vv = L & 255, ii = L >> 8, c8 = vv & 7, grp = vv >> 3;
            const int bh = grp * 4 + ii, qb = (ii & 1) ? 7 - c8 : c8;
            b = bh / nheads; head0 = bh % nheads; cbase = qb * 4; }
        else { const int vv = L & 255, bhp = vv >> 1, g = 2 * (L >> 8) + (vv & 1); b = bhp >> 3; head0 = (bhp & 7) * 2; cbase = g * 2; }
        asm volatile("s_waitcnt lgkmcnt(0)\n\ts_barrier" ::: "memory");
        if constexpr (PIPE) { if (wid < 4) attn_unit<DQK, DV, NHU, BIAS, true, 0>(lds, ldsb, F.tid, lane, wid, Q, ldq, K, ldk, V, ldv, vhs, O, ldo, bias, C, b, head0, cbase, klane, vlane, probe, head0 != prev_h0);
                              else         attn_unit<DQK, DV, NHU, BIAS, true, 1>(lds, ldsb, F.tid, lane, wid, Q, ldq, K, ldk, V, ldv, vhs, O, ldo, bias, C, b, head0, cbase, klane, vlane, probe, head0 != prev_h0); }
        else attn_unit<DQK, DV, NHU, BIAS, false, 0>(lds, ldsb, F.tid, lane, wid, Q, ldq, K, ldk, V, ldv, vhs, O, ldo, bias, C, b, head0, cbase, klane, vlane, probe, head0 != prev_h0);
        prev_h0 = head0;
    }
    asm volatile("s_waitcnt vmcnt(0) lgkmcnt(0)\n\ts_barrier" ::: "memory");
}
}

struct Args { const void* in[50]; float* out; unsigned char* ws; int ph_lo, ph_hi; };
#define NAIVE(g) (((NAIVE_MASK) >> (g)) & 1)
constexpr int N_PHASES = 2 * (13 + NAIVE(5)) + 1;

__global__ void __launch_bounds__(512, 2) fwd(Args args) {
    extern __shared__ __attribute__((aligned(16))) unsigned char lds_raw[];
    Frame F;
    F.lds = (LAS unsigned char*)lds_raw;
    F.tid = threadIdx.x; F.lane = F.tid & 63; F.wave = __builtin_amdgcn_readfirstlane(F.tid >> 6);
    F.G = gridDim.x; { const int bx = blockIdx.x; F.vcu = (F.G % 8 == 0) ? (bx % 8) * (F.G / 8) + bx / 8 : bx; }
    F.gw = F.vcu * 8 + F.wave; F.NGW = F.G * 8;
    volatile LAS unsigned* MISC = (volatile LAS unsigned*)(F.lds + MISC_OFF);
    gu32* ctl = (gu32*)(args.ws + WS_CTL);
    for (int u = F.tid; u < (LDS_BYTES - LDSCTL_OFF) / 4; u += 512) ((LAS unsigned*)(F.lds + LDSCTL_OFF))[u] = 0u;
    __syncthreads();
    XcdBarrier bar; bar.bar = (unsigned*)(ctl + CW_BAR); bar.x = 0; bar.st = nullptr;
    if (!MK_PER_PHASE) bar = xcd_barrier_post((unsigned*)(ctl + CW_BAR), MISC + 8);
    const int lo = args.ph_lo, hi = args.ph_hi;
    int ph = 0;
#ifndef PH_MASK
#define PH_MASK 0xFFFFFFFFu
#endif
#ifndef DUP_MASK
#define DUP_MASK 0u
#endif
#ifndef EPI_PROBE
#define EPI_PROBE 0
#endif
#ifndef E0_PROBE
#define E0_PROBE 0
#endif
#ifndef BAR_PROBE
#define BAR_PROBE 0
#endif
#ifndef ATT_PROBE
#define ATT_PROBE 0
#endif
#define PHASE_BEGIN(k) if (ph >= lo && ph < hi) { if ((PH_MASK >> (k)) & 1u) for (int rep_ = 0; rep_ < 1 + (int)((DUP_MASK >> (k)) & 1u); ++rep_) { asm volatile("; PHASE_MARK %0" :: "n"(k)); { unsigned z_ = 0u; asm volatile("" : "+v"(z_)); F.lane = (int)__builtin_amdgcn_mbcnt_hi(~0u, __builtin_amdgcn_mbcnt_lo(~0u, z_)); } F.tid = F.wave * 64 + F.lane; asm volatile("" : "+s"(F.wave), "+s"(F.vcu), "+s"(F.gw));
#define PHASE_END   } if (!MK_PER_PHASE && ph + 1 < hi) { unsigned z_ = 0u; asm volatile("" : "+v"(z_)); xcd_barrier(bar, (int)(F.wave * 64 + __builtin_amdgcn_mbcnt_hi(~0u, __builtin_amdgcn_mbcnt_lo(~0u, z_)))); if (BAR_PROBE) xcd_barrier(bar, (int)(F.wave * 64 + __builtin_amdgcn_mbcnt_hi(~0u, __builtin_amdgcn_mbcnt_lo(~0u, z_)))); } } ++ph;

#define XB2 ((bf16_t*)args.out)
#define H8B ((unsigned char*)args.out + (size_t)64 * MiB)
#define H ((bf16_t*)(args.ws + WS_H))
#define W (args.ws + WS_W)
#define BIG (args.ws + WS_BIG)
#define route_e ((int*)(args.ws + WS_ROUTE_E))
#define route_p ((int*)(args.ws + WS_ROUTE_P))
#define route_w ((float*)(args.ws + WS_ROUTE_W))
#define perm_g ((int*)(args.ws + WS_PERM))
#define Ybuf ((bf16_t*)(BIG + B_Y))
#define positions ((const int*)args.in[1])

#pragma unroll 1
    for (int lp = 0; lp < 2; ++lp) {
#define FFN8 (((FFN8_MASK) >> lp) & 1)
#define QKV8 (((QKV8_MASK) >> lp) & 1)
#define AO8 (((AO8_MASK) >> lp) & 1)
#define IN8 (((IN8_MASK) >> lp) & 1)
#define MLAUP8 (((MLAUP8_MASK) >> lp) & 1)
#define BO8 (((BO8_MASK) >> lp) & 1)
#define EIN(k) ((const float*)args.in[2 + lp * 24 + (k)])
#define OIN(k) ((const float*)args.in[15 + lp * 24 + (k)])
#define e_attn_norm EIN(0)
#define e_w_in EIN(1)
#define e_qa EIN(2)
#define e_kva EIN(3)
#define e_w_uq EIN(4)
#define e_w_ukv EIN(5)
#define e_qn EIN(6)
#define e_kn EIN(7)
#define e_w_o EIN(8)
#define e_ffn_norm EIN(9)
#define e_wg EIN(10)
#define e_wu EIN(11)
#define e_wd EIN(12)
#define o_attn_norm OIN(0)
#define o_w_qkv OIN(1)
#define o_qn OIN(2)
#define o_kn OIN(3)
#define o_bias OIN(4)
#define o_w_o OIN(5)
#define o_ffn_norm OIN(6)
#define o_router OIN(7)
#define o_wg OIN(8)
#define o_wu OIN(9)
#define o_wd OIN(10)
#define cnt_prev (ctl + CW_CNT + (lp ? (lp - 1) : 0) * 512)
#define cnt_cur (ctl + CW_CNT + lp * 512)
#define A1 ((bf16_t*)(BIG + B_A1))
#define VM ((bf16_t*)(BIG + B_VM))
#define QN ((bf16_t*)(BIG + B_QN))
#define KN ((bf16_t*)(BIG + B_KN))
#define OM ((bf16_t*)(BIG + B_OM))
#define ACT ((bf16_t*)(BIG + B_ACT))
#define CQ ((bf16_t*)(BIG + B_CQ))
#define CK ((bf16_t*)(BIG + B_CK))
#define CV ((bf16_t*)(BIG + B_CV))
#define CO ((bf16_t*)(BIG + B_CO))
        PHASE_BEGIN(0)
          for (int r2_ = 0; r2_ < ((E0_PROBE && lp == 0) ? 2 : 1); ++r2_) {
            { EvenConv ec{e_w_in, e_w_uq, e_qa, e_w_ukv, e_kva, e_w_o, e_wg, e_wu, e_ffn_norm, e_wd, (unsigned char*)W, MLAUP8, AO8, FFN8, IN8, e_attn_norm}; conv_even(F, ec); }
            MoeCombine mc; mc.re = route_e; mc.rp = route_p; mc.rw = route_w; mc.Y = Ybuf;
            static_assert((IN8_MASK) == 0, "the input projection reads the raw bf16 residual rows (rstd in its epilogue, gain folded into w_in)");
            if (lp == 0) { res_rows<false, false, true, false, false>(F, args.in[0], XB2, nullptr, nullptr, nullptr, mc, false, (float*)(args.ws + WS_SSX)); }
            else { mc.mi.load(cnt_prev); res_rows<true, true, true, false, false>(F, H, XB2, nullptr, nullptr, nullptr, mc, false, (float*)(args.ws + WS_SSX)); }
          }
        PHASE_END
        PHASE_BEGIN(1)
            if (NAIVE(0)) { naive_gemm<false>(F, T_ / 64, AIN, DM, H, DM, [](int r) { return r; }, [&](int, const float*& b1, const float*& b2) { b1 = e_w_in; b2 = e_w_in; }, AIN,
                              [&](int r, int c, float v, float) { A1[(size_t)r * AINP + c] = (bf16_t)f2bf(v); }); }
            else { pg8::Gemm g{(const char*)XB2, (const char*)(W + WE_IN), DM, DM, DM, 2, 0u, 0u}; pg8::DenseOrder S; S.init(T_ / 256, AINP / 256, F.G, (int)blockIdx.x);
                static_assert((MLAUP8_MASK) == 0, "the fp8 input projection below stores bf16 latents");
                pg8::EpiA1<false> E{A1, AINP, (float*)(args.ws + WS_SSQ), (const float*)(args.ws + WS_SSX), (LAS float*)(F.lds + LDSCTL_OFF + 8192)};
                if (((IN8_MASK) != 0) && IN8) { g.A = (const char*)H8B; g.es = 1; E.iscale = 1.0f / 4096.0f; pg8::gemm_phase<pg8::EpiA1<false>, pg8::DenseOrder, false, true>(F.lds, F.wave, g, S, E); }
                else if ((IN8_MASK) != 3) pg8::gemm_phase<pg8::EpiA1<false>, pg8::DenseOrder, false>(F.lds, F.wave, g, S, E); }
        PHASE_END
        PHASE_BEGIN(3)
            { { LAS float* GL = (LAS float*)(F.lds + LDSCTL_OFF + 5120); if (F.tid < QKD) { GL[F.tid] = e_qn[F.tid]; GL[192 + F.tid] = e_kn[F.tid]; } __syncthreads(); }
              pg8::Gemm g{(const char*)A1, (const char*)(W + WE_QKVF), 256, AINP, 256, 2, 0u, 0u}; pg8::MlaOrder S; S.d.init(T_ / 256, 18, F.G, (int)blockIdx.x);
              pg8::EpiMlaQKV E{(LAS float*)(F.lds + LDSCTL_OFF + 1024), QN, (size_t)(B_KN - B_QN) / 2, VM, (const float*)(args.ws + WS_SSQ), e_qn, e_kn, positions, (LAS float*)(F.lds + LDSCTL_OFF + 8192)};
              if (((MLAUP8_MASK) != 0) && MLAUP8) { g.es = 1; E.iscale = 1.0f / 4096.0f; pg8::gemm_phase<pg8::EpiMlaQKV, pg8::MlaOrder, false, true>(F.lds, F.wave, g, S, E); }
              else if ((MLAUP8_MASK) != 3) { E.nostore = rep_ && EPI_PROBE == 2; pg8::gemm_phase<pg8::EpiMlaQKV, pg8::MlaOrder, false>(F.lds, F.wave, g, S, E); } }
        PHASE_END
        PHASE_BEGIN(5)
#if NAIVE_ATTN & 1
            attn_naive<QKD, VD, false>(F, QN, 1536, KN, 1536, VM, DM, OM, DM, MLA_H, nullptr, 0.07216878364870322f);
#else
            att::attn_mfma<QKD, VD, 1, false, MLA_PIPE>(F, QN, 1536, KN, MLA_H, VM, 0, AO8, OM, DM, MLA_H, nullptr, 0.07216878364870322f * 1.4426950408889634f, rep_ ? ATT_PROBE : 0);
#endif
        PHASE_END
        PHASE_BEGIN(6)
            if (NAIVE(2)) { naive_gemm<false>(F, T_ / 64, DM, DM, OM, DM, [](int r) { return r; }, [&](int, const float*& b1, const float*& b2) { b1 = e_w_o; b2 = e_w_o; }, DM,
                              [&](int r, int c, float v, float) { H[(size_t)r * DM + c] = (bf16_t)f2bf(bf2f(H[(size_t)r * DM + c]) + v); }); }
            else { pg8::Gemm g{(const char*)OM, (const char*)(W + WE_O), DM, DM, DM, 2, 0u, 0u}; pg8::DenseOrder S; S.init(T_ / 256, DM / 256, F.G, (int)blockIdx.x);
                const bf16_t* xin_ = rep_ ? H : XB2; const float sc_ = rep_ ? 0.0f : 1.0f; float* ssx_ = (float*)(args.ws + WS_SSX); LAS float* P_ = (LAS float*)(F.lds + LDSCTL_OFF + 8192);
                if (HAS_G3(1, 1) && AO8 && FFN8) { g.es = 1; pg8::EpiResid16<true, true> E{xin_, H, ssx_, P_, sc_ / 4096.0f, H8B}; pg8::gemm_phase<pg8::EpiResid16<true, true>, pg8::DenseOrder, false, true>(F.lds, F.wave, g, S, E); }
                else if (HAS_G3(1, 0) && AO8) { g.es = 1; pg8::EpiResid16<true> E{xin_, H, ssx_, P_, sc_ / 4096.0f}; pg8::gemm_phase<pg8::EpiResid16<true>, pg8::DenseOrder, false, true>(F.lds, F.wave, g, S, E); }
                else if (HAS_G3(0, 1) && FFN8) { pg8::EpiResid16<true, true> E{xin_, H, ssx_, P_, sc_, H8B}; pg8::gemm_phase<pg8::EpiResid16<true, true>, pg8::DenseOrder, false>(F.lds, F.wave, g, S, E); }
                else if (HAS_G3(0, 0)) { pg8::EpiResid16<true> E{xin_, H, ssx_, P_, sc_}; pg8::gemm_phase<pg8::EpiResid16<true>, pg8::DenseOrder, false>(F.lds, F.wave, g, S, E); } }
        PHASE_END
        PHASE_BEGIN(8)
            if (NAIVE(3)) { naive_gemm<true>(F, T_ / 64, FF, DM, H, DM, [](int r) { return r; }, [&](int, const float*& b1, const float*& b2) { b1 = e_wg; b2 = e_wu; }, FF,
                              [&](int r, int c, float v, float v2) { ACT[(size_t)r * FF + c] = (bf16_t)f2bf(silu_f(v) * v2); }); }
            else { pg8::Gemm g{(const char*)H, (const char*)(W + WE_GU), DM, DM, DM, 2, 0u, 0u}; pg8::DenseOrder S; S.init(T_ / 256, 2 * FF / 256, F.G, (int)blockIdx.x); g.probe = rep_ ? KL_PROBE : 0;
                if (FFN8) { g.A = (const char*)H8B; g.es = 1;
                    pg8::EpiSwiglu8R E{(unsigned char*)ACT, FF, 1.0f / 2048.0f, 4.0f, (const float*)(args.ws + WS_SSX), (LAS float*)(F.lds + LDSCTL_OFF + 8192)}; pg8::gemm_phase<pg8::EpiSwiglu8R, pg8::DenseOrder, false, true>(F.lds, F.wave, g, S, E); }
                else { pg8::EpiSwiglu E{ACT, FF, (const float*)(args.ws + WS_SSX), rep_ && EPI_PROBE, (LAS float*)(F.lds + LDSCTL_OFF + 8192)}; pg8::gemm_phase<pg8::EpiSwiglu, pg8::DenseOrder, false>(F.lds, F.wave, g, S, E); } }
        PHASE_END
        PHASE_BEGIN(9)
            if (NAIVE(4)) { naive_gemm<false>(F, T_ / 64, DM, FF, ACT, FF, [](int r) { return r; }, [&](int, const float*& b1, const float*& b2) { b1 = e_wd; b2 = e_wd; }, DM,
                              [&](int r, int c, float v, float) { H[(size_t)r * DM + c] = (bf16_t)f2bf(bf2f(H[(size_t)r * DM + c]) + v); }); }
            else { pg8::Gemm g{(const char*)ACT, (const char*)(W + WE_D), FF, FF, FF, 2, 0u, 0u}; pg8::DenseOrder S; S.init(T_ / 256, DM / 256, F.G, (int)blockIdx.x);
                const float sc_ = rep_ ? 0.0f : 1.0f; float* ssx_ = (float*)(args.ws + WS_SSX); LAS float* P_ = (LAS float*)(F.lds + LDSCTL_OFF + 8192);
                if (HAS_G5(1, 1) && FFN8 && QKV8) { g.es = 1; pg8::EpiResid16<true, true> E{H, H, ssx_, P_, sc_ / 1024.0f, H8B}; pg8::gemm_phase<pg8::EpiResid16<true, true>, pg8::DenseOrder, false, true>(F.lds, F.wave, g, S, E); }
                else if (HAS_G5(1, 0) && FFN8) { g.es = 1; pg8::EpiResid16<true> E{H, H, ssx_, P_, sc_ / 1024.0f}; pg8::gemm_phase<pg8::EpiResid16<true>, pg8::DenseOrder, false, true>(F.lds, F.wave, g, S, E); }
                else if (HAS_G5(0, 1) && QKV8) { pg8::EpiResid16<true, true> E{H, H, ssx_, P_, sc_, H8B}; pg8::gemm_phase<pg8::EpiResid16<true, true>, pg8::DenseOrder, false>(F.lds, F.wave, g, S, E); }
                else if (HAS_G5(0, 0)) { pg8::EpiResid16<true> E{H, H, ssx_, P_, sc_}; pg8::gemm_phase<pg8::EpiResid16<true>, pg8::DenseOrder, false>(F.lds, F.wave, g, S, E); } }
            if (rep_ == 0) {
            if (QKV8) conv_matrix<true>(F, MapQkvCA{o_w_qkv}, DM, DM, 3 * DM, (unsigned char*)(W + WO_QKV), o_attn_norm, 256.0f);
            else conv_matrix(F, MapQkvCA{o_w_qkv}, DM, DM, 3 * DM, (bf16_t*)(W + WO_QKV), o_attn_norm);
            if (BO8) conv_matrix<true>(F, MapPlain{o_w_o, DM}, DM, DM, DM, (unsigned char*)(W + WO_O), nullptr, 256.0f);
            else conv_matrix(F, MapPlain{o_w_o, DM}, DM, DM, DM, (bf16_t*)(W + WO_O));
#pragma unroll 1
            for (int e = 0; e < NE; ++e) {
#if MOE_FP8
                conv_matrix<true>(F, MapGateUp{o_wg + (size_t)e * DM * EFF, o_wu + (size_t)e * DM * EFF, EFF}, DM, DM, 2 * EFF, (unsigned char*)(W + WO_GU) + (size_t)e * 2 * EFF * DM, nullptr, 256.0f);
                conv_matrix<true>(F, MapPlain{o_wd + (size_t)e * EFF * DM, DM}, EFF, EFF, DM, (unsigned char*)(W + WO_D) + (size_t)e * DM * EFF, nullptr, 256.0f);
#else
                conv_matrix(F, MapGateUp{o_wg + (size_t)e * DM * EFF, o_wu + (size_t)e * DM * EFF, EFF}, DM, DM, 2 * EFF, (bf16_t*)(W + WO_GU) + (size_t)e * 2 * EFF * DM);
                conv_matrix(F, MapPlain{o_wd + (size_t)e * EFF * DM, DM}, EFF, EFF, DM, (bf16_t*)(W + WO_D) + (size_t)e * DM * EFF);
#endif
            }
            }
        PHASE_END

        PHASE_BEGIN(11)
            if (NAIVE(5)) {
                naive_gemm<false>(F, T_ / 64, 3 * DM, DM, H, DM, [](int r) { return r; }, [&](int, const float*& b1, const float*& b2) { b1 = o_w_qkv; b2 = o_w_qkv; }, 3 * DM,
                                  [&](int r, int c, float v, float) { bf16_t* dst = c < DM ? CQ : (c < 2 * DM ? CK : CV); dst[(size_t)r * DM + (c & (DM - 1))] = (bf16_t)f2bf(v); });
                __syncthreads(); VM_WAIT();
            } else { { LAS float* GL = (LAS float*)(F.lds + LDSCTL_OFF + 5120); if (F.tid < CA_D) { GL[F.tid] = o_qn[F.tid]; GL[192 + F.tid] = o_kn[F.tid]; } __syncthreads(); }
                pg8::Gemm g{(const char*)H, (const char*)(W + WO_QKV), DM, DM, DM, 2, 0u, 0u}; pg8::DenseOrder S; S.init(T_ / 256, 3 * DM / 256, F.G, (int)blockIdx.x);
                pg8::EpiQkvNorm E{(LAS float*)(F.lds + LDSCTL_OFF + 8192), (LAS float*)(F.lds + LDSCTL_OFF + 5120), CQ, (size_t)(B_CK - B_CQ) / 2, o_qn, o_kn, (const float*)(args.ws + WS_SSX)};
                if (QKV8) { g.A = (const char*)H8B; g.es = 1; E.iscale = 1.0f / 2048.0f; pg8::gemm_phase<pg8::EpiQkvNorm, pg8::DenseOrder, false, true>(F.lds, F.wave, g, S, E); }
                else pg8::gemm_phase<pg8::EpiQkvNorm, pg8::DenseOrder, false>(F.lds, F.wave, g, S, E); }
        PHASE_END
#if NAIVE(5)
        PHASE_BEGIN(12)
            ca_head_norm(F, CQ, o_qn); ca_head_norm(F, CK, o_kn);
        PHASE_END
#endif
        PHASE_BEGIN(13)
#if NAIVE_ATTN & 2
            attn_naive<CA_D, CA_D, true>(F, CQ, DM, CK, DM, CV, DM, CO, DM, CA_H, o_bias, 0.125f);
#else
            att::attn_mfma<CA_D, CA_D, 2, true, BAND_PIPE>(F, CQ, DM, CK, CA_H, CV, 0, BO8, CO, DM, CA_H, o_bias, 0.125f * 1.4426950408889634f, rep_ ? ATT_PROBE : 0);
#endif
        PHASE_END
        PHASE_BEGIN(14)
            if (NAIVE(2)) { naive_gemm<false>(F, T_ / 64, DM, DM, CO, DM, [](int r) { return r; }, [&](int, const float*& b1, const float*& b2) { b1 = o_w_o; b2 = o_w_o; }, DM,
                              [&](int r, int c, float v, float) { H[(size_t)r * DM + c] = (bf16_t)f2bf(bf2f(H[(size_t)r * DM + c]) + v); }); }
            else { pg8::Gemm g{(const char*)CO, (const char*)(W + WO_O), DM, DM, DM, 2, 0u, 0u}; pg8::DenseOrder S; S.init(T_ / 256, DM / 256, F.G, (int)blockIdx.x);
                pg8::EpiResid16<false> E{H, H, nullptr, nullptr, rep_ ? 0.0f : 1.0f};
                if (((BO8_MASK) != 0) && BO8) { g.es = 1; E.scale *= 1.0f / 4096.0f; pg8::gemm_phase<pg8::EpiResid16<false>, pg8::DenseOrder, false, true>(F.lds, F.wave, g, S, E); }
                else if ((BO8_MASK) != 3) pg8::gemm_phase<pg8::EpiResid16<false>, pg8::DenseOrder, false>(F.lds, F.wave, g, S, E); }
        PHASE_END
        PHASE_BEGIN(15)
            norm_router<MOE_FP8 != 0>(F, H, o_ffn_norm, o_router, H8B, route_e, route_p, route_w, perm_g, cnt_cur, rep_ != 0);
        PHASE_END
        PHASE_BEGIN(16)
            pg8::MoeInfo mi; mi.load(cnt_cur);
            if (NAIVE(6)) {
                naive_gemm<true>(F, mi.total * 4, EFF, DM, H, DM,
                    [&](int r) { const int pm = r >> 8, e = mi.expert_of(pm), p = (pm - mi.start_of(e)) * 256 + (r & 255); return p < mi.cnt_of(e) ? perm_g[(size_t)e * T_ + p] : -1; },
                    [&](int mt, const float*& b1, const float*& b2) { const int e = mi.expert_of(mt >> 2); b1 = o_wg + (size_t)e * DM * EFF; b2 = o_wu + (size_t)e * DM * EFF; }, EFF,
                    [&](int r, int c, float v, float v2) { ACT[(size_t)r * EFF + c] = (bf16_t)f2bf(silu_f(v) * v2); });
            } else {
                pg8::Gemm g{(const char*)H8B, (const char*)(W + WO_GU), DM, DM, DM, 2, 0u, 0u}; LAS int* tb = (LAS int*)(F.lds + LDSCTL_OFF + 1024); pg8::moe_tables(mi, tb, F.tid);
                pg8::MoeOrder S; S.d.init(mi.total, 2 * EFF / 256, F.G, (int)blockIdx.x); S.perm = perm_g; S.tb = tb; S.gather = true;
#if MOE_FP8
                g.es = 1;
                pg8::EpiSwiglu8 E{(unsigned char*)ACT, EFF, 1.0f / 4096.0f, 4.0f, rep_ && EPI_PROBE}; pg8::gemm_phase<pg8::EpiSwiglu8, pg8::MoeOrder, true, true>(F.lds, F.wave, g, S, E);
#else
                pg8::EpiSwiglu E{ACT, EFF, nullptr, false, nullptr}; pg8::gemm_phase<pg8::EpiSwiglu, pg8::MoeOrder, true>(F.lds, F.wave, g, S, E);
#endif
            }
        PHASE_END
        PHASE_BEGIN(17)
            pg8::MoeInfo mi; mi.load(cnt_cur);
            if (NAIVE(7)) {
                naive_gemm<false>(F, mi.total * 4, DM, EFF, ACT, EFF,
                    [&](int r) { const int pm = r >> 8, e = mi.expert_of(pm), p = (pm - mi.start_of(e)) * 256 + (r & 255); return p < mi.cnt_of(e) ? r : -1; },
                    [&](int mt, const float*& b1, const float*& b2) { const int e = mi.expert_of(mt >> 2); b1 = o_wd + (size_t)e * EFF * DM; b2 = b1; }, DM,
                    [&](int r, int c, float v, float) { Ybuf[(size_t)r * DM + c] = (bf16_t)f2bf(v); });
            } else {
                pg8::Gemm g{(const char*)ACT, (const char*)(W + WO_D), EFF, EFF, EFF, 2, 0u, 0u}; LAS int* tb = (LAS int*)(F.lds + LDSCTL_OFF + 1024); pg8::moe_tables(mi, tb, F.tid);
                pg8::MoeOrder S; S.d.init(mi.total, DM / 256, F.G, (int)blockIdx.x); S.perm = perm_g; S.tb = tb; S.gather = false;
#if MOE_FP8
                g.es = 1;
                pg8::EpiStoreBf16 E{Ybuf, DM, 1.0f / 1024.0f}; pg8::gemm_phase<pg8::EpiStoreBf16, pg8::MoeOrder, false, true>(F.lds, F.wave, g, S, E);
#else
                pg8::EpiStoreBf16 E{Ybuf, DM, 1.0f}; pg8::gemm_phase<pg8::EpiStoreBf16, pg8::MoeOrder, false>(F.lds, F.wave, g, S, E);
#endif
            }
        PHASE_END
    }
    PHASE_BEGIN(31)
        MoeCombine mc; mc.re = route_e; mc.rp = route_p; mc.rw = route_w; mc.Y = Ybuf; mc.mi.load(ctl + CW_CNT + 512);
        res_rows<true, true, false, false, true>(F, H, nullptr, nullptr, nullptr, args.out, mc);
    PHASE_END
}

#undef XB2
#undef H8B
#undef H
#undef W
#undef BIG
#undef route_e
#undef route_p
#undef route_w
#undef perm_g
#undef Ybuf
#undef positions
#undef EIN
#undef FFN8
#undef QKV8
#undef AO8
#undef IN8
#undef MLAUP8
#undef BO8
#undef OIN
#undef e_attn_norm
#undef e_w_in
#undef e_qa
#undef e_kva
#undef e_w_uq
#undef e_w_ukv
#undef e_qn
#undef e_kn
#undef e_w_o
#undef e_ffn_norm
#undef e_wg
#undef e_wu
#undef e_wd
#undef o_attn_norm
#undef o_w_qkv
#undef o_qn
#undef o_kn
#undef o_bias
#undef o_w_o
#undef o_ffn_norm
#undef o_router
#undef o_wg
#undef o_wu
#undef o_wd
#undef cnt_prev
#undef cnt_cur
#undef A1
#undef QRAW
#undef KVRAW
#undef QN
#undef KN
#undef OM
#undef ACT
#undef CQ
#undef CK
#undef CV
#undef CO
extern "C" void kernel_launch(void* const* d_in, const int* in_sizes, int n_in, void* d_out, int out_size, void* d_ws, size_t ws_size, hipStream_t stream) {
    static int grid = 0;
    if (grid == 0) {
        if (n_in != 50 || out_size != T_ * DM || ws_size < WS_END) { fprintf(stderr, "kernel_launch: shape mismatch n_in %d out %d ws %zu (need %zu)\n", n_in, out_size, ws_size, (size_t)WS_END); grid = -1; return; }
        int dev = 0, cus = 0, per_cu = 0;
        if (hipGetDevice(&dev) != hipSuccess || hipDeviceGetAttribute(&cus, hipDeviceAttributeMultiprocessorCount, dev) != hipSuccess) { grid = -1; return; }
        if (hipFuncSetAttribute((const void*)fwd, hipFuncAttributeMaxDynamicSharedMemorySize, LDS_BYTES) != hipSuccess) { fprintf(stderr, "kernel_launch: hipFuncSetAttribute failed\n"); grid = -1; return; }
        if (hipOccupancyMaxActiveBlocksPerMultiprocessor(&per_cu, (const void*)fwd, 512, LDS_BYTES) != hipSuccess || per_cu < 1) { fprintf(stderr, "kernel_launch: occupancy query says %d\n", per_cu); }
        (void)hipGetLastError();
        grid = cus;
    }
    if (grid < 0) return;
    (void)hipMemsetAsync((char*)d_ws + WS_CTL, 0, CTL_ZERO_BYTES, stream);
    Args a{};
    for (int i = 0; i < 50; ++i) a.in[i] = d_in[i];
    a.out = (float*)d_out; a.ws = (unsigned char*)d_ws;
#if MK_PER_PHASE
    for (int p = 0; p < N_PHASES; ++p) { a.ph_lo = p; a.ph_hi = p + 1; hipLaunchKernelGGL(fwd, dim3(grid), dim3(512), LDS_BYTES, stream, a); }
#else
    a.ph_lo = 0; a.ph_hi = N_PHASES; hipLaunchKernelGGL(fwd, dim3(grid), dim3(512), LDS_BYTES, stream, a);
#endif
    const hipError_t le = hipPeekAtLastError();
    if (le != hipSuccess) fprintf(stderr, "kernel_launch: launch failed: %s\n", hipGetErrorName(le));
}
```
